# Optimizing an MI355X kernel written in HIP

```python
import jax, jax.numpy as jnp
from jax import lax
import numpy as np

D_MODEL = 1024
BATCH = 4
SEQ = 8192
DEPTH = 2

N_META = 16
N_MIXERS = 2
D_FF = 2816
CONV_WIDTH = 3
GLA_HEADS = 4
GLA_DK = D_MODEL // 2
GLA_DV = D_MODEL
GLA_HEAD_K = GLA_DK // GLA_HEADS
GLA_HEAD_V = GLA_DV // GLA_HEADS
GLA_GATE_RANK = 16
GLA_GATE_NORMALIZER = 16.0
GLA_CHUNK = 64
DEEPNORM_ALPHA = (2.0 * DEPTH) ** 0.25
DEEPNORM_BETA = (8.0 * DEPTH) ** -0.25
LN_EPS = 1e-5
RMS_EPS = 1e-6
N_CONV_LAYERS = (DEPTH + 1) // 2
N_GLA_LAYERS = DEPTH // 2

kernel_name = "hybrid_shortconv_gla_macaron_deepnorm"


def layer_norm(x, gain, bias):
    xf = x.astype(jnp.float32)
    mu = jnp.mean(xf, axis=-1, keepdims=True)
    var = jnp.mean(jnp.square(xf - mu), axis=-1, keepdims=True)
    y = (xf - mu) * lax.rsqrt(var + LN_EPS) * gain.astype(jnp.float32) + bias.astype(jnp.float32)
    return y.astype(x.dtype)


def swiglu_ffn(h, w_in, w_out):
    gate, up = jnp.split(h @ w_in, 2, axis=-1)
    return (jax.nn.silu(gate) * up) @ w_out


def short_conv_mixer(h, w_in, w_conv, w_out):
    bgate, cgate, u = jnp.split(h @ w_in, 3, axis=-1)
    u = cgate * u
    L = u.shape[1]
    up = jnp.pad(u, ((0, 0), (CONV_WIDTH - 1, 0), (0, 0)))
    conv = w_conv[0] * up[:, 0:L]
    for tap in range(1, CONV_WIDTH):
        conv = conv + w_conv[tap] * up[:, tap:tap + L]
    return (bgate * conv) @ w_out


def gla_mixer(h, w_in, w_gate_up, b_gate, norm_w, w_out):
    bsz, L, _ = h.shape
    f32 = jnp.float32
    splits = [GLA_DK, 2 * GLA_DK, 2 * GLA_DK + GLA_DV, 2 * GLA_DK + 2 * GLA_DV]
    q, k, v, g, gz = jnp.split(h @ w_in, splits, axis=-1)
    log_a = jax.nn.log_sigmoid((gz @ w_gate_up + b_gate).astype(f32)) / GLA_GATE_NORMALIZER
    q = q.astype(f32) * (GLA_HEAD_K ** -0.5)
    k = k.astype(f32)
    v = v.astype(f32)
    pad = (-L) % GLA_CHUNK
    padw = ((0, 0), (pad, 0), (0, 0))
    q, k, v, log_a = (jnp.pad(t, padw) for t in (q, k, v, log_a))
    Lp = L + pad
    nc = Lp // GLA_CHUNK

    def to_chunks(t, d):
        return t.reshape(bsz, nc, GLA_CHUNK, GLA_HEADS, d).transpose(1, 0, 3, 2, 4)

    q = to_chunks(q, GLA_HEAD_K)
    k = to_chunks(k, GLA_HEAD_K)
    v = to_chunks(v, GLA_HEAD_V)
    b = jnp.cumsum(to_chunks(log_a, GLA_HEAD_K), axis=3)
    b_ref = b[:, :, :, GLA_CHUNK // 2:GLA_CHUNK // 2 + 1, :]
    b_last = b[:, :, :, -1:, :]
    scores = jnp.einsum('nbhik,nbhjk->nbhij', q * jnp.exp(b - b_ref), k * jnp.exp(b_ref - b))
    causal = jnp.tril(jnp.ones((GLA_CHUNK, GLA_CHUNK), dtype=bool))
    scores = jnp.where(causal, scores, 0.0)
    o_intra = jnp.einsum('nbhij,nbhjv->nbhiv', scores, v)
    q_inter = q * jnp.exp(b)
    k_state = k * jnp.exp(b_last - b)
    decay = jnp.exp(b_last[:, :, :, 0, :])

    def step(state, xs):
        qi, ks, vi, dec = xs
        o = jnp.einsum('bhck,bhkv->bhcv', qi, state)
        state = dec[..., None] * state + jnp.einsum('bhck,bhcv->bhkv', ks, vi)
        return state, o

    s0 = jnp.zeros((bsz, GLA_HEADS, GLA_HEAD_K, GLA_HEAD_V), f32)
    _, o_inter = lax.scan(step, s0, (q_inter, k_state, v, decay))
    o = (o_intra + o_inter).transpose(1, 0, 3, 2, 4).reshape(bsz, Lp, GLA_HEADS, GLA_HEAD_V)[:, pad:]
    o = o * lax.rsqrt(jnp.mean(jnp.square(o), axis=-1, keepdims=True) + RMS_EPS) * norm_w.astype(f32)
    o = o.reshape(bsz, L, GLA_DV).astype(h.dtype) * jax.nn.silu(g)
    return o @ w_out


def setup_inputs(seed: int = 0) -> dict:
    key = jax.random.key(seed)
    ks = jax.random.split(key, 16)
    nrm = jax.random.normal
    D, F = D_MODEL, D_FF
    gla_in_width = 2 * GLA_DK + 2 * GLA_DV + GLA_GATE_RANK
    return {
        "x": nrm(ks[0], (BATCH, SEQ, D), jnp.float32),
        "meta_tokens": nrm(ks[1], (N_META, D), jnp.float32),
        "ln_gain": 1.0 + 0.02 * nrm(ks[2], (DEPTH, 3, D), jnp.float32),
        "ln_bias": 0.02 * nrm(ks[3], (DEPTH, 3, D), jnp.float32),
        "ffn_w_in": nrm(ks[4], (DEPTH, 2, D, 2 * F), jnp.float32) * D ** -0.5,
        "ffn_w_out": nrm(ks[5], (DEPTH, 2, F, D), jnp.float32) * (F ** -0.5 * DEEPNORM_BETA),
        "conv_w_in": nrm(ks[6], (N_CONV_LAYERS, D, 3 * D), jnp.float32) * D ** -0.5,
        "conv_w": nrm(ks[7], (N_CONV_LAYERS, CONV_WIDTH, D), jnp.float32) * CONV_WIDTH ** -0.5,
        "conv_w_out": nrm(ks[8], (N_CONV_LAYERS, D, D), jnp.float32) * (D ** -0.5 * DEEPNORM_BETA),
        "gla_w_in": nrm(ks[9], (N_GLA_LAYERS, D, gla_in_width), jnp.float32) * D ** -0.5,
        "gla_w_gate_up": nrm(ks[10], (N_GLA_LAYERS, GLA_GATE_RANK, GLA_DK), jnp.float32) * GLA_GATE_RANK ** -0.5,
        "gla_b_gate": 0.01 * nrm(ks[11], (N_GLA_LAYERS, GLA_DK), jnp.float32),
        "gla_norm_w": 1.0 + 0.02 * nrm(ks[12], (N_GLA_LAYERS, GLA_HEAD_V), jnp.float32),
        "gla_w_out": nrm(ks[13], (N_GLA_LAYERS, GLA_DV, D), jnp.float32) * (GLA_DV ** -0.5 * DEEPNORM_BETA),
    }


def reference(x, meta_tokens, ln_gain, ln_bias, ffn_w_in, ffn_w_out, conv_w_in, conv_w, conv_w_out,
              gla_w_in, gla_w_gate_up, gla_b_gate, gla_norm_w, gla_w_out):
    bsz = x.shape[0]
    meta = jnp.broadcast_to(meta_tokens[None].astype(x.dtype), (bsz, N_META, D_MODEL))
    h = jnp.concatenate([meta, x], axis=1)
    for i in range(DEPTH):
        h = layer_norm(DEEPNORM_ALPHA * h + 0.5 * swiglu_ffn(h, ffn_w_in[i, 0], ffn_w_out[i, 0]),
                       ln_gain[i, 0], ln_bias[i, 0])
        j = i // N_MIXERS
        if i % N_MIXERS == 0:
            mix = short_conv_mixer(h, conv_w_in[j], conv_w[j], conv_w_out[j])
        else:
            mix = gla_mixer(h, gla_w_in[j], gla_w_gate_up[j], gla_b_gate[j], gla_norm_w[j], gla_w_out[j])
        h = layer_norm(DEEPNORM_ALPHA * h + mix, ln_gain[i, 1], ln_bias[i, 1])
        h = layer_norm(DEEPNORM_ALPHA * h + 0.5 * swiglu_ffn(h, ffn_w_in[i, 1], ffn_w_out[i, 1]),
                       ln_gain[i, 2], ln_bias[i, 2])
    return h[:, N_META:]
```

```cpp
#include <hip/hip_runtime.h>
#include <hip/hip_cooperative_groups.h>
#include <cstdio>
#include <cstdint>
namespace cg = cooperative_groups;

namespace pg8 {
#define PG8_LAS __attribute__((address_space(3)))
typedef unsigned short bf16_t;
typedef short bf16x8 __attribute__((ext_vector_type(8)));
typedef float f32x4 __attribute__((ext_vector_type(4)));
typedef unsigned u32x4 __attribute__((ext_vector_type(4)));
typedef unsigned u32x2 __attribute__((ext_vector_type(2)));
constexpr int BM = 256, BK = 64, HALF = 128, HTB = HALF * BK * 2  , STAGE_BYTES = 8 * HTB, NXCD = 8, WGM = 8;

__host__ __device__ __forceinline__ int lds_byte(int r, int c) { const int st = (r >> 4) * 2 + (c >> 5), rr = r & 15, cc = c & 31, ob = rr * 64 + cc * 2; return st * 1024 + (ob ^ (((ob >> 9) & 1) << 5)); }
__host__ __device__ __forceinline__ void stage_rc(int b, int& R, int& C) { const int st = b / 1024, sb = b % 1024, swz = sb ^ (((sb >> 9) & 1) << 5); R = (st >> 1) * 16 + swz / 64; C = (st & 1) * 32 + (swz % 64) / 2; }
__host__ __device__ __forceinline__ int perm32(int rho) { const int n = rho >> 4, i = rho & 15; return 8 * (i >> 2) + 4 * n + (i & 3); }

struct Unit { int pm, pn; };
struct Gemm { const bf16_t* A; const bf16_t* Bt; int M, N, K; };

struct StaticOrder {
    int nM, nN, nwg, G, c, rev = 0, pm0 = 0;
    __host__ __device__ void init(int M, int N, int G_, int c_) { nM = M / BM; nN = N / BM; nwg = nM * nN; G = G_; c = c_; }
    __host__ __device__ bool next(int i, Unit& u) const {
        const long L = (long)i * G + c; if (L >= nwg) return false;
        int wgid = rev ? nwg - 1 - (int)L : (int)L;
        { const int q = nwg / NXCD, r = nwg % NXCD, xcd = wgid % NXCD, off = wgid / NXCD; wgid = (xcd < r ? xcd * (q + 1) : r * (q + 1) + (xcd - r) * q) + off; }
        const int nig = WGM * nN, gid = wgid / nig, fm = gid * WGM, gsz = (nM - fm) < WGM ? (nM - fm) : WGM;
        u.pm = fm + ((wgid % nig) % gsz); u.pn = (wgid % nig) / gsz; if (pm0) u.pm &= 7; return true;
    }
    __device__ __forceinline__ void a_ready(const Unit&) const {}
    __device__ __forceinline__ void done(const Unit&) const {}
};

__device__ __forceinline__ unsigned cvt_pk_bf16(float lo, float hi) { unsigned r; asm volatile("v_cvt_pk_bf16_f32 %0, %1, %2" : "=v"(r) : "v"(lo), "v"(hi)); return r; }
__device__ __forceinline__ float silu_f(float x) { return x * __builtin_amdgcn_rcpf(1.0f + __builtin_amdgcn_exp2f(-1.44269504089f * x)); }
__device__ __forceinline__ u32x4 pack8(const f32x4 a, const f32x4 b) { u32x4 w; w.x = cvt_pk_bf16(a[0], a[1]); w.y = cvt_pk_bf16(a[2], a[3]); w.z = cvt_pk_bf16(b[0], b[1]); w.w = cvt_pk_bf16(b[2], b[3]); return w; }

constexpr int MROWS_REAL = 32768;

struct EpiSwiGLU {
    static constexpr bool PERM = true, AFTER_DRAIN = false;
    bf16_t* O; int ldc;
    __device__ __forceinline__ void operator()(const f32x4 (&acc)[2][2][4][2], const Unit& u, int wr, int wc, int fr, int fq) const {
        const int row0 = u.pm * BM + wr * 64 + fr, col0 = u.pn * HALF + wc * 32 + 8 * fq;
#pragma unroll
        for (int ai = 0; ai < 2; ++ai)
#pragma unroll
            for (int m = 0; m < 4; ++m) {
                bf16_t* rowp = O + (size_t)(row0 + ai * HALF + m * 16) * ldc + col0;
                f32x4 a0, a1;
#pragma unroll
                for (int j = 0; j < 4; ++j) { a0[j] = silu_f(acc[ai][0][m][0][j]) * acc[ai][1][m][0][j]; a1[j] = silu_f(acc[ai][0][m][1][j]) * acc[ai][1][m][1][j]; }
                *(u32x4*)rowp = pack8(a0, a1);
            }
    }
};

struct EpiResid {
    static constexpr bool PERM = false, AFTER_DRAIN = false;
    const float* Rreal; const float* Rmeta; float* Oreal; float* Ometa; const float* stats; const float* gain; const float* bias; float alpha, scale; int light = 0;
    __device__ __forceinline__ void operator()(const f32x4 (&acc)[2][2][4][2], const Unit& u, int wr, int wc, int fr, int fq) const {
        const float* src = Rreal + (size_t)u.pm * BM * 1024;
        float* dst = Oreal + (size_t)u.pm * BM * 1024;
        const int r0 = wr * 64 + fr, col0 = u.pn * BM + wc * 32 + 4 * fq;
        float mean[2][4], rstd[2][4];
#pragma unroll
        for (int ai = 0; ai < 2; ++ai)
#pragma unroll
            for (int m = 0; m < 4; ++m) {
                mean[ai][m] = 0.f; rstd[ai][m] = 1.f;
                if (stats) { const float2 s = *(const float2*)(stats + (size_t)(u.pm * BM + r0 + ai * HALF + m * 16) * 2); mean[ai][m] = s.x; rstd[ai][m] = s.y; }
            }
#pragma unroll
        for (int bj = 0; bj < 2; ++bj)
#pragma unroll
            for (int n = 0; n < 2; ++n) {
                const int c = col0 + bj * HALF + n * 16;
                f32x4 gv = (f32x4){1.f, 1.f, 1.f, 1.f}, bv = (f32x4){0.f, 0.f, 0.f, 0.f};
                if (stats) { gv = *(const f32x4*)(gain + c); bv = *(const f32x4*)(bias + c); }
#pragma unroll
                for (int ai = 0; ai < 2; ++ai)
#pragma unroll
                    for (int m = 0; m < 4; ++m) {
                        const size_t off = (size_t)(r0 + ai * HALF + m * 16) * 1024 + c;
                        const f32x4 x = light ? (f32x4){0.f, 0.f, 0.f, 0.f} : *(const f32x4*)(src + off);
                        const f32x4 h = (x - mean[ai][m]) * rstd[ai][m] * gv + bv;
                        *(f32x4*)(dst + off) = h * alpha + acc[ai][bj][m][n] * scale;
                    }
                asm volatile("" ::: "memory");
            }
    }
};

struct EpiConvIn {
    static constexpr bool PERM = true, AFTER_DRAIN = false;
    bf16_t* CU; bf16_t* BG;
    __device__ __forceinline__ void operator()(const f32x4 (&acc)[2][2][4][2], const Unit& u, int wr, int wc, int fr, int fq) const {
        const int row0 = u.pm * BM + wr * 64 + fr;
        if (u.pn < 8) {
            const int col0 = u.pn * HALF + wc * 32 + 8 * fq;
#pragma unroll
            for (int ai = 0; ai < 2; ++ai)
#pragma unroll
                for (int m = 0; m < 4; ++m) {
                    bf16_t* rowp = CU + (size_t)(row0 + ai * HALF + m * 16) * 1024 + col0;
                    *(u32x4*)rowp = pack8(acc[ai][0][m][0] * acc[ai][1][m][0], acc[ai][0][m][1] * acc[ai][1][m][1]);
                }
        } else {
            const int col0 = (u.pn - 8) * BM + wc * 32 + 8 * fq;
#pragma unroll
            for (int ai = 0; ai < 2; ++ai)
#pragma unroll
                for (int m = 0; m < 4; ++m) {
                    bf16_t* rowp = BG + (size_t)(row0 + ai * HALF + m * 16) * 1024 + col0;
#pragma unroll
                    for (int bj = 0; bj < 2; ++bj) *(u32x4*)(rowp + bj * HALF) = pack8(acc[ai][bj][m][0], acc[ai][bj][m][1]);
                }
        }
    }
};

struct EpiGlaIn {
    static constexpr bool PERM = true, AFTER_DRAIN = false;
    bf16_t* Q; bf16_t* Kk; bf16_t* V; bf16_t* G; float* GZ; float qscale;
    __device__ __forceinline__ void operator()(const f32x4 (&acc)[2][2][4][2], const Unit& u, int wr, int wc, int fr, int fq) const {
        const int row0 = u.pm * BM + wr * 64 + fr;
        bf16_t* base; int ld, colt; float sc = 1.f; bool act = false;
        if (u.pn < 2) { base = Q; ld = 512; colt = u.pn * BM; sc = qscale; }
        else if (u.pn < 4) { base = Kk; ld = 512; colt = (u.pn - 2) * BM; }
        else if (u.pn < 8) { base = V; ld = 1024; colt = (u.pn - 4) * BM; }
        else { base = G; ld = 1024; colt = (u.pn - 8) * BM; act = true; }
        const int col0 = colt + wc * 32 + 8 * fq;
#pragma unroll
        for (int ai = 0; ai < 2; ++ai)
#pragma unroll
            for (int m = 0; m < 4; ++m) {
                bf16_t* rowp = base + (size_t)(row0 + ai * HALF + m * 16) * ld + col0;
#pragma unroll
                for (int bj = 0; bj < 2; ++bj) {
                    f32x4 v0 = acc[ai][bj][m][0] * sc, v1 = acc[ai][bj][m][1] * sc;
                    if (act) {
#pragma unroll
                        for (int j = 0; j < 4; ++j) { v0[j] = silu_f(v0[j]); v1[j] = silu_f(v1[j]); }
                    }
                    *(u32x4*)(rowp + bj * HALF) = pack8(v0, v1);
                }
            }
    }
};

template <class Epi, class Sched, bool ALIGN_EPI = false, bool SP2 = false>
__device__ __forceinline__ void gemm_phase(PG8_LAS unsigned char* lds, const Gemm g, const Sched& S, const Epi& E) {
    int tid_ = threadIdx.x; asm volatile("" : "+v"(tid_));
    const int tid = tid_, wid = __builtin_amdgcn_readfirstlane(tid >> 6), lane = tid & 63, wr = wid >> 2, wc = wid & 3, fr = lane & 15, fq = lane >> 4;
    const int K = g.K, nt = K / BK;
    unsigned voffA[2], voffB[2];
#pragma unroll
    for (int i = 0; i < 2; ++i) { int R, C; stage_rc(tid * 16 + i * 8192, R, C); const int Rb = Epi::PERM ? ((R & ~31) + perm32(R & 31)) : R;
        voffA[i] = (unsigned)(R * K + C) * 2u; voffB[i] = (unsigned)(Rb * K + C) * 2u; }
    const size_t kstep = (size_t)(BK * 2);
    const size_t hstep = (size_t)HALF * K * 2;
    const size_t tstep = 2 * hstep;
    const unsigned ldsw = (unsigned)wid * 1024u;
    const int aoff = lds_byte(wr * 64 + fr, fq * 8), boff = lds_byte(wc * 32 + fr, fq * 8);
#define PG8_SA(b, h) (((b) * 2 + (h)) * HTB)
#define PG8_SB(b, h) ((4 + (b) * 2 + (h)) * HTB)
#define PG8_STAGE(bufoff, gbase, voff) do { _Pragma("unroll") for (int _i = 0; _i < 2; ++_i) \
        __builtin_amdgcn_global_load_lds((const unsigned*)((const char*)(gbase) + (voff)[_i]), (PG8_LAS unsigned*)(lds + (bufoff) + ldsw + _i * 8192), 16, 0, 0); } while (0)
#define PG8_LDA(dst, b, h) do { _Pragma("unroll") for (int m = 0; m < 4; ++m) _Pragma("unroll") for (int k = 0; k < 2; ++k) dst[m][k] = *(const PG8_LAS bf16x8*)(lds + PG8_SA(b, h) + aoff + m * 2048 + k * 1024); } while (0)
#define PG8_LDB(dst, b, h) do { _Pragma("unroll") for (int n = 0; n < 2; ++n) _Pragma("unroll") for (int k = 0; k < 2; ++k) dst[n][k] = *(const PG8_LAS bf16x8*)(lds + PG8_SB(b, h) + boff + n * 2048 + k * 1024); } while (0)
#define PG8_MMA(ai, bj, At, Bt) do { __builtin_amdgcn_s_setprio(1); _Pragma("unroll") for (int m = 0; m < 4; ++m) _Pragma("unroll") for (int n = 0; n < 2; ++n) _Pragma("unroll") for (int k = 0; k < 2; ++k) \
        acc[ai][bj][m][n] = __builtin_amdgcn_mfma_f32_16x16x32_bf16(Bt[n][k], At[m][k], acc[ai][bj][m][n], 0, 0, 0); __builtin_amdgcn_s_setprio(0); } while (0)
#define PG8_WAIT_V(n) asm volatile("s_waitcnt vmcnt(" #n ")" ::: "memory")
#define PG8_WAIT_L(n) asm volatile("s_waitcnt lgkmcnt(" #n ")" ::: "memory")
#define PG8_BAR __builtin_amdgcn_s_barrier()
#define PG8_SCHED __builtin_amdgcn_sched_barrier(0)
    Unit cur, nxt; int ui = 0;
    if (!S.next(0, cur)) return;
    f32x4 acc[2][2][4][2];
#pragma unroll
    for (int a = 0; a < 2; ++a)
#pragma unroll
        for (int b = 0; b < 2; ++b)
#pragma unroll
            for (int m = 0; m < 4; ++m)
#pragma unroll
                for (int n = 0; n < 2; ++n) acc[a][b][m][n] = (f32x4){0.f, 0.f, 0.f, 0.f};
    bf16x8 At[4][2], B0[2][2], B1[2][2];
    const char* cA = (const char*)g.A + (size_t)cur.pm * tstep; const char* cB = (const char*)g.Bt + (size_t)cur.pn * tstep;
    S.a_ready(cur);
    if constexpr (SP2) {
        PG8_STAGE(PG8_SB(0, 0), cB, voffB); PG8_STAGE(PG8_SB(0, 1), cB + hstep, voffB); PG8_STAGE(PG8_SA(0, 0), cA, voffA); PG8_STAGE(PG8_SA(0, 1), cA + hstep, voffA);
        if (wr == 1) PG8_BAR;
        PG8_WAIT_V(2); PG8_BAR;
        PG8_STAGE(PG8_SB(1, 0), cB + kstep, voffB); PG8_STAGE(PG8_SA(1, 0), cA + kstep, voffA); PG8_STAGE(PG8_SB(1, 1), cB + hstep + kstep, voffB);
        PG8_WAIT_V(6); PG8_BAR;
    } else {
        PG8_STAGE(PG8_SB(0, 0), cB, voffB); PG8_STAGE(PG8_SA(0, 0), cA, voffA); PG8_STAGE(PG8_SB(0, 1), cB + hstep, voffB); PG8_STAGE(PG8_SA(0, 1), cA + hstep, voffA);
        if (wr == 1) PG8_BAR;
        PG8_WAIT_V(4); PG8_BAR;
        PG8_STAGE(PG8_SB(1, 0), cB + kstep, voffB); PG8_STAGE(PG8_SA(1, 0), cA + kstep, voffA); PG8_STAGE(PG8_SB(1, 1), cB + hstep + kstep, voffB);
        PG8_WAIT_V(6); PG8_BAR;
    }
    for (;;) {
        const bool has_next = S.next(ui + 1, nxt);
        const char* nA = has_next ? (const char*)g.A + (size_t)nxt.pm * tstep : cA; const char* nB = has_next ? (const char*)g.Bt + (size_t)nxt.pn * tstep : cB;
        for (int t = 0; t < nt; t += 2) {
            const bool last = (t == nt - 2);
            const char* a1 = cA + (size_t)(t + 1) * kstep;
            const char* a2 = last ? nA : cA + (size_t)(t + 2) * kstep; const char* b2 = last ? nB : cB + (size_t)(t + 2) * kstep;
            const char* a3 = a2 + kstep; const char* b3 = b2 + kstep;
            if (last && has_next) S.a_ready(nxt);
            if constexpr (SP2) {
            PG8_LDB(B0, 0, 0); PG8_LDB(B1, 0, 1); PG8_SCHED; PG8_LDA(At, 0, 0); PG8_STAGE(PG8_SA(1, 1), a1 + hstep, voffA);
            PG8_WAIT_V(8); PG8_WAIT_L(0); PG8_BAR; PG8_MMA(0, 0, At, B0); PG8_MMA(0, 1, At, B1); PG8_BAR; PG8_SCHED;
            PG8_LDA(At, 0, 1); PG8_STAGE(PG8_SB(0, 0), b2, voffB); PG8_STAGE(PG8_SB(0, 1), b2 + hstep, voffB); PG8_STAGE(PG8_SA(0, 0), a2, voffA);
            PG8_WAIT_V(8); PG8_WAIT_L(0); PG8_BAR; PG8_MMA(1, 0, At, B0); PG8_MMA(1, 1, At, B1); PG8_BAR; PG8_SCHED;
            PG8_LDB(B0, 1, 0); PG8_LDB(B1, 1, 1); PG8_SCHED; PG8_LDA(At, 1, 0); PG8_STAGE(PG8_SA(0, 1), a2 + hstep, voffA);
            PG8_WAIT_V(8); PG8_WAIT_L(0); PG8_BAR; PG8_MMA(0, 0, At, B0); PG8_MMA(0, 1, At, B1); PG8_BAR; PG8_SCHED;
            PG8_LDA(At, 1, 1); PG8_STAGE(PG8_SB(1, 0), b3, voffB); PG8_STAGE(PG8_SB(1, 1), b3 + hstep, voffB); PG8_STAGE(PG8_SA(1, 0), a3, voffA);
            PG8_WAIT_V(8); PG8_WAIT_L(0); PG8_BAR; PG8_MMA(1, 0, At, B0); PG8_MMA(1, 1, At, B1); PG8_BAR; PG8_SCHED;
            } else {
            PG8_LDB(B0, 0, 0); PG8_SCHED; PG8_LDA(At, 0, 0); PG8_STAGE(PG8_SA(1, 1), a1 + hstep, voffA);
            PG8_WAIT_L(8); PG8_BAR; PG8_WAIT_L(0); PG8_MMA(0, 0, At, B0); PG8_BAR; PG8_SCHED;
            PG8_LDB(B1, 0, 1); PG8_STAGE(PG8_SB(0, 0), b2, voffB);
            PG8_BAR; PG8_WAIT_L(0); PG8_MMA(0, 1, At, B1); PG8_BAR;
            PG8_LDA(At, 0, 1); PG8_STAGE(PG8_SA(0, 0), a2, voffA);
            PG8_BAR; PG8_WAIT_L(0); PG8_MMA(1, 0, At, B0); PG8_BAR; PG8_SCHED;
            PG8_STAGE(PG8_SB(0, 1), b2 + hstep, voffB);
            PG8_WAIT_V(6); PG8_BAR; PG8_MMA(1, 1, At, B1); PG8_BAR;
            PG8_LDB(B0, 1, 0); PG8_SCHED; PG8_LDA(At, 1, 0); PG8_STAGE(PG8_SA(0, 1), a2 + hstep, voffA);
            PG8_WAIT_L(8); PG8_BAR; PG8_WAIT_L(0); PG8_MMA(0, 0, At, B0); PG8_BAR; PG8_SCHED;
            PG8_LDB(B1, 1, 1); PG8_STAGE(PG8_SB(1, 0), b3, voffB);
            PG8_BAR; PG8_WAIT_L(0); PG8_MMA(0, 1, At, B1); PG8_BAR;
            PG8_LDA(At, 1, 1); PG8_STAGE(PG8_SA(1, 0), a3, voffA);
            PG8_BAR; PG8_WAIT_L(0); PG8_MMA(1, 0, At, B0); PG8_BAR; PG8_SCHED;
            PG8_STAGE(PG8_SB(1, 1), b3 + hstep, voffB);
            PG8_WAIT_V(6); PG8_BAR; PG8_MMA(1, 1, At, B1); PG8_BAR;
            }
        }
        if constexpr (ALIGN_EPI) { if (wr == 0) PG8_BAR; }
        if constexpr (!Epi::AFTER_DRAIN) { E(acc, cur, wr, wc, fr, fq); S.done(cur); }
        if (!has_next) break;
#pragma unroll
        for (int a = 0; a < 2; ++a)
#pragma unroll
            for (int b = 0; b < 2; ++b)
#pragma unroll
                for (int m = 0; m < 4; ++m)
#pragma unroll
                    for (int n = 0; n < 2; ++n) acc[a][b][m][n] = (f32x4){0.f, 0.f, 0.f, 0.f};
        cur = nxt; cA = nA; cB = nB; ++ui;
        if constexpr (ALIGN_EPI) { if (wr == 1) PG8_BAR; }
    }
    PG8_WAIT_V(0);
    if constexpr (!ALIGN_EPI) { if (wr == 0) PG8_BAR; }
    PG8_BAR;
    if constexpr (Epi::AFTER_DRAIN) { E.fused(acc, cur, wr, wc, fr, fq, lds, wid, lane); S.done(cur); }
#undef PG8_SA
#undef PG8_SB
#undef PG8_STAGE
#undef PG8_LDA
#undef PG8_LDB
#undef PG8_MMA
#undef PG8_WAIT_V
#undef PG8_WAIT_L
#undef PG8_BAR
#undef PG8_SCHED
}
}

#define LAS __attribute__((address_space(3)))
typedef unsigned short bf16;
typedef float f32x4 __attribute__((ext_vector_type(4)));
typedef short bf16x8 __attribute__((ext_vector_type(8)));
typedef short s16x4 __attribute__((ext_vector_type(4)));
typedef unsigned u32x4 __attribute__((ext_vector_type(4)));
typedef unsigned u32x2 __attribute__((ext_vector_type(2)));

constexpr int D = 1024, FF = 2816, SEQ = 8192, NB = 4, NMETA = 16;
constexpr int MREAL = NB * SEQ;
constexpr int MMETA0 = MREAL;
constexpr int MPAD = MREAL + 256;
constexpr int NCH = 129;
constexpr int GLA_NIN = 3328;
constexpr float LN_EPS = 1e-5f, RMS_EPS = 1e-6f;
constexpr float ALPHA = 1.41421356237f;

constexpr size_t al256(size_t x) { return (x + 255) & ~(size_t)255; }
constexpr size_t SZ_WFI = (size_t)2 * FF * D * 2, SZ_WFO = (size_t)D * FF * 2;
constexpr size_t WS_WFI = 0;
constexpr size_t WS_WFO = WS_WFI + 4 * SZ_WFI;
constexpr size_t WS_WCI = WS_WFO + 4 * SZ_WFO;
constexpr size_t WS_WCO = WS_WCI + (size_t)3072 * D * 2;
constexpr size_t WS_WGI = WS_WCO + (size_t)D * D * 2;
constexpr size_t WS_WGO = WS_WGI + (size_t)GLA_NIN * D * 2;
constexpr size_t WS_HB = WS_WGO + (size_t)D * D * 2;
constexpr size_t WS_XM = WS_HB + (size_t)MPAD * D * 2;
constexpr size_t WS_METAR = WS_XM + (size_t)256 * D * 4;
constexpr size_t WS_STATS = WS_METAR + (size_t)256 * D * 4;
constexpr size_t WS_BIG = al256(WS_STATS + (size_t)MPAD * 8);
constexpr size_t SZ_ROWBF = (size_t)MPAD * D * 2;
constexpr size_t BIG_ACT = 0;
constexpr size_t BIG_BG = 0, BIG_CU = SZ_ROWBF;
constexpr size_t BIG_Q = 0, BIG_K = SZ_ROWBF / 2, BIG_V = SZ_ROWBF, BIG_G = 2 * SZ_ROWBF, BIG_GZ = 3 * SZ_ROWBF;
constexpr size_t BIG_U = al256(BIG_GZ + (size_t)MPAD * 16 * 4);
constexpr size_t BIG_DEC = BIG_U + (size_t)NCH * 16 * 32768 * 2;
constexpr size_t BIG_END = BIG_DEC + (size_t)NCH * 16 * 128 * 4;
constexpr size_t WS_BAR = al256(WS_BIG + BIG_END);
constexpr size_t WS_BAR_BYTES = 16384;
constexpr size_t WS_END = WS_BAR + WS_BAR_BYTES;
static_assert((size_t)MPAD * FF * 2 <= BIG_END, "act fits");

constexpr int LDS_BYTES = 147456;

struct Params {
    const float* x; const float* meta; const float* ln_gain; const float* ln_bias; const float* ffn_w_in; const float* ffn_w_out;
    const float* conv_w_in; const float* conv_w; const float* conv_w_out; const float* gla_w_in; const float* gla_w_up; const float* gla_b_gate;
    const float* gla_norm_w; const float* gla_w_out; float* out; unsigned char* ws;
};

__device__ __forceinline__ unsigned f2bf(float f) { unsigned u = __builtin_bit_cast(unsigned, f); return (u + 0x7fffu + ((u >> 16) & 1u)) >> 16; }
__device__ __forceinline__ unsigned pk2(float lo, float hi) { return pg8::cvt_pk_bf16(lo, hi); }
__device__ __forceinline__ float bf_lo(unsigned w) { return __builtin_bit_cast(float, w << 16); }
__device__ __forceinline__ float bf_hi(unsigned w) { return __builtin_bit_cast(float, w & 0xffff0000u); }
__device__ __forceinline__ float wave_sum(float v) {
#pragma unroll
    for (int o = 1; o < 64; o <<= 1) v += __shfl_xor(v, o);
    return v;
}
#define LDS_WAIT() asm volatile("s_waitcnt lgkmcnt(0)" ::: "memory")

__device__ __forceinline__ void p0_transpose_item(const float* W, int K, int ldw, int scol, int nvalid, bf16* WT, int n0d, int k0, LAS float* scr, int lane) {
    float tv[32];
#pragma unroll
    for (int i = 0; i < 32; ++i) { const int kk = 2 * i + (lane >> 5), j = lane & 31; tv[i] = (j < nvalid) ? W[(size_t)(k0 + kk) * ldw + scol + j] : 0.f; }
#pragma unroll
    for (int i = 0; i < 32; ++i) { const int kk = 2 * i + (lane >> 5), j = lane & 31; scr[kk * 33 + j] = tv[i]; }
    LDS_WAIT(); asm volatile("" ::: "memory");
    const int c = lane & 7;
#pragma unroll
    for (int jj = 0; jj < 4; ++jj) { const int n = (lane >> 3) + 8 * jj; const LAS float* s = scr + (8 * c) * 33 + n;
        u32x4 o; o.x = pk2(s[0 * 33], s[1 * 33]); o.y = pk2(s[2 * 33], s[3 * 33]); o.z = pk2(s[4 * 33], s[5 * 33]); o.w = pk2(s[6 * 33], s[7 * 33]);
        *(u32x4*)(WT + (size_t)(n0d + n) * K + k0 + 8 * c) = o; }
    LDS_WAIT(); asm volatile("" ::: "memory");
}
__device__ __forceinline__ void p0_matrix(const float* W, int K, int Nsrc, int Ndst, int mode, bf16* WT, LAS float* scr, int lane, int item) {
    const int nblk = Ndst / 32, kb = item / nblk, nb = item % nblk, n0d = nb * 32, k0 = kb * 64;
    int scol = n0d, nvalid = 32;
    if (mode == 1) { const int pn = n0d >> 8, j = n0d & 255; scol = (j < 128) ? 128 * pn + j : FF + 128 * pn + (j - 128); }
    else if (mode == 2) { const int pn = n0d >> 8, j = n0d & 255; scol = (pn < 8) ? ((j < 128) ? 1024 + 128 * pn + j : 2048 + 128 * pn + (j - 128)) : 256 * (pn - 8) + j; }
    else if (mode == 3) { nvalid = Nsrc - n0d; nvalid = nvalid < 0 ? 0 : (nvalid > 32 ? 32 : nvalid); if (nvalid == 0) scol = 0; }
    p0_transpose_item(W, K, Nsrc, scol, nvalid, WT, n0d, k0, scr, lane);
}
__device__ __forceinline__ void p0_prologue(const Params& p, LAS unsigned char* lds, int gw, int NGW, int wave, int lane) {
    LAS float* scr = (LAS float*)(lds + wave * 16384);
    unsigned char* ws = p.ws;
    constexpr int I_FI = (D / 64) * (2 * FF / 32), I_FO = (FF / 64) * (D / 32), I_CI = (D / 64) * (3072 / 32), I_SQ = (D / 64) * (D / 32), I_GI = (D / 64) * (GLA_NIN / 32);
    constexpr int NITEMS = 4 * I_FI + 4 * I_FO + I_CI + I_SQ + I_GI + I_SQ;
    for (int it = gw; it < NITEMS; it += NGW) {
        int r = it;
        if (r < 4 * I_FI) { const int l = r / I_FI; p0_matrix(p.ffn_w_in + (size_t)l * D * 2 * FF, D, 2 * FF, 2 * FF, 1, (bf16*)(ws + WS_WFI + l * SZ_WFI), scr, lane, r % I_FI); continue; } r -= 4 * I_FI;
        if (r < 4 * I_FO) { const int l = r / I_FO; p0_matrix(p.ffn_w_out + (size_t)l * FF * D, FF, D, D, 0, (bf16*)(ws + WS_WFO + l * SZ_WFO), scr, lane, r % I_FO); continue; } r -= 4 * I_FO;
        if (r < I_CI) { p0_matrix(p.conv_w_in, D, 3072, 3072, 2, (bf16*)(ws + WS_WCI), scr, lane, r); continue; } r -= I_CI;
        if (r < I_SQ) { p0_matrix(p.conv_w_out, D, D, D, 0, (bf16*)(ws + WS_WCO), scr, lane, r); continue; } r -= I_SQ;
        if (r < I_GI) { p0_matrix(p.gla_w_in, D, 3088, GLA_NIN, 3, (bf16*)(ws + WS_WGI), scr, lane, r); continue; } r -= I_GI;
        p0_matrix(p.gla_w_out, D, D, D, 0, (bf16*)(ws + WS_WGO), scr, lane, r);
    }
    bf16* HB = (bf16*)(ws + WS_HB); float* METAR = (float*)(ws + WS_METAR);
    for (int m0 = gw; m0 < MREAL + NMETA; m0 += 4 * NGW) {
        f32x4 v[4][4];
#pragma unroll
        for (int r = 0; r < 4; ++r) { const int m = m0 + r * NGW;
            if (m < MREAL + NMETA) { const float* src = (m < MREAL) ? p.x + (size_t)m * D : p.meta + (size_t)(m - MREAL) * D;
#pragma unroll
                for (int j = 0; j < 4; ++j) v[r][j] = ((const f32x4*)src)[lane + 64 * j]; } }
#pragma unroll
        for (int r = 0; r < 4; ++r) { const int m = m0 + r * NGW;
            if (m < MREAL + NMETA) {
                unsigned long long* o8 = (unsigned long long*)(HB + (size_t)m * D) + lane;
#pragma unroll
                for (int j = 0; j < 4; ++j) {
                    o8[64 * j] = (unsigned long long)pk2(v[r][j][0], v[r][j][1]) | ((unsigned long long)pk2(v[r][j][2], v[r][j][3]) << 32);
                    if (m >= MREAL) ((f32x4*)(METAR + (size_t)(m - MREAL) * D))[lane + 64 * j] = v[r][j];
                } } }
    }
}

template <bool FINAL>
__device__ __forceinline__ void ln_phase(const float* Zreal, const float* Zmeta, const float* gain, const float* bias, bf16* HB, float* stats, float* out, int gw, int NGW, int lane) {
    f32x4 g[4], bb[4];
#pragma unroll
    for (int j = 0; j < 4; ++j) { g[j] = ((const f32x4*)gain)[lane + 64 * j]; bb[j] = ((const f32x4*)bias)[lane + 64 * j]; }
    const int nrows = FINAL ? MREAL : MREAL + NMETA;
    for (int m0 = gw; m0 < nrows; m0 += 4 * NGW) {
        f32x4 v[4][4];
#pragma unroll
        for (int r = 0; r < 4; ++r) { const int m = m0 + r * NGW;
            if (m < nrows) { const float* zr = (m < MREAL) ? Zreal + (size_t)m * D : Zmeta + (size_t)(m - MREAL) * D;
#pragma unroll
                for (int j = 0; j < 4; ++j) v[r][j] = ((const f32x4*)zr)[lane + 64 * j]; }
            else {
#pragma unroll
                for (int j = 0; j < 4; ++j) v[r][j] = (f32x4){0.f, 0.f, 0.f, 0.f}; } }
#pragma unroll
        for (int r = 0; r < 4; ++r) { const int m = m0 + r * NGW;
            float s = 0.f;
#pragma unroll
            for (int j = 0; j < 4; ++j) s += (v[r][j][0] + v[r][j][1]) + (v[r][j][2] + v[r][j][3]);
            const float mean = wave_sum(s) * (1.f / D); float s2 = 0.f;
#pragma unroll
            for (int j = 0; j < 4; ++j) { const f32x4 d = v[r][j] - mean; s2 += (d[0] * d[0] + d[1] * d[1]) + (d[2] * d[2] + d[3] * d[3]); }
            const float rstd = 1.0f / sqrtf(wave_sum(s2) * (1.f / D) + LN_EPS);
            if (m < nrows) {
                if (FINAL) {
#pragma unroll
                    for (int j = 0; j < 4; ++j) ((f32x4*)(out + (size_t)m * D))[lane + 64 * j] = (v[r][j] - mean) * rstd * g[j] + bb[j];
                } else {
                    if (lane == 0) { stats[(size_t)m * 2] = mean; stats[(size_t)m * 2 + 1] = rstd; }
                    unsigned long long* o8 = (unsigned long long*)(HB + (size_t)m * D) + lane;
#pragma unroll
                    for (int j = 0; j < 4; ++j) { const f32x4 y = (v[r][j] - mean) * rstd * g[j] + bb[j]; o8[64 * j] = (unsigned long long)pk2(y[0], y[1]) | ((unsigned long long)pk2(y[2], y[3]) << 32); }
                }
            }
        }
    }
}

__device__ __forceinline__ int conv_pred(int m, int k) {
    if (m < MREAL) { const int t = m & (SEQ - 1); return (t >= k) ? m - k : MMETA0 + (NMETA + t - k); }
    const int j = m - MMETA0; return (j >= k) ? m - k : -1;
}
__device__ __forceinline__ void conv_mix_phase(const bf16* BG, const bf16* CU, const float* cw, bf16* VO, int gw, int NGW, int lane) {
    const int nrows = MREAL + NMETA;
    const u32x4 z4 = (u32x4){0u, 0u, 0u, 0u};
    float wt[3][16];
#pragma unroll
    for (int k = 0; k < 3; ++k)
#pragma unroll
        for (int j = 0; j < 2; ++j)
#pragma unroll
            for (int q = 0; q < 2; ++q) { const f32x4 t = *(const f32x4*)(cw + k * D + 8 * (lane + 64 * j) + 4 * q);
                wt[k][8 * j + 4 * q] = t[0]; wt[k][8 * j + 4 * q + 1] = t[1]; wt[k][8 * j + 4 * q + 2] = t[2]; wt[k][8 * j + 4 * q + 3] = t[3]; }
    for (int m0 = gw; m0 < nrows; m0 += 2 * NGW) {
        u32x4 b4[2][2], x0[2][2], x1[2][2], x2[2][2];
#pragma unroll
        for (int r = 0; r < 2; ++r) { const int m = m0 + r * NGW; const bool ok = m < nrows;
            const int p1 = ok ? conv_pred(m, 1) : -1, p2 = ok ? conv_pred(m, 2) : -1;
#pragma unroll
            for (int j = 0; j < 2; ++j) { const int c0 = 8 * (lane + 64 * j);
                b4[r][j] = ok ? *(const u32x4*)(BG + (size_t)m * D + c0) : z4; x0[r][j] = ok ? *(const u32x4*)(CU + (size_t)m * D + c0) : z4;
                x1[r][j] = (p1 >= 0) ? *(const u32x4*)(CU + (size_t)p1 * D + c0) : z4; x2[r][j] = (p2 >= 0) ? *(const u32x4*)(CU + (size_t)p2 * D + c0) : z4; } }
#pragma unroll
        for (int r = 0; r < 2; ++r) { const int m = m0 + r * NGW;
            if (m < nrows) {
#pragma unroll
                for (int j = 0; j < 2; ++j) { u32x4 o;
#pragma unroll
                    for (int q = 0; q < 4; ++q) { const int e = 8 * j + 2 * q;
                        const float lo = bf_lo(b4[r][j][q]) * (wt[0][e] * bf_lo(x2[r][j][q]) + wt[1][e] * bf_lo(x1[r][j][q]) + wt[2][e] * bf_lo(x0[r][j][q]));
                        const float hi = bf_hi(b4[r][j][q]) * (wt[0][e + 1] * bf_hi(x2[r][j][q]) + wt[1][e + 1] * bf_hi(x1[r][j][q]) + wt[2][e + 1] * bf_hi(x0[r][j][q]));
                        o[q] = pk2(lo, hi); }
                    *(u32x4*)(VO + (size_t)m * D + 8 * (lane + 64 * j)) = o; } } }
    }
}

constexpr int GL_B = 0, GL_GZ = 33792, GL_TOT = 37888, GL_RED = 39936, GL_K = 41984, GL_QS = 59392, GL_QI = 76800, GL_V = 94208, GL_P = 128000;
constexpr int BSTR = 132, KSTR = 136, VSTR = 264, PSTR = 72;
static_assert(GL_P + 64 * PSTR * 2 <= LDS_BYTES, "gla lds");
__device__ __forceinline__ int gla_row(int b, int n, int c) { return n ? b * SEQ + (n - 1) * 64 + c : (c >= 48 ? MMETA0 + (c - 48) : -1); }
__device__ __forceinline__ s16x4 tr_read(unsigned a) { s16x4 r; asm volatile("ds_read_b64_tr_b16 %0, %1\n\ts_waitcnt lgkmcnt(0)" : "=&v"(r) : "v"(a) : "memory"); return r; }
__device__ __forceinline__ bf16x8 tr_frag(unsigned a0, unsigned a1) { const s16x4 lo = tr_read(a0), hi = tr_read(a1); return __builtin_shufflevector(lo, hi, 0, 1, 2, 3, 4, 5, 6, 7); }
__device__ __forceinline__ unsigned lds_u32(const LAS void* p) { return (unsigned)(uintptr_t)p; }
__device__ __forceinline__ void tr_frag_x2(unsigned a0, unsigned a1, bf16x8 (&f)[2]) {
    s16x4 l0, l1, h0, h1;
    asm volatile("ds_read_b64_tr_b16 %0, %4\n\tds_read_b64_tr_b16 %1, %4 offset:32\n\tds_read_b64_tr_b16 %2, %5\n\tds_read_b64_tr_b16 %3, %5 offset:32\n\ts_waitcnt lgkmcnt(0)"
                 : "=&v"(l0), "=&v"(l1), "=&v"(h0), "=&v"(h1) : "v"(a0), "v"(a1) : "memory");
    f[0] = __builtin_shufflevector(l0, h0, 0, 1, 2, 3, 4, 5, 6, 7); f[1] = __builtin_shufflevector(l1, h1, 0, 1, 2, 3, 4, 5, 6, 7);
}
__device__ __forceinline__ void tr_frag_x8(unsigned a0, unsigned a1, bf16x8 (&f)[8]) {
    s16x4 l0, l1, l2, l3, l4, l5, l6, l7, h0, h1, h2, h3, h4, h5, h6, h7;
    asm volatile("ds_read_b64_tr_b16 %0, %16\n\tds_read_b64_tr_b16 %1, %16 offset:32\n\tds_read_b64_tr_b16 %2, %16 offset:64\n\tds_read_b64_tr_b16 %3, %16 offset:96\n\t"
                 "ds_read_b64_tr_b16 %4, %16 offset:128\n\tds_read_b64_tr_b16 %5, %16 offset:160\n\tds_read_b64_tr_b16 %6, %16 offset:192\n\tds_read_b64_tr_b16 %7, %16 offset:224\n\t"
                 "ds_read_b64_tr_b16 %8, %17\n\tds_read_b64_tr_b16 %9, %17 offset:32\n\tds_read_b64_tr_b16 %10, %17 offset:64\n\tds_read_b64_tr_b16 %11, %17 offset:96\n\t"
                 "ds_read_b64_tr_b16 %12, %17 offset:128\n\tds_read_b64_tr_b16 %13, %17 offset:160\n\tds_read_b64_tr_b16 %14, %17 offset:192\n\tds_read_b64_tr_b16 %15, %17 offset:224\n\ts_waitcnt lgkmcnt(0)"
                 : "=&v"(l0), "=&v"(l1), "=&v"(l2), "=&v"(l3), "=&v"(l4), "=&v"(l5), "=&v"(l6), "=&v"(l7), "=&v"(h0), "=&v"(h1), "=&v"(h2), "=&v"(h3), "=&v"(h4), "=&v"(h5), "=&v"(h6), "=&v"(h7)
                 : "v"(a0), "v"(a1) : "memory");
    f[0] = __builtin_shufflevector(l0, h0, 0, 1, 2, 3, 4, 5, 6, 7); f[1] = __builtin_shufflevector(l1, h1, 0, 1, 2, 3, 4, 5, 6, 7);
    f[2] = __builtin_shufflevector(l2, h2, 0, 1, 2, 3, 4, 5, 6, 7); f[3] = __builtin_shufflevector(l3, h3, 0, 1, 2, 3, 4, 5, 6, 7);
    f[4] = __builtin_shufflevector(l4, h4, 0, 1, 2, 3, 4, 5, 6, 7); f[5] = __builtin_shufflevector(l5, h5, 0, 1, 2, 3, 4, 5, 6, 7);
    f[6] = __builtin_shufflevector(l6, h6, 0, 1, 2, 3, 4, 5, 6, 7); f[7] = __builtin_shufflevector(l7, h7, 0, 1, 2, 3, 4, 5, 6, 7);
}

constexpr int GLA_UNITS = (NCH - 1) * 16 + 4;
__device__ __forceinline__ void gla_unit(int idx, int& n, int& b, int& h) { if (idx < (NCH - 1) * 16) { n = 1 + (idx >> 4); b = (idx & 15) >> 2; h = idx & 3; } else { n = 0; b = 0; h = idx - (NCH - 1) * 16; } }
__device__ __forceinline__ void gla_cumdecay(LAS unsigned char* lds, const f32x4 gzv, const float (&w)[16], float bia, int n, int tid) {
    LAS float* sB = (LAS float*)(lds + GL_B); LAS float* sGZ = (LAS float*)(lds + GL_GZ); LAS float* sTot = (LAS float*)(lds + GL_TOT);
    if (tid < 256) *(LAS f32x4*)(sGZ + (tid >> 2) * 16 + (tid & 3) * 4) = gzv;
    const int kd = tid & 127, grp = tid >> 7;
    __syncthreads();
    float loc[16]; float run = 0.f;
#pragma unroll
    for (int i = 0; i < 16; ++i) {
        const int c = grp * 16 + i;
        float z = bia;
#pragma unroll
        for (int r4 = 0; r4 < 4; ++r4) { const f32x4 gv = *(const LAS f32x4*)(sGZ + c * 16 + r4 * 4); z += gv[0] * w[r4 * 4] + gv[1] * w[r4 * 4 + 1] + gv[2] * w[r4 * 4 + 2] + gv[3] * w[r4 * 4 + 3]; }
        float la = (fminf(z, 0.f) - __logf(1.0f + __expf(-fabsf(z)))) * (1.0f / 16.0f);
        if (n == 0 && c < 48) la = 0.f;
        run += la; loc[i] = run;
    }
    sTot[grp * 128 + kd] = run;
    __syncthreads();
    float off = 0.f;
#pragma unroll
    for (int g2 = 0; g2 < 3; ++g2) off += (g2 < grp) ? sTot[g2 * 128 + kd] : 0.f;
#pragma unroll
    for (int i = 0; i < 16; ++i) sB[(grp * 16 + i) * BSTR + kd] = loc[i] + off;
    __syncthreads();
}
__device__ __forceinline__ void unpack8(const u32x4 w, float (&f)[8]) {
#pragma unroll
    for (int q = 0; q < 4; ++q) { f[2 * q] = bf_lo(w[q]); f[2 * q + 1] = bf_hi(w[q]); }
}
__device__ __forceinline__ u32x4 pack8f(const float (&f)[8]) { u32x4 w; w.x = pk2(f[0], f[1]); w.y = pk2(f[2], f[3]); w.z = pk2(f[4], f[5]); w.w = pk2(f[6], f[7]); return w; }

__device__ __forceinline__ void gla_g1(const Params& p, LAS unsigned char* lds, int tid, int wave, int lane) {
    unsigned char* big = p.ws + WS_BIG;
    const bf16* Kb = (const bf16*)(big + BIG_K); const bf16* Vb = (const bf16*)(big + BIG_V); const float* GZ = (const float*)(big + BIG_GZ);
    bf16* Ub = (bf16*)(big + BIG_U); float* Dec = (float*)(big + BIG_DEC);
    LAS float* sB = (LAS float*)(lds + GL_B); LAS bf16* sK = (LAS bf16*)(lds + GL_K); LAS bf16* sV = (LAS bf16*)(lds + GL_V);
    const int fr = lane & 15, fq = lane >> 4;
    const u32x4 z4 = (u32x4){0u, 0u, 0u, 0u};
    const int kd8 = (tid & 15) * 8, cb = tid >> 4;
    f32x4 gzv; float w[16]; float bia; u32x4 kv[2], vv[4];
#define G1_LOAD(IDX) do { int n_, b_, h_; gla_unit((IDX), n_, b_, h_); gzv = (f32x4){0.f, 0.f, 0.f, 0.f}; \
        if (tid < 256) { const int row = gla_row(b_, n_, tid >> 2); if (row >= 0) gzv = *(const f32x4*)(GZ + (size_t)row * 16 + (tid & 3) * 4); } \
        _Pragma("unroll") for (int r = 0; r < 16; ++r) w[r] = p.gla_w_up[r * 512 + h_ * 128 + (tid & 127)]; \
        bia = p.gla_b_gate[h_ * 128 + (tid & 127)]; \
        _Pragma("unroll") for (int i = 0; i < 2; ++i) { const int row = gla_row(b_, n_, cb + 32 * i); kv[i] = (row >= 0) ? *(const u32x4*)(Kb + (size_t)row * 512 + h_ * 128 + kd8) : z4; } \
        _Pragma("unroll") for (int i = 0; i < 4; ++i) { const int ii = tid + 512 * i, row = gla_row(b_, n_, ii >> 5); vv[i] = (row >= 0) ? *(const u32x4*)(Vb + (size_t)row * D + h_ * 256 + (ii & 31) * 8) : z4; } } while (0)
#ifndef G1_PREFETCH
#define G1_PREFETCH 1
#endif
    if (G1_PREFETCH && (int)blockIdx.x < GLA_UNITS) G1_LOAD(blockIdx.x);
    for (int idx = blockIdx.x; idx < GLA_UNITS; idx += gridDim.x) {
        int n, b, h; gla_unit(idx, n, b, h); const int unit = n * 16 + b * 4 + h;
        if (!G1_PREFETCH) G1_LOAD(idx);
        gla_cumdecay(lds, gzv, w, bia, n, tid);
        {
            float bl[8];
#pragma unroll
            for (int j = 0; j < 8; ++j) bl[j] = sB[63 * BSTR + kd8 + j];
#pragma unroll
            for (int i = 0; i < 2; ++i) { const int c = cb + 32 * i;
                float kf[8]; unpack8(kv[i], kf);
#pragma unroll
                for (int j = 0; j < 8; ++j) kf[j] *= __expf(bl[j] - sB[c * BSTR + kd8 + j]);
                *(LAS u32x4*)(sK + c * KSTR + kd8) = pack8f(kf); }
            if (tid < 128) Dec[(size_t)unit * 128 + tid] = __expf(sB[63 * BSTR + tid]);
#pragma unroll
            for (int i = 0; i < 4; ++i) { const int ii = tid + 512 * i; *(LAS u32x4*)(sV + (ii >> 5) * VSTR + (ii & 31) * 8) = vv[i]; }
        }
        if (G1_PREFETCH) { const int nx = idx + (int)gridDim.x; if (nx < GLA_UNITS) G1_LOAD(nx); }
        __syncthreads();
        f32x4 acc[8][2];
#pragma unroll
        for (int i = 0; i < 8; ++i)
#pragma unroll
            for (int j = 0; j < 2; ++j) acc[i][j] = (f32x4){0.f, 0.f, 0.f, 0.f};
#pragma unroll
        for (int ks = 0; ks < 2; ++ks) {
            const int r0 = 32 * ks + 8 * fq + (fr >> 2), cc = 4 * (fr & 3);
            bf16x8 Y[2];
#pragma unroll
            for (int j = 0; j < 2; ++j) { const int vd0 = 32 * wave + 16 * j; Y[j] = tr_frag(lds_u32(sV + r0 * VSTR + vd0 + cc), lds_u32(sV + (r0 + 4) * VSTR + vd0 + cc)); }
#pragma unroll
            for (int i = 0; i < 8; ++i) { const bf16x8 X = tr_frag(lds_u32(sK + r0 * KSTR + 16 * i + cc), lds_u32(sK + (r0 + 4) * KSTR + 16 * i + cc));
#pragma unroll
                for (int j = 0; j < 2; ++j) acc[i][j] = __builtin_amdgcn_mfma_f32_16x16x32_bf16(X, Y[j], acc[i][j], 0, 0, 0); }
        }
        bf16* Uu = Ub + (size_t)unit * 32768;
#pragma unroll
        for (int i = 0; i < 8; ++i)
#pragma unroll
            for (int j = 0; j < 2; ++j) { const int vd = 32 * wave + 16 * j + fr, kd = 16 * i + 4 * fq;
                u32x2 wv; wv.x = pk2(acc[i][j][0], acc[i][j][1]); wv.y = pk2(acc[i][j][2], acc[i][j][3]);
                *(u32x2*)(Uu + vd * 128 + kd) = wv; }
        __syncthreads();
    }
}

__device__ __forceinline__ void gla_g2(const Params& p, int tid) {
    unsigned char* big = p.ws + WS_BIG;
    bf16* Ub = (bf16*)(big + BIG_U); const float* Dec = (const float*)(big + BIG_DEC);
    for (int g = blockIdx.x * 512 + tid; g < 16 * 8192; g += gridDim.x * 512) {
        const int bh = g >> 13, e4 = (g & 8191) * 4, kd = e4 & 127;
        float S0, S1, S2, S3;
        { const size_t unit = (size_t)(bh & 3); const u32x2 u0 = *(const u32x2*)(Ub + unit * 32768 + e4); S0 = bf_lo(u0.x); S1 = bf_hi(u0.x); S2 = bf_lo(u0.y); S3 = bf_hi(u0.y); }
        for (int n0 = 1; n0 < NCH; n0 += 8) {
            u32x2 uu[8]; f32x4 dd[8];
#pragma unroll
            for (int i = 0; i < 8; ++i) { const size_t unit = (size_t)(n0 + i) * 16 + bh;
                uu[i] = *(const u32x2*)(Ub + unit * 32768 + e4); dd[i] = *(const f32x4*)(Dec + unit * 128 + kd); }
#pragma unroll
            for (int i = 0; i < 8; ++i) { const size_t unit = (size_t)(n0 + i) * 16 + bh;
                u32x2 wv; wv.x = pk2(S0, S1); wv.y = pk2(S2, S3); *(u32x2*)(Ub + unit * 32768 + e4) = wv;
                S0 = dd[i][0] * S0 + bf_lo(uu[i].x); S1 = dd[i][1] * S1 + bf_hi(uu[i].x); S2 = dd[i][2] * S2 + bf_lo(uu[i].y); S3 = dd[i][3] * S3 + bf_hi(uu[i].y); }
        }
    }
}

__device__ __forceinline__ void gla_g3(const Params& p, LAS unsigned char* lds, int tid, int wave, int lane) {
    unsigned char* big = p.ws + WS_BIG;
    const bf16* Qb = (const bf16*)(big + BIG_Q); const bf16* Kb = (const bf16*)(big + BIG_K); const bf16* Vb = (const bf16*)(big + BIG_V); const bf16* Gb = (const bf16*)(big + BIG_G);
    const float* GZ = (const float*)(big + BIG_GZ); const bf16* Sb = (const bf16*)(big + BIG_U); bf16* Ob = (bf16*)(p.ws + WS_HB);
    LAS float* sB = (LAS float*)(lds + GL_B); LAS float* sRed = (LAS float*)(lds + GL_RED);
    LAS bf16* sK = (LAS bf16*)(lds + GL_K); LAS bf16* sQs = (LAS bf16*)(lds + GL_QS); LAS bf16* sQi = (LAS bf16*)(lds + GL_QI); LAS bf16* sV = (LAS bf16*)(lds + GL_V); LAS bf16* sP = (LAS bf16*)(lds + GL_P);
    const int fr = lane & 15, fq = lane >> 4;
    const u32x4 z4 = (u32x4){0u, 0u, 0u, 0u};
    for (int idx = blockIdx.x; idx < GLA_UNITS; idx += gridDim.x) {
        int n, b, h; gla_unit(idx, n, b, h); const int unit = n * 16 + b * 4 + h;
        f32x4 gzv = (f32x4){0.f, 0.f, 0.f, 0.f};
        if (tid < 256) { const int row = gla_row(b, n, tid >> 2); if (row >= 0) gzv = *(const f32x4*)(GZ + (size_t)row * 16 + (tid & 3) * 4); }
        float w[16];
#pragma unroll
        for (int r = 0; r < 16; ++r) w[r] = p.gla_w_up[r * 512 + h * 128 + (tid & 127)];
        const float bia = p.gla_b_gate[h * 128 + (tid & 127)];
        const int kd8 = (tid & 15) * 8, cb = tid >> 4;
        u32x4 qv[2], kv[2], vv[4];
#pragma unroll
        for (int i = 0; i < 2; ++i) { const int row = gla_row(b, n, cb + 32 * i);
            qv[i] = (row >= 0) ? *(const u32x4*)(Qb + (size_t)row * 512 + h * 128 + kd8) : z4; kv[i] = (row >= 0) ? *(const u32x4*)(Kb + (size_t)row * 512 + h * 128 + kd8) : z4; }
#pragma unroll
        for (int i = 0; i < 4; ++i) { const int ii = tid + 512 * i, row = gla_row(b, n, ii >> 5); vv[i] = (row >= 0) ? *(const u32x4*)(Vb + (size_t)row * D + h * 256 + (ii & 31) * 8) : z4; }
        const bf16* Su = Sb + (size_t)unit * 32768;
        bf16x8 X2[4][2];
        if (n) {
#pragma unroll
            for (int ks = 0; ks < 4; ++ks)
#pragma unroll
                for (int xi = 0; xi < 2; ++xi) X2[ks][xi] = *(const bf16x8*)(Su + (32 * wave + 16 * xi + fr) * 128 + 32 * ks + 8 * fq);
        }
        u32x2 gg[4][2]; f32x4 nw[2];
#pragma unroll
        for (int xi = 0; xi < 2; ++xi) nw[xi] = *(const f32x4*)(p.gla_norm_w + 32 * wave + 16 * xi + 4 * fq);
#pragma unroll
        for (int mi = 0; mi < 4; ++mi) { const int row = gla_row(b, n, 16 * mi + fr);
#pragma unroll
            for (int xi = 0; xi < 2; ++xi) gg[mi][xi] = (row >= 0) ? *(const u32x2*)(Gb + (size_t)row * D + h * 256 + 32 * wave + 16 * xi + 4 * fq) : (u32x2){0u, 0u}; }
        gla_cumdecay(lds, gzv, w, bia, n, tid);
        {
            float br[8];
#pragma unroll
            for (int j = 0; j < 8; ++j) br[j] = sB[32 * BSTR + kd8 + j];
#pragma unroll
            for (int i = 0; i < 2; ++i) { const int c = cb + 32 * i;
                float qf[8], kf[8], qs[8], qi[8]; unpack8(qv[i], qf); unpack8(kv[i], kf);
#pragma unroll
                for (int j = 0; j < 8; ++j) { const float bb = sB[c * BSTR + kd8 + j]; const float e = __expf(bb - br[j]);
                    qs[j] = qf[j] * e; kf[j] = kf[j] * __expf(br[j] - bb); qi[j] = qf[j] * __expf(bb); }
                *(LAS u32x4*)(sQs + c * KSTR + kd8) = pack8f(qs); *(LAS u32x4*)(sK + c * KSTR + kd8) = pack8f(kf); *(LAS u32x4*)(sQi + c * KSTR + kd8) = pack8f(qi); }
#pragma unroll
            for (int i = 0; i < 4; ++i) { const int ii = tid + 512 * i; *(LAS u32x4*)(sV + (ii >> 5) * VSTR + (ii & 31) * 8) = vv[i]; }
        }
        __syncthreads();
        {
            const int ti = wave >> 1;
#pragma unroll
            for (int jj = 0; jj < 2; ++jj) {
                const int tj = 2 * (wave & 1) + jj;
                f32x4 a = (f32x4){0.f, 0.f, 0.f, 0.f};
                if (tj <= ti) {
#pragma unroll
                    for (int ks = 0; ks < 4; ++ks) {
                        const bf16x8 X = *(const LAS bf16x8*)(sK + (tj * 16 + fr) * KSTR + 32 * ks + 8 * fq);
                        const bf16x8 Y = *(const LAS bf16x8*)(sQs + (ti * 16 + fr) * KSTR + 32 * ks + 8 * fq);
                        a = __builtin_amdgcn_mfma_f32_16x16x32_bf16(X, Y, a, 0, 0, 0);
                    }
                }
                const int ci = ti * 16 + fr, cj = tj * 16 + 4 * fq;
                float e0 = (cj + 0 <= ci) ? a[0] : 0.f, e1 = (cj + 1 <= ci) ? a[1] : 0.f, e2 = (cj + 2 <= ci) ? a[2] : 0.f, e3 = (cj + 3 <= ci) ? a[3] : 0.f;
                u32x2 wv; wv.x = pk2(e0, e1); wv.y = pk2(e2, e3);
                *(LAS u32x2*)(sP + ci * PSTR + cj) = wv;
            }
        }
        __syncthreads();
        f32x4 acc[4][2];
#pragma unroll
        for (int mi = 0; mi < 4; ++mi)
#pragma unroll
            for (int xi = 0; xi < 2; ++xi) acc[mi][xi] = (f32x4){0.f, 0.f, 0.f, 0.f};
#pragma unroll
        for (int ks = 0; ks < 2; ++ks) {
            const int r0 = 32 * ks + 8 * fq + (fr >> 2), cc = 4 * (fr & 3);
            bf16x8 X1[2];
#pragma unroll
            for (int xi = 0; xi < 2; ++xi) { const int vd0 = 32 * wave + 16 * xi; X1[xi] = tr_frag(lds_u32(sV + r0 * VSTR + vd0 + cc), lds_u32(sV + (r0 + 4) * VSTR + vd0 + cc)); }
#pragma unroll
            for (int mi = 0; mi < 4; ++mi) { const bf16x8 Y1 = *(const LAS bf16x8*)(sP + (16 * mi + fr) * PSTR + 32 * ks + 8 * fq);
#pragma unroll
                for (int xi = 0; xi < 2; ++xi) acc[mi][xi] = __builtin_amdgcn_mfma_f32_16x16x32_bf16(X1[xi], Y1, acc[mi][xi], 0, 0, 0); }
        }
        if (n) {
#pragma unroll
            for (int ks = 0; ks < 4; ++ks) {
#pragma unroll
                for (int mi = 0; mi < 4; ++mi) { const bf16x8 Y2 = *(const LAS bf16x8*)(sQi + (16 * mi + fr) * KSTR + 32 * ks + 8 * fq);
#pragma unroll
                    for (int xi = 0; xi < 2; ++xi) acc[mi][xi] = __builtin_amdgcn_mfma_f32_16x16x32_bf16(X2[ks][xi], Y2, acc[mi][xi], 0, 0, 0); }
            }
        }
#pragma unroll
        for (int mi = 0; mi < 4; ++mi) { float ss = 0.f;
#pragma unroll
            for (int xi = 0; xi < 2; ++xi) ss += (acc[mi][xi][0] * acc[mi][xi][0] + acc[mi][xi][1] * acc[mi][xi][1]) + (acc[mi][xi][2] * acc[mi][xi][2] + acc[mi][xi][3] * acc[mi][xi][3]);
            ss += __shfl_xor(ss, 16); ss += __shfl_xor(ss, 32);
            if (fq == 0) sRed[wave * 64 + 16 * mi + fr] = ss; }
        __syncthreads();
#pragma unroll
        for (int mi = 0; mi < 4; ++mi) {
            const int c = 16 * mi + fr, row = gla_row(b, n, c);
            float tot = 0.f;
#pragma unroll
            for (int w2 = 0; w2 < 8; ++w2) tot += sRed[w2 * 64 + c];
            const float rinv = 1.0f / sqrtf(tot * (1.0f / 256.0f) + RMS_EPS);
            if (row >= 0) {
#pragma unroll
                for (int xi = 0; xi < 2; ++xi) { const int vd = 32 * wave + 16 * xi + 4 * fq;
                    const float o0 = acc[mi][xi][0] * rinv * nw[xi][0] * bf_lo(gg[mi][xi].x), o1 = acc[mi][xi][1] * rinv * nw[xi][1] * bf_hi(gg[mi][xi].x);
                    const float o2 = acc[mi][xi][2] * rinv * nw[xi][2] * bf_lo(gg[mi][xi].y), o3 = acc[mi][xi][3] * rinv * nw[xi][3] * bf_hi(gg[mi][xi].y);
                    u32x2 wv; wv.x = pk2(o0, o1); wv.y = pk2(o2, o3);
                    *(u32x2*)(Ob + (size_t)row * D + h * 256 + vd) = wv; }
            }
        }
        __syncthreads();
    }
}

typedef __attribute__((address_space(1))) unsigned gu32;
#define XB_TMO      128
#define XB_XCNT(j)  (256  + 64 * (j))
#define XB_XSUB(j)  (1280 + 64 * (j))
#define XB_XGEN(j)  (2304 + 64 * (j))
#define XB_TOP      3328
#define XB_TOPGEN   3392
#define XCD_BAR_WORDS 3456
#define XB_SPIN_CAP (1u << 18)

__device__ __forceinline__ unsigned xb_ld(unsigned* p)              { return __hip_atomic_load(p, __ATOMIC_RELAXED, __HIP_MEMORY_SCOPE_AGENT); }
__device__ __forceinline__ unsigned xb_add(unsigned* p, unsigned v) { return __hip_atomic_fetch_add(p, v, __ATOMIC_RELAXED, __HIP_MEMORY_SCOPE_AGENT); }
__device__ __forceinline__ unsigned xb_xcc_id() { return (unsigned)__builtin_amdgcn_s_getreg((3 << 11) | 20) & 0xFu; }
#define XB_SPIN(cond, bar) do { unsigned _sp = 0; while (cond) { __builtin_amdgcn_s_sleep(1); \
    if ((++_sp & 255u) == 0u) { if (xb_ld(&(bar)[XB_TMO])) break; if (_sp > XB_SPIN_CAP) { atomicAdd(&(bar)[XB_TMO], 1u); break; } } } } while (0)

struct XcdBarrier {
    unsigned* bar; unsigned x;
    volatile LAS unsigned* st;
};

__device__ __forceinline__ XcdBarrier xcd_barrier_post(unsigned* bar, volatile LAS unsigned* st) {
    XcdBarrier b; b.bar = bar; b.x = xb_xcc_id(); b.st = st;
    if (threadIdx.x == 0) (void)xb_add(&bar[XB_XCNT(b.x)], 1u);
    return b;
}
__device__ __forceinline__ void xcd_barrier_complete(unsigned* bar, unsigned x, unsigned& nloc, unsigned& nx) {
    const unsigned G = gridDim.x * gridDim.y * gridDim.z;
    unsigned sum, cnt, mine, sp = 0u;
    for (;;) {
        sum = 0u; cnt = 0u; mine = 0u;
#pragma unroll
        for (unsigned j = 0; j < 16; ++j) { const unsigned c = xb_ld(&bar[XB_XCNT(j)]); sum += c; cnt += (c > 0u) ? 1u : 0u; mine = (j == x) ? c : mine; }
        if (sum == G) break;
        __builtin_amdgcn_s_sleep(1);
        if ((++sp & 255u) == 0u) { if (xb_ld(&bar[XB_TMO])) break; if (sp > XB_SPIN_CAP) { atomicAdd(&bar[XB_TMO], 1u); break; } }
    }
    nloc = mine > 0u ? mine : 1u; nx = cnt > 0u ? cnt : 1u;
}

__device__ __forceinline__ void xcd_barrier(const XcdBarrier& b) {
    asm volatile("s_waitcnt vmcnt(0)" ::: "memory");
    __syncthreads();
    if (threadIdx.x == 0) {
        unsigned* bar = b.bar;
        __builtin_amdgcn_s_waitcnt(0);
        __builtin_amdgcn_fence(__ATOMIC_RELEASE, "agent"); asm volatile("s_waitcnt vmcnt(0)" ::: "memory");
        unsigned nloc = b.st[0], nx = b.st[1];
        if (nloc == 0u) { xcd_barrier_complete(bar, b.x, nloc, nx); b.st[0] = nloc; b.st[1] = nx; }
        const unsigned old = xb_add(&bar[XB_XSUB(b.x)], 1u);
        const unsigned gen = old / nloc;
        if (old + 1u == (gen + 1u) * nloc) {
            __builtin_amdgcn_fence(__ATOMIC_RELEASE, "agent");
            asm volatile("s_waitcnt vmcnt(0)" ::: "memory");
            const unsigned og = xb_add(&bar[XB_TOP], 1u);
            const unsigned tg = og / nx;
            if (og + 1u == (tg + 1u) * nx) xb_add(&bar[XB_TOPGEN], 1u);
            else XB_SPIN(xb_ld(&bar[XB_TOPGEN]) == tg, bar);
            __builtin_amdgcn_fence(__ATOMIC_ACQUIRE, "agent");
            xb_add(&bar[XB_XGEN(b.x)], 1u);
            asm volatile("s_waitcnt vmcnt(0)" ::: "memory");
        } else {
            XB_SPIN(xb_ld(&bar[XB_XGEN(b.x)]) == gen, bar);
            __builtin_amdgcn_fence(__ATOMIC_ACQUIRE, "agent");
            asm volatile("s_waitcnt vmcnt(0)" ::: "memory");
        }
    }
    __syncthreads();
}

__device__ __forceinline__ void mini_gemm(LAS unsigned char* lds, const bf16* A, const bf16* B0, const bf16* B1, int K, int wave, int lane, f32x4& r0, f32x4& r1) {
    const int fr = lane & 15, fq = lane >> 4;
    f32x4 a0 = (f32x4){0.f, 0.f, 0.f, 0.f}, a1 = a0;
    const bf16* ap = A + (size_t)fr * K + 8 * fq; const bf16* b0p = B0 + (size_t)fr * K + 8 * fq; const bf16* b1p = B1 + (size_t)fr * K + 8 * fq;
    for (int ks = wave; ks < K / 32; ks += 8) {
        const bf16x8 af = *(const bf16x8*)(ap + 32 * ks), b0 = *(const bf16x8*)(b0p + 32 * ks), b1 = *(const bf16x8*)(b1p + 32 * ks);
        a0 = __builtin_amdgcn_mfma_f32_16x16x32_bf16(b0, af, a0, 0, 0, 0);
        a1 = __builtin_amdgcn_mfma_f32_16x16x32_bf16(b1, af, a1, 0, 0, 0);
    }
    LAS f32x4* red = (LAS f32x4*)lds;
    red[(wave * 2 + 0) * 64 + lane] = a0; red[(wave * 2 + 1) * 64 + lane] = a1;
    __syncthreads();
    if (wave == 0) {
        r0 = red[lane]; r1 = red[64 + lane];
#pragma unroll
        for (int w = 1; w < 8; ++w) { r0 += red[(w * 2) * 64 + lane]; r1 += red[(w * 2 + 1) * 64 + lane]; }
    }
    __syncthreads();
}
__device__ __forceinline__ u32x2 pack4(const f32x4 v) { u32x2 w; w.x = pk2(v[0], v[1]); w.y = pk2(v[2], v[3]); return w; }
__device__ __forceinline__ void mini_ffn_in(LAS unsigned char* lds, const bf16* HB, const bf16* Wt, bf16* ACT, int t, int wave, int lane) {
    const int pn = t >> 3, j0 = (t & 7) * 16; f32x4 g, u;
    mini_gemm(lds, HB + (size_t)MMETA0 * D, Wt + (size_t)(256 * pn + j0) * D, Wt + (size_t)(256 * pn + 128 + j0) * D, D, wave, lane, g, u);
    if (wave == 0) { f32x4 a;
#pragma unroll
        for (int j = 0; j < 4; ++j) a[j] = pg8::silu_f(g[j]) * u[j];
        *(u32x2*)(ACT + (size_t)(MMETA0 + (lane & 15)) * FF + 16 * t + 4 * (lane >> 4)) = pack4(a); }
}
__device__ __forceinline__ void mini_resid(LAS unsigned char* lds, const bf16* A, int K, const bf16* Wt, const float* src, float* dst, const float* stats, const float* gain, const float* bias, float scale, int t, int wave, int lane) {
    f32x4 r[2];
    mini_gemm(lds, A + (size_t)MMETA0 * K, Wt + (size_t)(32 * t) * K, Wt + (size_t)(32 * t + 16) * K, K, wave, lane, r[0], r[1]);
    if (wave == 0) { const int row = lane & 15; float mean = 0.f, rstd = 1.f;
        if (stats) { mean = stats[(size_t)(MMETA0 + row) * 2]; rstd = stats[(size_t)(MMETA0 + row) * 2 + 1]; }
#pragma unroll
        for (int q = 0; q < 2; ++q) { const int col = 32 * t + 16 * q + 4 * (lane >> 4);
            const f32x4 x = *(const f32x4*)(src + (size_t)row * D + col);
            f32x4 h = x;
            if (stats) h = (x - mean) * rstd * *(const f32x4*)(gain + col) + *(const f32x4*)(bias + col);
            *(f32x4*)(dst + (size_t)row * D + col) = h * ALPHA + r[q] * scale; } }
}
__device__ __forceinline__ void mini_conv_in(LAS unsigned char* lds, const bf16* HB, const bf16* Wt, bf16* CU, bf16* BG, int t, int wave, int lane) {
    f32x4 a, b;
    if (t < 64) { const int pn = t >> 3, j0 = (t & 7) * 16;
        mini_gemm(lds, HB + (size_t)MMETA0 * D, Wt + (size_t)(256 * pn + j0) * D, Wt + (size_t)(256 * pn + 128 + j0) * D, D, wave, lane, a, b);
        if (wave == 0) *(u32x2*)(CU + (size_t)(MMETA0 + (lane & 15)) * D + 16 * t + 4 * (lane >> 4)) = pack4(a * b);
    } else { const int c0 = 16 * (t - 64);
        mini_gemm(lds, HB + (size_t)MMETA0 * D, Wt + (size_t)(2048 + c0) * D, Wt + (size_t)(2048 + c0) * D, D, wave, lane, a, b);
        if (wave == 0) *(u32x2*)(BG + (size_t)(MMETA0 + (lane & 15)) * D + c0 + 4 * (lane >> 4)) = pack4(a); }
}
__device__ __forceinline__ void mini_gla_in(LAS unsigned char* lds, const bf16* HB, const bf16* Wt, bf16* Q, bf16* Kk, bf16* V, bf16* G, float qscale, int t, int wave, int lane) {
    f32x4 r[2];
    mini_gemm(lds, HB + (size_t)MMETA0 * D, Wt + (size_t)(32 * t) * D, Wt + (size_t)(32 * t + 16) * D, D, wave, lane, r[0], r[1]);
    if (wave == 0) { const size_t row = MMETA0 + (lane & 15);
#pragma unroll
        for (int q = 0; q < 2; ++q) { const int c = 32 * t + 16 * q + 4 * (lane >> 4); f32x4 v = r[q];
            if (c < 512) *(u32x2*)(Q + row * 512 + c) = pack4(v * qscale);
            else if (c < 1024) *(u32x2*)(Kk + row * 512 + (c - 512)) = pack4(v);
            else if (c < 2048) *(u32x2*)(V + row * D + (c - 1024)) = pack4(v);
            else {
#pragma unroll
                for (int j = 0; j < 4; ++j) v[j] = pg8::silu_f(v[j]);
                *(u32x2*)(G + row * D + (c - 2048)) = pack4(v); } } }
}
__device__ __forceinline__ void gz_phase(const bf16* HB, const bf16* Wgz, float* GZ, int gw, int NGW, int lane) {
    const int fr = lane & 15, fq = lane >> 4;
    for (int rb = gw; rb < MREAL / 16 + 1; rb += NGW) {
        const size_t row0 = (size_t)rb * 16;
        const bf16* ap = HB + (row0 + fr) * D + 8 * fq; const bf16* bp = Wgz + (size_t)fr * D + 8 * fq;
        f32x4 a0 = (f32x4){0.f, 0.f, 0.f, 0.f}, a1 = a0;
#pragma unroll 4
        for (int ks = 0; ks < D / 32; ks += 2) {
            a0 = __builtin_amdgcn_mfma_f32_16x16x32_bf16(*(const bf16x8*)(bp + 32 * ks), *(const bf16x8*)(ap + 32 * ks), a0, 0, 0, 0);
            a1 = __builtin_amdgcn_mfma_f32_16x16x32_bf16(*(const bf16x8*)(bp + 32 * ks + 32), *(const bf16x8*)(ap + 32 * ks + 32), a1, 0, 0, 0);
        }
        *(f32x4*)(GZ + (row0 + fr) * 16 + 4 * fq) = a0 + a1;
    }
}


#ifndef REP_G1
#define REP_G1 1
#endif
#ifndef REV_G2
#define REV_G2 0
#endif
#ifndef REP_PM0
#define REP_PM0 0
#endif
#ifndef REP_LIGHT
#define REP_LIGHT 0
#endif
#ifndef REP_G2
#define REP_G2 0
#endif
#ifndef REP_LN
#define REP_LN 1
#endif
#ifndef REP_GLA
#define REP_GLA 1
#endif
#ifndef REP_SYNC
#define REP_SYNC 0
#endif
#ifndef REP_MIX
#define REP_MIX 1
#endif
template <class Epi>
__device__ __forceinline__ void run_gemm(LAS unsigned char* lds, const bf16* A, const bf16* Bt, int N, int K, const Epi& E, int rev = 0, int pm0 = 0) {
    pg8::Gemm g{A, Bt, MREAL, N, K}; pg8::StaticOrder S; S.init(MREAL, N, (int)gridDim.x, (int)blockIdx.x); S.rev = rev; S.pm0 = pm0;
    pg8::gemm_phase<Epi, pg8::StaticOrder, true, true>(lds, g, S, E);
}

__global__ void __launch_bounds__(512, 2) fwd_megakernel(Params p) {
    extern __shared__ __attribute__((aligned(16))) unsigned char lds_raw[];
    LAS unsigned char* lds = (LAS unsigned char*)lds_raw;
    cg::grid_group grid = cg::this_grid();
    if (threadIdx.x < 16) ((LAS unsigned*)(lds + LDS_BYTES - 64))[threadIdx.x] = 0u;
    __syncthreads();
    const XcdBarrier xbar = xcd_barrier_post((unsigned*)(p.ws + WS_BAR), (volatile LAS unsigned*)(lds + LDS_BYTES - 64));
#define GSYNC() xcd_barrier(xbar)
    grid.sync();
    const int tid0 = threadIdx.x;
#define FRESH_IDS() int tid = tid0; asm volatile("" : "+v"(tid)); const int lane = tid & 63, wave = __builtin_amdgcn_readfirstlane(tid >> 6); const int gw = vcu * 8 + wave
    const int G = gridDim.x, bx = blockIdx.x;
    const int vcu = (G % 8 == 0) ? (bx % 8) * (G / 8) + bx / 8 : bx;
    const int NGW = G * 8;
    unsigned char* ws = p.ws; unsigned char* big = ws + WS_BIG;
    bf16* HB = (bf16*)(ws + WS_HB); float* XM = (float*)(ws + WS_XM); float* METAR = (float*)(ws + WS_METAR); float* STATS = (float*)(ws + WS_STATS);
    bf16* ACT = (bf16*)(big + BIG_ACT);

#ifndef NO_P0
    { FRESH_IDS(); p0_prologue(p, lds, gw, NGW, wave, lane); }
#endif
    GSYNC();

    int lnk = 0;
#pragma clang loop unroll(disable)
    for (int blk = 0; blk < 4; ++blk) {
        {
            { FRESH_IDS(); if (bx < 176) mini_ffn_in(lds, HB, (const bf16*)(ws + WS_WFI + (size_t)blk * SZ_WFI), ACT, bx, wave, lane); }
            pg8::EpiSwiGLU E1{ACT, FF};
            for (int rep = 0; rep < REP_G1; ++rep) run_gemm(lds, HB, (const bf16*)(ws + WS_WFI + (size_t)blk * SZ_WFI), 2 * FF, D, E1);
            GSYNC();
            pg8::EpiResid E2;
            if (lnk == 0) E2 = pg8::EpiResid{p.x, METAR, p.out, XM, nullptr, nullptr, nullptr, ALPHA, 0.5f};
            else E2 = pg8::EpiResid{p.out, XM, p.out, XM, STATS, p.ln_gain + (lnk - 1) * D, p.ln_bias + (lnk - 1) * D, ALPHA, 0.5f};
            { FRESH_IDS(); if (bx >= 64 && bx < 96) mini_resid(lds, ACT, FF, (const bf16*)(ws + WS_WFO + (size_t)blk * SZ_WFO), lnk == 0 ? METAR : XM, XM, E2.stats, E2.gain, E2.bias, 0.5f, bx - 64, wave, lane); }
            for (int rep = 0; rep < REP_G2; ++rep) { pg8::EpiResid E3 = E2; E3.Oreal = (float*)(big + BIG_U); E3.light = REP_LIGHT; run_gemm(lds, ACT, (const bf16*)(ws + WS_WFO + (size_t)blk * SZ_WFO), D, FF, E3, 0, REP_PM0); }
            run_gemm(lds, ACT, (const bf16*)(ws + WS_WFO + (size_t)blk * SZ_WFO), D, FF, E2, REV_G2);
            GSYNC();
            if (blk == 3) { FRESH_IDS(); ln_phase<true>(p.out, XM, p.ln_gain + 5 * D, p.ln_bias + 5 * D, nullptr, nullptr, p.out, gw, NGW, lane); break; }
            for (int rep = 0; rep < REP_LN; ++rep) { FRESH_IDS(); ln_phase<false>(p.out, XM, p.ln_gain + lnk * D, p.ln_bias + lnk * D, HB, STATS, nullptr, gw, NGW, lane); } ++lnk;
            for (int rep = 0; rep < REP_SYNC; ++rep) GSYNC();
            GSYNC();
        }
        if (blk == 0 || blk == 2) {
            const bf16* Wo;
            if (blk == 0) {
                { FRESH_IDS(); if (bx < 128) mini_conv_in(lds, HB, (const bf16*)(ws + WS_WCI), (bf16*)(big + BIG_CU), (bf16*)(big + BIG_BG), bx, wave, lane); }
                pg8::EpiConvIn Ec{(bf16*)(big + BIG_CU), (bf16*)(big + BIG_BG)};
                run_gemm(lds, HB, (const bf16*)(ws + WS_WCI), 3072, D, Ec);
                GSYNC();
#ifndef NO_CM
                for (int rep = 0; rep < REP_MIX; ++rep) { FRESH_IDS(); conv_mix_phase((const bf16*)(big + BIG_BG), (const bf16*)(big + BIG_CU), p.conv_w, HB, gw, NGW, lane); }
#endif
                GSYNC();
                Wo = (const bf16*)(ws + WS_WCO);
            } else {
                { FRESH_IDS(); gz_phase(HB, (const bf16*)(ws + WS_WGI) + (size_t)3072 * D, (float*)(big + BIG_GZ), gw, NGW, lane);
                  if (bx >= 128 && bx < 224) mini_gla_in(lds, HB, (const bf16*)(ws + WS_WGI), (bf16*)(big + BIG_Q), (bf16*)(big + BIG_K), (bf16*)(big + BIG_V), (bf16*)(big + BIG_G), 0.08838834764831845f, bx - 128, wave, lane); }
                pg8::EpiGlaIn Eg{(bf16*)(big + BIG_Q), (bf16*)(big + BIG_K), (bf16*)(big + BIG_V), (bf16*)(big + BIG_G), (float*)(big + BIG_GZ), 0.08838834764831845f};
                run_gemm(lds, HB, (const bf16*)(ws + WS_WGI), 3072, D, Eg);
                GSYNC();
#ifndef NO_G1
                for (int rep = 0; rep < REP_GLA; ++rep) { FRESH_IDS(); gla_g1(p, lds, tid, wave, lane); }
#endif
                GSYNC();
#ifndef NO_G2
                { FRESH_IDS(); gla_g2(p, tid); }
#endif
                GSYNC();
#ifndef NO_G3
                for (int rep = 0; rep < REP_GLA; ++rep) { FRESH_IDS(); gla_g3(p, lds, tid, wave, lane); }
#endif
                GSYNC();
                Wo = (const bf16*)(ws + WS_WGO);
            }
            pg8::EpiResid Eo{p.out, XM, p.out, XM, STATS, p.ln_gain + (lnk - 1) * D, p.ln_bias + (lnk - 1) * D, ALPHA, 1.0f};
            { FRESH_IDS(); if (bx >= 32 && bx < 64) mini_resid(lds, HB, D, Wo, XM, XM, STATS, Eo.gain, Eo.bias, 1.0f, bx - 32, wave, lane); }
            run_gemm(lds, HB, Wo, D, D, Eo);
            GSYNC();
            for (int rep = 0; rep < REP_LN; ++rep) { FRESH_IDS(); ln_phase<false>(p.out, XM, p.ln_gain + lnk * D, p.ln_bias + lnk * D, HB, STATS, nullptr, gw, NGW, lane); } ++lnk;
            for (int rep = 0; rep < REP_SYNC; ++rep) GSYNC();
            GSYNC();
        }
    }
}

extern "C" void kernel_launch(void* const* d_in, const int* in_sizes, int n_in, void* d_out, int out_size, void* d_ws, size_t ws_size, hipStream_t stream) {
    static int grid_blocks = 0;
    if (grid_blocks == 0) {
        if (n_in != 14 || out_size != MREAL * D || ws_size < WS_END) { fprintf(stderr, "kernel_launch: unexpected shapes: n_in %d out %d ws %zu (need %zu)\n", n_in, out_size, ws_size, (size_t)WS_END); grid_blocks = -1; return; }
        int dev = 0, cus = 0, per_cu = 0;
        hipGetDevice(&dev); hipDeviceGetAttribute(&cus, hipDeviceAttributeMultiprocessorCount, dev);
        if (hipFuncSetAttribute((const void*)fwd_megakernel, hipFuncAttributeMaxDynamicSharedMemorySize, LDS_BYTES) != hipSuccess) { fprintf(stderr, "kernel_launch: hipFuncSetAttribute failed\n"); grid_blocks = -1; return; }
        if (hipOccupancyMaxActiveBlocksPerMultiprocessor(&per_cu, (const void*)fwd_megakernel, 512, LDS_BYTES) != hipSuccess || per_cu < 1) { fprintf(stderr, "kernel_launch: occupancy query says %d\n", per_cu); per_cu = 1; }
        (void)hipGetLastError();
        grid_blocks = cus * 1;
    }
    if (grid_blocks < 0) return;
    Params p{};
    p.x = (const float*)d_in[0]; p.meta = (const float*)d_in[1]; p.ln_gain = (const float*)d_in[2]; p.ln_bias = (const float*)d_in[3];
    p.ffn_w_in = (const float*)d_in[4]; p.ffn_w_out = (const float*)d_in[5]; p.conv_w_in = (const float*)d_in[6]; p.conv_w = (const float*)d_in[7];
    p.conv_w_out = (const float*)d_in[8]; p.gla_w_in = (const float*)d_in[9]; p.gla_w_up = (const float*)d_in[10]; p.gla_b_gate = (const float*)d_in[11];
    p.gla_norm_w = (const float*)d_in[12]; p.gla_w_out = (const float*)d_in[13]; p.out = (float*)d_out; p.ws = (unsigned char*)d_ws;
    if (hipMemsetAsync((char*)d_ws + WS_BAR, 0, WS_BAR_BYTES, stream) != hipSuccess) { fprintf(stderr, "kernel_launch: memset of barrier words failed\n"); return; }
    void* args[] = {&p};
    hipError_t e = hipLaunchCooperativeKernel((const void*)fwd_megakernel, dim3(grid_blocks), dim3(512), args, LDS_BYTES, stream);
    if (e != hipSuccess) fprintf(stderr, "cooperative launch failed: %s (grid %d)\n", hipGetErrorString(e), grid_blocks);
}
```

```cpp
#include <hip/hip_runtime.h>
#include <hip/hip_cooperative_groups.h>
#include <cstdio>
#include <cstdint>
namespace cg = cooperative_groups;

namespace pg8 {
#define PG8_LAS __attribute__((address_space(3)))
typedef unsigned short bf16_t;
typedef short bf16x8 __attribute__((ext_vector_type(8)));
typedef float f32x4 __attribute__((ext_vector_type(4)));
typedef unsigned u32x4 __attribute__((ext_vector_type(4)));
typedef unsigned u32x2 __attribute__((ext_vector_type(2)));
constexpr int BM = 256, BK = 64, HALF = 128, HTB = HALF * BK * 2  , STAGE_BYTES = 8 * HTB, NXCD = 8, WGM = 8;

__host__ __device__ __forceinline__ int lds_byte(int r, int c) { const int st = (r >> 4) * 2 + (c >> 5), rr = r & 15, cc = c & 31, ob = rr * 64 + cc * 2; return st * 1024 + (ob ^ (((ob >> 9) & 1) << 5)); }
__host__ __device__ __forceinline__ void stage_rc(int b, int& R, int& C) { const int st = b / 1024, sb = b % 1024, swz = sb ^ (((sb >> 9) & 1) << 5); R = (st >> 1) * 16 + swz / 64; C = (st & 1) * 32 + (swz % 64) / 2; }
__host__ __device__ __forceinline__ int perm32(int rho) { const int n = rho >> 4, i = rho & 15; return 8 * (i >> 2) + 4 * n + (i & 3); }

struct Unit { int pm, pn; };
struct Gemm { const bf16_t* A; const bf16_t* Bt; int M, N, K; };

struct StaticOrder {
    int nM, nN, nwg, G, c;
    __host__ __device__ void init(int M, int N, int G_, int c_) { nM = M / BM; nN = N / BM; nwg = nM * nN; G = G_; c = c_; }
    __host__ __device__ bool next(int i, Unit& u) const {
        const long L = (long)i * G + c; if (L >= nwg) return false;
        int wgid = (int)L; { const int q = nwg / NXCD, r = nwg % NXCD, xcd = wgid % NXCD, off = wgid / NXCD; wgid = (xcd < r ? xcd * (q + 1) : r * (q + 1) + (xcd - r) * q) + off; }
        const int nig = WGM * nN, gid = wgid / nig, fm = gid * WGM, gsz = (nM - fm) < WGM ? (nM - fm) : WGM;
        u.pm = fm + ((wgid % nig) % gsz); u.pn = (wgid % nig) / gsz; return true;
    }
    __device__ __forceinline__ void a_ready(const Unit&) const {}
    __device__ __forceinline__ void done(const Unit&) const {}
};

__device__ __forceinline__ unsigned cvt_pk_bf16(float lo, float hi) { unsigned r; asm volatile("v_cvt_pk_bf16_f32 %0, %1, %2" : "=v"(r) : "v"(lo), "v"(hi)); return r; }
__device__ __forceinline__ float silu_f(float x) { return x * __builtin_amdgcn_rcpf(1.0f + __builtin_amdgcn_exp2f(-1.44269504089f * x)); }
__device__ __forceinline__ u32x4 pack8(const f32x4 a, const f32x4 b) { u32x4 w; w.x = cvt_pk_bf16(a[0], a[1]); w.y = cvt_pk_bf16(a[2], a[3]); w.z = cvt_pk_bf16(b[0], b[1]); w.w = cvt_pk_bf16(b[2], b[3]); return w; }
__device__ __forceinline__ void wt16(void* p, u32x4 v) { asm volatile("global_store_dwordx4 %0, %1, off sc1\n\ts_nop 1" :: "v"(p), "v"(v)); }
__device__ __forceinline__ void wt16(void* p, f32x4 v) { asm volatile("global_store_dwordx4 %0, %1, off sc1\n\ts_nop 1" :: "v"(p), "v"(v)); }
__device__ __forceinline__ void wt8(void* p, unsigned long long v) { __hip_atomic_store((unsigned long long*)p, v, __ATOMIC_RELAXED, __HIP_MEMORY_SCOPE_AGENT); }
__device__ __forceinline__ void wt8(void* p, u32x2 v) { wt8(p, (unsigned long long)v.x | ((unsigned long long)v.y << 32)); }
__device__ __forceinline__ void wt4(float* p, float v) { __hip_atomic_store(p, v, __ATOMIC_RELAXED, __HIP_MEMORY_SCOPE_AGENT); }

constexpr int MROWS_REAL = 32768;

struct EpiSwiGLU {
    static constexpr bool PERM = true, AFTER_DRAIN = false;
    bf16_t* O; int ldc;
    __device__ __forceinline__ void operator()(const f32x4 (&acc)[2][2][4][2], const Unit& u, int wr, int wc, int fr, int fq) const {
        const int row0 = u.pm * BM + wr * 64 + fr, col0 = u.pn * HALF + wc * 32 + 8 * fq;
#pragma unroll
        for (int ai = 0; ai < 2; ++ai)
#pragma unroll
            for (int m = 0; m < 4; ++m) {
                bf16_t* rowp = O + (size_t)(row0 + ai * HALF + m * 16) * ldc + col0;
                f32x4 a0, a1;
#pragma unroll
                for (int j = 0; j < 4; ++j) { a0[j] = silu_f(acc[ai][0][m][0][j]) * acc[ai][1][m][0][j]; a1[j] = silu_f(acc[ai][0][m][1][j]) * acc[ai][1][m][1][j]; }
                wt16(rowp, pack8(a0, a1));
            }
    }
};

struct EpiResid {
    static constexpr bool PERM = false, AFTER_DRAIN = false;
    const float* Rreal; const float* Rmeta; float* Oreal; float* Ometa; const float* stats; const float* gain; const float* bias; float alpha, scale;
    __device__ __forceinline__ void operator()(const f32x4 (&acc)[2][2][4][2], const Unit& u, int wr, int wc, int fr, int fq) const {
        const float* src = Rreal + (size_t)u.pm * BM * 1024;
        float* dst = Oreal + (size_t)u.pm * BM * 1024;
        const int r0 = wr * 64 + fr, col0 = u.pn * BM + wc * 32 + 4 * fq;
        float mean[2][4], rstd[2][4];
#pragma unroll
        for (int ai = 0; ai < 2; ++ai)
#pragma unroll
            for (int m = 0; m < 4; ++m) {
                mean[ai][m] = 0.f; rstd[ai][m] = 1.f;
                if (stats) { const float2 s = *(const float2*)(stats + (size_t)(u.pm * BM + r0 + ai * HALF + m * 16) * 2); mean[ai][m] = s.x; rstd[ai][m] = s.y; }
            }
#pragma unroll
        for (int bj = 0; bj < 2; ++bj)
#pragma unroll
            for (int n = 0; n < 2; ++n) {
                const int c = col0 + bj * HALF + n * 16;
                f32x4 gv = (f32x4){1.f, 1.f, 1.f, 1.f}, bv = (f32x4){0.f, 0.f, 0.f, 0.f};
                if (stats) { gv = *(const f32x4*)(gain + c); bv = *(const f32x4*)(bias + c); }
#pragma unroll
                for (int ai = 0; ai < 2; ++ai)
#pragma unroll
                    for (int m = 0; m < 4; ++m) {
                        const size_t off = (size_t)(r0 + ai * HALF + m * 16) * 1024 + c;
                        const f32x4 x = *(const f32x4*)(src + off);
                        const f32x4 h = (x - mean[ai][m]) * rstd[ai][m] * gv + bv;
                        wt16(dst + off, h * alpha + acc[ai][bj][m][n] * scale);
                    }
                asm volatile("" ::: "memory");
            }
    }
};

struct EpiConvIn {
    static constexpr bool PERM = true, AFTER_DRAIN = false;
    bf16_t* CU; bf16_t* BG;
    __device__ __forceinline__ void operator()(const f32x4 (&acc)[2][2][4][2], const Unit& u, int wr, int wc, int fr, int fq) const {
        const int row0 = u.pm * BM + wr * 64 + fr;
        if (u.pn < 8) {
            const int col0 = u.pn * HALF + wc * 32 + 8 * fq;
#pragma unroll
            for (int ai = 0; ai < 2; ++ai)
#pragma unroll
                for (int m = 0; m < 4; ++m) {
                    bf16_t* rowp = CU + (size_t)(row0 + ai * HALF + m * 16) * 1024 + col0;
                    wt16(rowp, pack8(acc[ai][0][m][0] * acc[ai][1][m][0], acc[ai][0][m][1] * acc[ai][1][m][1]));
                }
        } else {
            const int col0 = (u.pn - 8) * BM + wc * 32 + 8 * fq;
#pragma unroll
            for (int ai = 0; ai < 2; ++ai)
#pragma unroll
                for (int m = 0; m < 4; ++m) {
                    bf16_t* rowp = BG + (size_t)(row0 + ai * HALF + m * 16) * 1024 + col0;
#pragma unroll
                    for (int bj = 0; bj < 2; ++bj) wt16(rowp + bj * HALF, pack8(acc[ai][bj][m][0], acc[ai][bj][m][1]));
                }
        }
    }
};

struct EpiGlaIn {
    static constexpr bool PERM = true, AFTER_DRAIN = false;
    bf16_t* Q; bf16_t* Kk; bf16_t* V; bf16_t* G; float* GZ; float qscale;
    __device__ __forceinline__ void operator()(const f32x4 (&acc)[2][2][4][2], const Unit& u, int wr, int wc, int fr, int fq) const {
        const int row0 = u.pm * BM + wr * 64 + fr;
        bf16_t* base; int ld, colt; float sc = 1.f; bool act = false;
        if (u.pn < 2) { base = Q; ld = 512; colt = u.pn * BM; sc = qscale; }
        else if (u.pn < 4) { base = Kk; ld = 512; colt = (u.pn - 2) * BM; }
        else if (u.pn < 8) { base = V; ld = 1024; colt = (u.pn - 4) * BM; }
        else { base = G; ld = 1024; colt = (u.pn - 8) * BM; act = true; }
        const int col0 = colt + wc * 32 + 8 * fq;
#pragma unroll
        for (int ai = 0; ai < 2; ++ai)
#pragma unroll
            for (int m = 0; m < 4; ++m) {
                bf16_t* rowp = base + (size_t)(row0 + ai * HALF + m * 16) * ld + col0;
#pragma unroll
                for (int bj = 0; bj < 2; ++bj) {
                    f32x4 v0 = acc[ai][bj][m][0] * sc, v1 = acc[ai][bj][m][1] * sc;
                    if (act) {
#pragma unroll
                        for (int j = 0; j < 4; ++j) { v0[j] = silu_f(v0[j]); v1[j] = silu_f(v1[j]); }
                    }
                    wt16(rowp + bj * HALF, pack8(v0, v1));
                }
            }
    }
};

template <class Epi, class Sched, bool ALIGN_EPI = false, bool SP2 = false>
__device__ __forceinline__ void gemm_phase(PG8_LAS unsigned char* lds, const Gemm g, const Sched& S, const Epi& E) {
    int tid_ = threadIdx.x; asm volatile("" : "+v"(tid_));
    const int tid = tid_, wid = __builtin_amdgcn_readfirstlane(tid >> 6), lane = tid & 63, wr = wid >> 2, wc = wid & 3, fr = lane & 15, fq = lane >> 4;
    const int K = g.K, nt = K / BK;
    unsigned voffA[2], voffB[2];
#pragma unroll
    for (int i = 0; i < 2; ++i) { int R, C; stage_rc(tid * 16 + i * 8192, R, C); const int Rb = Epi::PERM ? ((R & ~31) + perm32(R & 31)) : R;
        voffA[i] = (unsigned)(R * K + C) * 2u; voffB[i] = (unsigned)(Rb * K + C) * 2u; }
    const size_t kstep = (size_t)(BK * 2);
    const size_t hstep = (size_t)HALF * K * 2;
    const size_t tstep = 2 * hstep;
    const unsigned ldsw = (unsigned)wid * 1024u;
    const int aoff = lds_byte(wr * 64 + fr, fq * 8), boff = lds_byte(wc * 32 + fr, fq * 8);
#define PG8_SA(b, h) (((b) * 2 + (h)) * HTB)
#define PG8_SB(b, h) ((4 + (b) * 2 + (h)) * HTB)
#define PG8_STAGE(bufoff, gbase, voff) do { _Pragma("unroll") for (int _i = 0; _i < 2; ++_i) \
        __builtin_amdgcn_global_load_lds((const unsigned*)((const char*)(gbase) + (voff)[_i]), (PG8_LAS unsigned*)(lds + (bufoff) + ldsw + _i * 8192), 16, 0, 0); } while (0)
#define PG8_LDA(dst, b, h) do { _Pragma("unroll") for (int m = 0; m < 4; ++m) _Pragma("unroll") for (int k = 0; k < 2; ++k) dst[m][k] = *(const PG8_LAS bf16x8*)(lds + PG8_SA(b, h) + aoff + m * 2048 + k * 1024); } while (0)
#define PG8_LDB(dst, b, h) do { _Pragma("unroll") for (int n = 0; n < 2; ++n) _Pragma("unroll") for (int k = 0; k < 2; ++k) dst[n][k] = *(const PG8_LAS bf16x8*)(lds + PG8_SB(b, h) + boff + n * 2048 + k * 1024); } while (0)
#define PG8_MMA(ai, bj, At, Bt) do { __builtin_amdgcn_s_setprio(1); _Pragma("unroll") for (int m = 0; m < 4; ++m) _Pragma("unroll") for (int n = 0; n < 2; ++n) _Pragma("unroll") for (int k = 0; k < 2; ++k) \
        acc[ai][bj][m][n] = __builtin_amdgcn_mfma_f32_16x16x32_bf16(Bt[n][k], At[m][k], acc[ai][bj][m][n], 0, 0, 0); __builtin_amdgcn_s_setprio(0); } while (0)
#define PG8_WAIT_V(n) asm volatile("s_waitcnt vmcnt(" #n ")" ::: "memory")
#define PG8_WAIT_L(n) asm volatile("s_waitcnt lgkmcnt(" #n ")" ::: "memory")
#define PG8_BAR __builtin_amdgcn_s_barrier()
#define PG8_SCHED __builtin_amdgcn_sched_barrier(0)
    Unit cur, nxt; int ui = 0;
    if (!S.next(0, cur)) return;
    f32x4 acc[2][2][4][2];
#pragma unroll
    for (int a = 0; a < 2; ++a)
#pragma unroll
        for (int b = 0; b < 2; ++b)
#pragma unroll
            for (int m = 0; m < 4; ++m)
#pragma unroll
                for (int n = 0; n < 2; ++n) acc[a][b][m][n] = (f32x4){0.f, 0.f, 0.f, 0.f};
    bf16x8 At[4][2], B0[2][2], B1[2][2];
    const char* cA = (const char*)g.A + (size_t)cur.pm * tstep; const char* cB = (const char*)g.Bt + (size_t)cur.pn * tstep;
    S.a_ready(cur);
    if constexpr (SP2) {
        PG8_STAGE(PG8_SB(0, 0), cB, voffB); PG8_STAGE(PG8_SB(0, 1), cB + hstep, voffB); PG8_STAGE(PG8_SA(0, 0), cA, voffA); PG8_STAGE(PG8_SA(0, 1), cA + hstep, voffA);
        if (wr == 1) PG8_BAR;
        PG8_WAIT_V(2); PG8_BAR;
        PG8_STAGE(PG8_SB(1, 0), cB + kstep, voffB); PG8_STAGE(PG8_SA(1, 0), cA + kstep, voffA); PG8_STAGE(PG8_SB(1, 1), cB + hstep + kstep, voffB);
        PG8_WAIT_V(6); PG8_BAR;
    } else {
        PG8_STAGE(PG8_SB(0, 0), cB, voffB); PG8_STAGE(PG8_SA(0, 0), cA, voffA); PG8_STAGE(PG8_SB(0, 1), cB + hstep, voffB); PG8_STAGE(PG8_SA(0, 1), cA + hstep, voffA);
        if (wr == 1) PG8_BAR;
        PG8_WAIT_V(4); PG8_BAR;
        PG8_STAGE(PG8_SB(1, 0), cB + kstep, voffB); PG8_STAGE(PG8_SA(1, 0), cA + kstep, voffA); PG8_STAGE(PG8_SB(1, 1), cB + hstep + kstep, voffB);
        PG8_WAIT_V(6); PG8_BAR;
    }
    for (;;) {
        const bool has_next = S.next(ui + 1, nxt);
        const char* nA = has_next ? (const char*)g.A + (size_t)nxt.pm * tstep : cA; const char* nB = has_next ? (const char*)g.Bt + (size_t)nxt.pn * tstep : cB;
        for (int t = 0; t < nt; t += 2) {
            const bool last = (t == nt - 2);
            const char* a1 = cA + (size_t)(t + 1) * kstep;
            const char* a2 = last ? nA : cA + (size_t)(t + 2) * kstep; const char* b2 = last ? nB : cB + (size_t)(t + 2) * kstep;
            const char* a3 = a2 + kstep; const char* b3 = b2 + kstep;
            if (last && has_next) S.a_ready(nxt);
            if constexpr (SP2) {
            PG8_LDB(B0, 0, 0); PG8_LDB(B1, 0, 1); PG8_SCHED; PG8_LDA(At, 0, 0); PG8_STAGE(PG8_SA(1, 1), a1 + hstep, voffA);
            PG8_WAIT_V(8); PG8_WAIT_L(0); PG8_BAR; PG8_MMA(0, 0, At, B0); PG8_MMA(0, 1, At, B1); PG8_BAR; PG8_SCHED;
            PG8_LDA(At, 0, 1); PG8_STAGE(PG8_SB(0, 0), b2, voffB); PG8_STAGE(PG8_SB(0, 1), b2 + hstep, voffB); PG8_STAGE(PG8_SA(0, 0), a2, voffA);
            PG8_WAIT_V(8); PG8_WAIT_L(0); PG8_BAR; PG8_MMA(1, 0, At, B0); PG8_MMA(1, 1, At, B1); PG8_BAR; PG8_SCHED;
            PG8_LDB(B0, 1, 0); PG8_LDB(B1, 1, 1); PG8_SCHED; PG8_LDA(At, 1, 0); PG8_STAGE(PG8_SA(0, 1), a2 + hstep, voffA);
            PG8_WAIT_V(8); PG8_WAIT_L(0); PG8_BAR; PG8_MMA(0, 0, At, B0); PG8_MMA(0, 1, At, B1); PG8_BAR; PG8_SCHED;
            PG8_LDA(At, 1, 1); PG8_STAGE(PG8_SB(1, 0), b3, voffB); PG8_STAGE(PG8_SB(1, 1), b3 + hstep, voffB); PG8_STAGE(PG8_SA(1, 0), a3, voffA);
            PG8_WAIT_V(8); PG8_WAIT_L(0); PG8_BAR; PG8_MMA(1, 0, At, B0); PG8_MMA(1, 1, At, B1); PG8_BAR; PG8_SCHED;
            } else {
            PG8_LDB(B0, 0, 0); PG8_SCHED; PG8_LDA(At, 0, 0); PG8_STAGE(PG8_SA(1, 1), a1 + hstep, voffA);
            PG8_WAIT_L(8); PG8_BAR; PG8_WAIT_L(0); PG8_MMA(0, 0, At, B0); PG8_BAR; PG8_SCHED;
            PG8_LDB(B1, 0, 1); PG8_STAGE(PG8_SB(0, 0), b2, voffB);
            PG8_BAR; PG8_WAIT_L(0); PG8_MMA(0, 1, At, B1); PG8_BAR;
            PG8_LDA(At, 0, 1); PG8_STAGE(PG8_SA(0, 0), a2, voffA);
            PG8_BAR; PG8_WAIT_L(0); PG8_MMA(1, 0, At, B0); PG8_BAR; PG8_SCHED;
            PG8_STAGE(PG8_SB(0, 1), b2 + hstep, voffB);
            PG8_WAIT_V(6); PG8_BAR; PG8_MMA(1, 1, At, B1); PG8_BAR;
            PG8_LDB(B0, 1, 0); PG8_SCHED; PG8_LDA(At, 1, 0); PG8_STAGE(PG8_SA(0, 1), a2 + hstep, voffA);
            PG8_WAIT_L(8); PG8_BAR; PG8_WAIT_L(0); PG8_MMA(0, 0, At, B0); PG8_BAR; PG8_SCHED;
            PG8_LDB(B1, 1, 1); PG8_STAGE(PG8_SB(1, 0), b3, voffB);
            PG8_BAR; PG8_WAIT_L(0); PG8_MMA(0, 1, At, B1); PG8_BAR;
            PG8_LDA(At, 1, 1); PG8_STAGE(PG8_SA(1, 0), a3, voffA);
            PG8_BAR; PG8_WAIT_L(0); PG8_MMA(1, 0, At, B0); PG8_BAR; PG8_SCHED;
            PG8_STAGE(PG8_SB(1, 1), b3 + hstep, voffB);
            PG8_WAIT_V(6); PG8_BAR; PG8_MMA(1, 1, At, B1); PG8_BAR;
            }
        }
        if constexpr (ALIGN_EPI) { if (wr == 0) PG8_BAR; }
        if constexpr (!Epi::AFTER_DRAIN) { E(acc, cur, wr, wc, fr, fq); S.done(cur); }
        if (!has_next) break;
#pragma unroll
        for (int a = 0; a < 2; ++a)
#pragma unroll
            for (int b = 0; b < 2; ++b)
#pragma unroll
                for (int m = 0; m < 4; ++m)
#pragma unroll
                    for (int n = 0; n < 2; ++n) acc[a][b][m][n] = (f32x4){0.f, 0.f, 0.f, 0.f};
        cur = nxt; cA = nA; cB = nB; ++ui;
        if constexpr (ALIGN_EPI) { if (wr == 1) PG8_BAR; }
    }
    PG8_WAIT_V(0);
    if constexpr (!ALIGN_EPI) { if (wr == 0) PG8_BAR; }
    PG8_BAR;
    if constexpr (Epi::AFTER_DRAIN) { E.fused(acc, cur, wr, wc, fr, fq, lds, wid, lane); S.done(cur); }
#undef PG8_SA
#undef PG8_SB
#undef PG8_STAGE
#undef PG8_LDA
#undef PG8_LDB
#undef PG8_MMA
#undef PG8_WAIT_V
#undef PG8_WAIT_L
#undef PG8_BAR
#undef PG8_SCHED
}
}

#define LAS __attribute__((address_space(3)))
typedef unsigned short bf16;
typedef float f32x4 __attribute__((ext_vector_type(4)));
typedef short bf16x8 __attribute__((ext_vector_type(8)));
typedef short s16x4 __attribute__((ext_vector_type(4)));
typedef unsigned u32x4 __attribute__((ext_vector_type(4)));
typedef unsigned u32x2 __attribute__((ext_vector_type(2)));

constexpr int D = 1024, FF = 2816, SEQ = 8192, NB = 4, NMETA = 16;
constexpr int MREAL = NB * SEQ;
constexpr int MMETA0 = MREAL;
constexpr int MPAD = MREAL + 256;
constexpr int NCH = 129;
constexpr int GLA_NIN = 3328;
constexpr float LN_EPS = 1e-5f, RMS_EPS = 1e-6f;
constexpr float ALPHA = 1.41421356237f;

constexpr size_t al256(size_t x) { return (x + 255) & ~(size_t)255; }
constexpr size_t SZ_WFI = (size_t)2 * FF * D * 2, SZ_WFO = (size_t)D * FF * 2;
constexpr size_t WS_WFI = 0;
constexpr size_t WS_WFO = WS_WFI + 4 * SZ_WFI;
constexpr size_t WS_WCI = WS_WFO + 4 * SZ_WFO;
constexpr size_t WS_WCO = WS_WCI + (size_t)3072 * D * 2;
constexpr size_t WS_WGI = WS_WCO + (size_t)D * D * 2;
constexpr size_t WS_WGO = WS_WGI + (size_t)GLA_NIN * D * 2;
constexpr size_t WS_HB = WS_WGO + (size_t)D * D * 2;
constexpr size_t WS_XM = WS_HB + (size_t)MPAD * D * 2;
constexpr size_t WS_METAR = WS_XM + (size_t)256 * D * 4;
constexpr size_t WS_STATS = WS_METAR + (size_t)256 * D * 4;
constexpr size_t WS_BIG = al256(WS_STATS + (size_t)MPAD * 8);
constexpr size_t SZ_ROWBF = (size_t)MPAD * D * 2;
constexpr size_t BIG_ACT = 0;
constexpr size_t BIG_BG = 0, BIG_CU = SZ_ROWBF;
constexpr size_t BIG_Q = 0, BIG_K = SZ_ROWBF / 2, BIG_V = SZ_ROWBF, BIG_G = 2 * SZ_ROWBF, BIG_GZ = 3 * SZ_ROWBF;
constexpr size_t BIG_U = al256(BIG_GZ + (size_t)MPAD * 16 * 4);
constexpr size_t BIG_DEC = BIG_U + (size_t)NCH * 16 * 32768 * 2;
constexpr size_t BIG_END = BIG_DEC + (size_t)NCH * 16 * 128 * 4;
constexpr size_t WS_BAR = al256(WS_BIG + BIG_END);
constexpr size_t WS_BAR_BYTES = 16384;
constexpr size_t WS_END = WS_BAR + WS_BAR_BYTES;
static_assert((size_t)MPAD * FF * 2 <= BIG_END, "act fits");

constexpr int LDS_BYTES = 147456;

struct Params {
    const float* x; const float* meta; const float* ln_gain; const float* ln_bias; const float* ffn_w_in; const float* ffn_w_out;
    const float* conv_w_in; const float* conv_w; const float* conv_w_out; const float* gla_w_in; const float* gla_w_up; const float* gla_b_gate;
    const float* gla_norm_w; const float* gla_w_out; float* out; unsigned char* ws;
};

__device__ __forceinline__ unsigned f2bf(float f) { unsigned u = __builtin_bit_cast(unsigned, f); return (u + 0x7fffu + ((u >> 16) & 1u)) >> 16; }
__device__ __forceinline__ unsigned pk2(float lo, float hi) { return pg8::cvt_pk_bf16(lo, hi); }
__device__ __forceinline__ float bf_lo(unsigned w) { return __builtin_bit_cast(float, w << 16); }
__device__ __forceinline__ float bf_hi(unsigned w) { return __builtin_bit_cast(float, w & 0xffff0000u); }
__device__ __forceinline__ float wave_sum(float v) {
#pragma unroll
    for (int o = 1; o < 64; o <<= 1) v += __shfl_xor(v, o);
    return v;
}
#define LDS_WAIT() asm volatile("s_waitcnt lgkmcnt(0)" ::: "memory")

__device__ __forceinline__ void p0_transpose_item(const float* W, int K, int ldw, int scol, int nvalid, bf16* WT, int n0d, int k0, LAS float* scr, int lane) {
    float tv[32];
#pragma unroll
    for (int i = 0; i < 32; ++i) { const int kk = 2 * i + (lane >> 5), j = lane & 31; tv[i] = (j < nvalid) ? W[(size_t)(k0 + kk) * ldw + scol + j] : 0.f; }
#pragma unroll
    for (int i = 0; i < 32; ++i) { const int kk = 2 * i + (lane >> 5), j = lane & 31; scr[kk * 33 + j] = tv[i]; }
    LDS_WAIT(); asm volatile("" ::: "memory");
    const int c = lane & 7;
#pragma unroll
    for (int jj = 0; jj < 4; ++jj) { const int n = (lane >> 3) + 8 * jj; const LAS float* s = scr + (8 * c) * 33 + n;
        u32x4 o; o.x = pk2(s[0 * 33], s[1 * 33]); o.y = pk2(s[2 * 33], s[3 * 33]); o.z = pk2(s[4 * 33], s[5 * 33]); o.w = pk2(s[6 * 33], s[7 * 33]);
        pg8::wt16(WT + (size_t)(n0d + n) * K + k0 + 8 * c, o); }
    LDS_WAIT(); asm volatile("" ::: "memory");
}
__device__ __forceinline__ void p0_matrix(const float* W, int K, int Nsrc, int Ndst, int mode, bf16* WT, LAS float* scr, int lane, int item) {
    const int nblk = Ndst / 32, kb = item / nblk, nb = item % nblk, n0d = nb * 32, k0 = kb * 64;
    int scol = n0d, nvalid = 32;
    if (mode == 1) { const int pn = n0d >> 8, j = n0d & 255; scol = (j < 128) ? 128 * pn + j : FF + 128 * pn + (j - 128); }
    else if (mode == 2) { const int pn = n0d >> 8, j = n0d & 255; scol = (pn < 8) ? ((j < 128) ? 1024 + 128 * pn + j : 2048 + 128 * pn + (j - 128)) : 256 * (pn - 8) + j; }
    else if (mode == 3) { nvalid = Nsrc - n0d; nvalid = nvalid < 0 ? 0 : (nvalid > 32 ? 32 : nvalid); if (nvalid == 0) scol = 0; }
    p0_transpose_item(W, K, Nsrc, scol, nvalid, WT, n0d, k0, scr, lane);
}
__device__ __forceinline__ void p0_prologue(const Params& p, LAS unsigned char* lds, int gw, int NGW, int wave, int lane) {
    LAS float* scr = (LAS float*)(lds + wave * 16384);
    unsigned char* ws = p.ws;
    constexpr int I_FI = (D / 64) * (2 * FF / 32), I_FO = (FF / 64) * (D / 32), I_CI = (D / 64) * (3072 / 32), I_SQ = (D / 64) * (D / 32), I_GI = (D / 64) * (GLA_NIN / 32);
    constexpr int NITEMS = 4 * I_FI + 4 * I_FO + I_CI + I_SQ + I_GI + I_SQ;
    for (int it = gw; it < NITEMS; it += NGW) {
        int r = it;
        if (r < 4 * I_FI) { const int l = r / I_FI; p0_matrix(p.ffn_w_in + (size_t)l * D * 2 * FF, D, 2 * FF, 2 * FF, 1, (bf16*)(ws + WS_WFI + l * SZ_WFI), scr, lane, r % I_FI); continue; } r -= 4 * I_FI;
        if (r < 4 * I_FO) { const int l = r / I_FO; p0_matrix(p.ffn_w_out + (size_t)l * FF * D, FF, D, D, 0, (bf16*)(ws + WS_WFO + l * SZ_WFO), scr, lane, r % I_FO); continue; } r -= 4 * I_FO;
        if (r < I_CI) { p0_matrix(p.conv_w_in, D, 3072, 3072, 2, (bf16*)(ws + WS_WCI), scr, lane, r); continue; } r -= I_CI;
        if (r < I_SQ) { p0_matrix(p.conv_w_out, D, D, D, 0, (bf16*)(ws + WS_WCO), scr, lane, r); continue; } r -= I_SQ;
        if (r < I_GI) { p0_matrix(p.gla_w_in, D, 3088, GLA_NIN, 3, (bf16*)(ws + WS_WGI), scr, lane, r); continue; } r -= I_GI;
        p0_matrix(p.gla_w_out, D, D, D, 0, (bf16*)(ws + WS_WGO), scr, lane, r);
    }
    bf16* HB = (bf16*)(ws + WS_HB); float* METAR = (float*)(ws + WS_METAR);
    for (int m0 = gw; m0 < MREAL + NMETA; m0 += 4 * NGW) {
        f32x4 v[4][4];
#pragma unroll
        for (int r = 0; r < 4; ++r) { const int m = m0 + r * NGW;
            if (m < MREAL + NMETA) { const float* src = (m < MREAL) ? p.x + (size_t)m * D : p.meta + (size_t)(m - MREAL) * D;
#pragma unroll
                for (int j = 0; j < 4; ++j) v[r][j] = ((const f32x4*)src)[lane + 64 * j]; } }
#pragma unroll
        for (int r = 0; r < 4; ++r) { const int m = m0 + r * NGW;
            if (m < MREAL + NMETA) {
                unsigned long long* o8 = (unsigned long long*)(HB + (size_t)m * D) + lane;
#pragma unroll
                for (int j = 0; j < 4; ++j) {
                    pg8::wt8(o8 + 64 * j, (unsigned long long)pk2(v[r][j][0], v[r][j][1]) | ((unsigned long long)pk2(v[r][j][2], v[r][j][3]) << 32));
                    if (m >= MREAL) pg8::wt16((f32x4*)(METAR + (size_t)(m - MREAL) * D) + lane + 64 * j, v[r][j]);
                } } }
    }
}

template <bool FINAL>
__device__ __forceinline__ void ln_phase(const float* Zreal, const float* Zmeta, const float* gain, const float* bias, bf16* HB, float* stats, float* out, int gw, int NGW, int lane) {
    f32x4 g[4], bb[4];
#pragma unroll
    for (int j = 0; j < 4; ++j) { g[j] = ((const f32x4*)gain)[lane + 64 * j]; bb[j] = ((const f32x4*)bias)[lane + 64 * j]; }
    const int nrows = FINAL ? MREAL : MREAL + NMETA;
    for (int m0 = gw; m0 < nrows; m0 += 4 * NGW) {
        f32x4 v[4][4];
#pragma unroll
        for (int r = 0; r < 4; ++r) { const int m = m0 + r * NGW;
            if (m < nrows) { const float* zr = (m < MREAL) ? Zreal + (size_t)m * D : Zmeta + (size_t)(m - MREAL) * D;
#pragma unroll
                for (int j = 0; j < 4; ++j) v[r][j] = ((const f32x4*)zr)[lane + 64 * j]; }
            else {
#pragma unroll
                for (int j = 0; j < 4; ++j) v[r][j] = (f32x4){0.f, 0.f, 0.f, 0.f}; } }
#pragma unroll
        for (int r = 0; r < 4; ++r) { const int m = m0 + r * NGW;
            float s = 0.f;
#pragma unroll
            for (int j = 0; j < 4; ++j) s += (v[r][j][0] + v[r][j][1]) + (v[r][j][2] + v[r][j][3]);
            const float mean = wave_sum(s) * (1.f / D); float s2 = 0.f;
#pragma unroll
            for (int j = 0; j < 4; ++j) { const f32x4 d = v[r][j] - mean; s2 += (d[0] * d[0] + d[1] * d[1]) + (d[2] * d[2] + d[3] * d[3]); }
            const float rstd = 1.0f / sqrtf(wave_sum(s2) * (1.f / D) + LN_EPS);
            if (m < nrows) {
                if (FINAL) {
#pragma unroll
                    for (int j = 0; j < 4; ++j) ((f32x4*)(out + (size_t)m * D))[lane + 64 * j] = (v[r][j] - mean) * rstd * g[j] + bb[j];
                } else {
                    if (lane == 0) { pg8::wt4(stats + (size_t)m * 2, mean); pg8::wt4(stats + (size_t)m * 2 + 1, rstd); }
                    unsigned long long* o8 = (unsigned long long*)(HB + (size_t)m * D) + lane;
#pragma unroll
                    for (int j = 0; j < 4; ++j) { const f32x4 y = (v[r][j] - mean) * rstd * g[j] + bb[j]; pg8::wt8(o8 + 64 * j, (unsigned long long)pk2(y[0], y[1]) | ((unsigned long long)pk2(y[2], y[3]) << 32)); }
                }
            }
        }
    }
}

__device__ __forceinline__ int conv_pred(int m, int k) {
    if (m < MREAL) { const int t = m & (SEQ - 1); return (t >= k) ? m - k : MMETA0 + (NMETA + t - k); }
    const int j = m - MMETA0; return (j >= k) ? m - k : -1;
}
__device__ __forceinline__ void conv_mix_phase(const bf16* BG, const bf16* CU, const float* cw, bf16* VO, int gw, int NGW, int lane) {
    const int nrows = MREAL + NMETA;
    const u32x4 z4 = (u32x4){0u, 0u, 0u, 0u};
    float wt[3][16];
#pragma unroll
    for (int k = 0; k < 3; ++k)
#pragma unroll
        for (int j = 0; j < 2; ++j)
#pragma unroll
            for (int q = 0; q < 2; ++q) { const f32x4 t = *(const f32x4*)(cw + k * D + 8 * (lane + 64 * j) + 4 * q);
                wt[k][8 * j + 4 * q] = t[0]; wt[k][8 * j + 4 * q + 1] = t[1]; wt[k][8 * j + 4 * q + 2] = t[2]; wt[k][8 * j + 4 * q + 3] = t[3]; }
    for (int m0 = gw; m0 < nrows; m0 += 2 * NGW) {
        u32x4 b4[2][2], x0[2][2], x1[2][2], x2[2][2];
#pragma unroll
        for (int r = 0; r < 2; ++r) { const int m = m0 + r * NGW; const bool ok = m < nrows;
            const int p1 = ok ? conv_pred(m, 1) : -1, p2 = ok ? conv_pred(m, 2) : -1;
#pragma unroll
            for (int j = 0; j < 2; ++j) { const int c0 = 8 * (lane + 64 * j);
                b4[r][j] = ok ? *(const u32x4*)(BG + (size_t)m * D + c0) : z4; x0[r][j] = ok ? *(const u32x4*)(CU + (size_t)m * D + c0) : z4;
                x1[r][j] = (p1 >= 0) ? *(const u32x4*)(CU + (size_t)p1 * D + c0) : z4; x2[r][j] = (p2 >= 0) ? *(const u32x4*)(CU + (size_t)p2 * D + c0) : z4; } }
#pragma unroll
        for (int r = 0; r < 2; ++r) { const int m = m0 + r * NGW;
            if (m < nrows) {
#pragma unroll
                for (int j = 0; j < 2; ++j) { u32x4 o;
#pragma unroll
                    for (int q = 0; q < 4; ++q) { const int e = 8 * j + 2 * q;
                        const float lo = bf_lo(b4[r][j][q]) * (wt[0][e] * bf_lo(x2[r][j][q]) + wt[1][e] * bf_lo(x1[r][j][q]) + wt[2][e] * bf_lo(x0[r][j][q]));
                        const float hi = bf_hi(b4[r][j][q]) * (wt[0][e + 1] * bf_hi(x2[r][j][q]) + wt[1][e + 1] * bf_hi(x1[r][j][q]) + wt[2][e + 1] * bf_hi(x0[r][j][q]));
                        o[q] = pk2(lo, hi); }
                    pg8::wt16(VO + (size_t)m * D + 8 * (lane + 64 * j), o); } } }
    }
}

constexpr int GL_B = 0, GL_GZ = 33792, GL_TOT = 37888, GL_RED = 39936, GL_K = 41984, GL_QS = 59392, GL_QI = 76800, GL_V = 94208, GL_P = 128000;
constexpr int BSTR = 132, KSTR = 136, VSTR = 264, PSTR = 72;
static_assert(GL_P + 64 * PSTR * 2 <= LDS_BYTES, "gla lds");
__device__ __forceinline__ int gla_row(int b, int n, int c) { return n ? b * SEQ + (n - 1) * 64 + c : (c >= 48 ? MMETA0 + (c - 48) : -1); }
__device__ __forceinline__ s16x4 tr_read(unsigned a) { s16x4 r; asm volatile("ds_read_b64_tr_b16 %0, %1\n\ts_waitcnt lgkmcnt(0)" : "=&v"(r) : "v"(a) : "memory"); return r; }
__device__ __forceinline__ bf16x8 tr_frag(unsigned a0, unsigned a1) { const s16x4 lo = tr_read(a0), hi = tr_read(a1); return __builtin_shufflevector(lo, hi, 0, 1, 2, 3, 4, 5, 6, 7); }
__device__ __forceinline__ unsigned lds_u32(const LAS void* p) { return (unsigned)(uintptr_t)p; }

constexpr int GLA_UNITS = (NCH - 1) * 16 + 4;
__device__ __forceinline__ void gla_unit(int idx, int& n, int& b, int& h) { if (idx < (NCH - 1) * 16) { n = 1 + (idx >> 4); b = (idx & 15) >> 2; h = idx & 3; } else { n = 0; b = 0; h = idx - (NCH - 1) * 16; } }
__device__ __forceinline__ void gla_cumdecay(LAS unsigned char* lds, const f32x4 gzv, const float (&w)[16], float bia, int n, int tid) {
    LAS float* sB = (LAS float*)(lds + GL_B); LAS float* sGZ = (LAS float*)(lds + GL_GZ); LAS float* sTot = (LAS float*)(lds + GL_TOT);
    if (tid < 256) *(LAS f32x4*)(sGZ + (tid >> 2) * 16 + (tid & 3) * 4) = gzv;
    const int kd = tid & 127, grp = tid >> 7;
    __syncthreads();
    float loc[16]; float run = 0.f;
#pragma unroll
    for (int i = 0; i < 16; ++i) {
        const int c = grp * 16 + i;
        float z = bia;
#pragma unroll
        for (int r4 = 0; r4 < 4; ++r4) { const f32x4 gv = *(const LAS f32x4*)(sGZ + c * 16 + r4 * 4); z += gv[0] * w[r4 * 4] + gv[1] * w[r4 * 4 + 1] + gv[2] * w[r4 * 4 + 2] + gv[3] * w[r4 * 4 + 3]; }
        float la = (fminf(z, 0.f) - __logf(1.0f + __expf(-fabsf(z)))) * (1.0f / 16.0f);
        if (n == 0 && c < 48) la = 0.f;
        run += la; loc[i] = run;
    }
    sTot[grp * 128 + kd] = run;
    __syncthreads();
    float off = 0.f;
#pragma unroll
    for (int g2 = 0; g2 < 3; ++g2) off += (g2 < grp) ? sTot[g2 * 128 + kd] : 0.f;
#pragma unroll
    for (int i = 0; i < 16; ++i) sB[(grp * 16 + i) * BSTR + kd] = loc[i] + off;
    __syncthreads();
}
__device__ __forceinline__ void unpack8(const u32x4 w, float (&f)[8]) {
#pragma unroll
    for (int q = 0; q < 4; ++q) { f[2 * q] = bf_lo(w[q]); f[2 * q + 1] = bf_hi(w[q]); }
}
__device__ __forceinline__ u32x4 pack8f(const float (&f)[8]) { u32x4 w; w.x = pk2(f[0], f[1]); w.y = pk2(f[2], f[3]); w.z = pk2(f[4], f[5]); w.w = pk2(f[6], f[7]); return w; }

__device__ __forceinline__ void gla_g1(const Params& p, LAS unsigned char* lds, int tid, int wave, int lane) {
    unsigned char* big = p.ws + WS_BIG;
    const bf16* Kb = (const bf16*)(big + BIG_K); const bf16* Vb = (const bf16*)(big + BIG_V); const float* GZ = (const float*)(big + BIG_GZ);
    bf16* Ub = (bf16*)(big + BIG_U); float* Dec = (float*)(big + BIG_DEC);
    LAS float* sB = (LAS float*)(lds + GL_B); LAS bf16* sK = (LAS bf16*)(lds + GL_K); LAS bf16* sV = (LAS bf16*)(lds + GL_V);
    const int fr = lane & 15, fq = lane >> 4;
    const u32x4 z4 = (u32x4){0u, 0u, 0u, 0u};
    for (int idx = blockIdx.x; idx < GLA_UNITS; idx += gridDim.x) {
        int n, b, h; gla_unit(idx, n, b, h); const int unit = n * 16 + b * 4 + h;
        f32x4 gzv = (f32x4){0.f, 0.f, 0.f, 0.f};
        if (tid < 256) { const int row = gla_row(b, n, tid >> 2); if (row >= 0) gzv = *(const f32x4*)(GZ + (size_t)row * 16 + (tid & 3) * 4); }
        float w[16];
#pragma unroll
        for (int r = 0; r < 16; ++r) w[r] = p.gla_w_up[r * 512 + h * 128 + (tid & 127)];
        const float bia = p.gla_b_gate[h * 128 + (tid & 127)];
        const int kd8 = (tid & 15) * 8, cb = tid >> 4;
        u32x4 kv[2], vv[4];
#pragma unroll
        for (int i = 0; i < 2; ++i) { const int row = gla_row(b, n, cb + 32 * i); kv[i] = (row >= 0) ? *(const u32x4*)(Kb + (size_t)row * 512 + h * 128 + kd8) : z4; }
#pragma unroll
        for (int i = 0; i < 4; ++i) { const int ii = tid + 512 * i, row = gla_row(b, n, ii >> 5); vv[i] = (row >= 0) ? *(const u32x4*)(Vb + (size_t)row * D + h * 256 + (ii & 31) * 8) : z4; }
        gla_cumdecay(lds, gzv, w, bia, n, tid);
        {
            float bl[8];
#pragma unroll
            for (int j = 0; j < 8; ++j) bl[j] = sB[63 * BSTR + kd8 + j];
#pragma unroll
            for (int i = 0; i < 2; ++i) { const int c = cb + 32 * i;
                float kf[8]; unpack8(kv[i], kf);
#pragma unroll
                for (int j = 0; j < 8; ++j) kf[j] *= __expf(bl[j] - sB[c * BSTR + kd8 + j]);
                *(LAS u32x4*)(sK + c * KSTR + kd8) = pack8f(kf); }
            if (tid < 128) pg8::wt4(Dec + (size_t)unit * 128 + tid, __expf(sB[63 * BSTR + tid]));
#pragma unroll
            for (int i = 0; i < 4; ++i) { const int ii = tid + 512 * i; *(LAS u32x4*)(sV + (ii >> 5) * VSTR + (ii & 31) * 8) = vv[i]; }
        }
        __syncthreads();
        f32x4 acc[8][2];
#pragma unroll
        for (int i = 0; i < 8; ++i)
#pragma unroll
            for (int j = 0; j < 2; ++j) acc[i][j] = (f32x4){0.f, 0.f, 0.f, 0.f};
#pragma unroll
        for (int ks = 0; ks < 2; ++ks) {
            const int r0 = 32 * ks + 8 * fq + (fr >> 2), cc = 4 * (fr & 3);
            bf16x8 Y[2];
#pragma unroll
            for (int j = 0; j < 2; ++j) { const int vd0 = 32 * wave + 16 * j; Y[j] = tr_frag(lds_u32(sV + r0 * VSTR + vd0 + cc), lds_u32(sV + (r0 + 4) * VSTR + vd0 + cc)); }
#pragma unroll
            for (int i = 0; i < 8; ++i) { const bf16x8 X = tr_frag(lds_u32(sK + r0 * KSTR + 16 * i + cc), lds_u32(sK + (r0 + 4) * KSTR + 16 * i + cc));
#pragma unroll
                for (int j = 0; j < 2; ++j) acc[i][j] = __builtin_amdgcn_mfma_f32_16x16x32_bf16(X, Y[j], acc[i][j], 0, 0, 0); }
        }
        bf16* Uu = Ub + (size_t)unit * 32768;
#pragma unroll
        for (int i = 0; i < 8; ++i)
#pragma unroll
            for (int j = 0; j < 2; ++j) { const int vd = 32 * wave + 16 * j + fr, kd = 16 * i + 4 * fq;
                u32x2 wv; wv.x = pk2(acc[i][j][0], acc[i][j][1]); wv.y = pk2(acc[i][j][2], acc[i][j][3]);
                pg8::wt8(Uu + vd * 128 + kd, wv); }
        __syncthreads();
    }
}

__device__ __forceinline__ void gla_g2(const Params& p, int tid) {
    unsigned char* big = p.ws + WS_BIG;
    bf16* Ub = (bf16*)(big + BIG_U); const float* Dec = (const float*)(big + BIG_DEC);
    for (int g = blockIdx.x * 512 + tid; g < 16 * 8192; g += gridDim.x * 512) {
        const int bh = g >> 13, e4 = (g & 8191) * 4, kd = e4 & 127;
        float S0, S1, S2, S3;
        { const size_t unit = (size_t)(bh & 3); const u32x2 u0 = *(const u32x2*)(Ub + unit * 32768 + e4); S0 = bf_lo(u0.x); S1 = bf_hi(u0.x); S2 = bf_lo(u0.y); S3 = bf_hi(u0.y); }
        for (int n0 = 1; n0 < NCH; n0 += 8) {
            u32x2 uu[8]; f32x4 dd[8];
#pragma unroll
            for (int i = 0; i < 8; ++i) { const size_t unit = (size_t)(n0 + i) * 16 + bh;
                uu[i] = *(const u32x2*)(Ub + unit * 32768 + e4); dd[i] = *(const f32x4*)(Dec + unit * 128 + kd); }
#pragma unroll
            for (int i = 0; i < 8; ++i) { const size_t unit = (size_t)(n0 + i) * 16 + bh;
                u32x2 wv; wv.x = pk2(S0, S1); wv.y = pk2(S2, S3); pg8::wt8(Ub + unit * 32768 + e4, wv);
                S0 = dd[i][0] * S0 + bf_lo(uu[i].x); S1 = dd[i][1] * S1 + bf_hi(uu[i].x); S2 = dd[i][2] * S2 + bf_lo(uu[i].y); S3 = dd[i][3] * S3 + bf_hi(uu[i].y); }
        }
    }
}

__device__ __forceinline__ void gla_g3(const Params& p, LAS unsigned char* lds, int tid, int wave, int lane) {
    unsigned char* big = p.ws + WS_BIG;
    const bf16* Qb = (const bf16*)(big + BIG_Q); const bf16* Kb = (const bf16*)(big + BIG_K); const bf16* Vb = (const bf16*)(big + BIG_V); const bf16* Gb = (const bf16*)(big + BIG_G);
    const float* GZ = (const float*)(big + BIG_GZ); const bf16* Sb = (const bf16*)(big + BIG_U); bf16* Ob = (bf16*)(p.ws + WS_HB);
    LAS float* sB = (LAS float*)(lds + GL_B); LAS float* sRed = (LAS float*)(lds + GL_RED);
    LAS bf16* sK = (LAS bf16*)(lds + GL_K); LAS bf16* sQs = (LAS bf16*)(lds + GL_QS); LAS bf16* sQi = (LAS bf16*)(lds + GL_QI); LAS bf16* sV = (LAS bf16*)(lds + GL_V); LAS bf16* sP = (LAS bf16*)(lds + GL_P);
    const int fr = lane & 15, fq = lane >> 4;
    const u32x4 z4 = (u32x4){0u, 0u, 0u, 0u};
    for (int idx = blockIdx.x; idx < GLA_UNITS; idx += gridDim.x) {
        int n, b, h; gla_unit(idx, n, b, h); const int unit = n * 16 + b * 4 + h;
        f32x4 gzv = (f32x4){0.f, 0.f, 0.f, 0.f};
        if (tid < 256) { const int row = gla_row(b, n, tid >> 2); if (row >= 0) gzv = *(const f32x4*)(GZ + (size_t)row * 16 + (tid & 3) * 4); }
        float w[16];
#pragma unroll
        for (int r = 0; r < 16; ++r) w[r] = p.gla_w_up[r * 512 + h * 128 + (tid & 127)];
        const float bia = p.gla_b_gate[h * 128 + (tid & 127)];
        const int kd8 = (tid & 15) * 8, cb = tid >> 4;
        u32x4 qv[2], kv[2], vv[4];
#pragma unroll
        for (int i = 0; i < 2; ++i) { const int row = gla_row(b, n, cb + 32 * i);
            qv[i] = (row >= 0) ? *(const u32x4*)(Qb + (size_t)row * 512 + h * 128 + kd8) : z4; kv[i] = (row >= 0) ? *(const u32x4*)(Kb + (size_t)row * 512 + h * 128 + kd8) : z4; }
#pragma unroll
        for (int i = 0; i < 4; ++i) { const int ii = tid + 512 * i, row = gla_row(b, n, ii >> 5); vv[i] = (row >= 0) ? *(const u32x4*)(Vb + (size_t)row * D + h * 256 + (ii & 31) * 8) : z4; }
        const bf16* Su = Sb + (size_t)unit * 32768;
        bf16x8 X2[4][2];
        if (n) {
#pragma unroll
            for (int ks = 0; ks < 4; ++ks)
#pragma unroll
                for (int xi = 0; xi < 2; ++xi) X2[ks][xi] = *(const bf16x8*)(Su + (32 * wave + 16 * xi + fr) * 128 + 32 * ks + 8 * fq);
        }
        u32x2 gg[4][2]; f32x4 nw[2];
#pragma unroll
        for (int xi = 0; xi < 2; ++xi) nw[xi] = *(const f32x4*)(p.gla_norm_w + 32 * wave + 16 * xi + 4 * fq);
#pragma unroll
        for (int mi = 0; mi < 4; ++mi) { const int row = gla_row(b, n, 16 * mi + fr);
#pragma unroll
            for (int xi = 0; xi < 2; ++xi) gg[mi][xi] = (row >= 0) ? *(const u32x2*)(Gb + (size_t)row * D + h * 256 + 32 * wave + 16 * xi + 4 * fq) : (u32x2){0u, 0u}; }
        gla_cumdecay(lds, gzv, w, bia, n, tid);
        {
            float br[8];
#pragma unroll
            for (int j = 0; j < 8; ++j) br[j] = sB[32 * BSTR + kd8 + j];
#pragma unroll
            for (int i = 0; i < 2; ++i) { const int c = cb + 32 * i;
                float qf[8], kf[8], qs[8], qi[8]; unpack8(qv[i], qf); unpack8(kv[i], kf);
#pragma unroll
                for (int j = 0; j < 8; ++j) { const float bb = sB[c * BSTR + kd8 + j]; const float e = __expf(bb - br[j]);
                    qs[j] = qf[j] * e; kf[j] = kf[j] * __expf(br[j] - bb); qi[j] = qf[j] * __expf(bb); }
                *(LAS u32x4*)(sQs + c * KSTR + kd8) = pack8f(qs); *(LAS u32x4*)(sK + c * KSTR + kd8) = pack8f(kf); *(LAS u32x4*)(sQi + c * KSTR + kd8) = pack8f(qi); }
#pragma unroll
            for (int i = 0; i < 4; ++i) { const int ii = tid + 512 * i; *(LAS u32x4*)(sV + (ii >> 5) * VSTR + (ii & 31) * 8) = vv[i]; }
        }
        __syncthreads();
        {
            const int ti = wave >> 1;
#pragma unroll
            for (int jj = 0; jj < 2; ++jj) {
                const int tj = 2 * (wave & 1) + jj;
                f32x4 a = (f32x4){0.f, 0.f, 0.f, 0.f};
                if (tj <= ti) {
#pragma unroll
                    for (int ks = 0; ks < 4; ++ks) {
                        const bf16x8 X = *(const LAS bf16x8*)(sK + (tj * 16 + fr) * KSTR + 32 * ks + 8 * fq);
                        const bf16x8 Y = *(const LAS bf16x8*)(sQs + (ti * 16 + fr) * KSTR + 32 * ks + 8 * fq);
                        a = __builtin_amdgcn_mfma_f32_16x16x32_bf16(X, Y, a, 0, 0, 0);
                    }
                }
                const int ci = ti * 16 + fr, cj = tj * 16 + 4 * fq;
                float e0 = (cj + 0 <= ci) ? a[0] : 0.f, e1 = (cj + 1 <= ci) ? a[1] : 0.f, e2 = (cj + 2 <= ci) ? a[2] : 0.f, e3 = (cj + 3 <= ci) ? a[3] : 0.f;
                u32x2 wv; wv.x = pk2(e0, e1); wv.y = pk2(e2, e3);
                *(LAS u32x2*)(sP + ci * PSTR + cj) = wv;
            }
        }
        __syncthreads();
        f32x4 acc[4][2];
#pragma unroll
        for (int mi = 0; mi < 4; ++mi)
#pragma unroll
            for (int xi = 0; xi < 2; ++xi) acc[mi][xi] = (f32x4){0.f, 0.f, 0.f, 0.f};
#pragma unroll
        for (int ks = 0; ks < 2; ++ks) {
            const int r0 = 32 * ks + 8 * fq + (fr >> 2), cc = 4 * (fr & 3);
            bf16x8 X1[2];
#pragma unroll
            for (int xi = 0; xi < 2; ++xi) { const int vd0 = 32 * wave + 16 * xi; X1[xi] = tr_frag(lds_u32(sV + r0 * VSTR + vd0 + cc), lds_u32(sV + (r0 + 4) * VSTR + vd0 + cc)); }
#pragma unroll
            for (int mi = 0; mi < 4; ++mi) { const bf16x8 Y1 = *(const LAS bf16x8*)(sP + (16 * mi + fr) * PSTR + 32 * ks + 8 * fq);
#pragma unroll
                for (int xi = 0; xi < 2; ++xi) acc[mi][xi] = __builtin_amdgcn_mfma_f32_16x16x32_bf16(X1[xi], Y1, acc[mi][xi], 0, 0, 0); }
        }
        if (n) {
#pragma unroll
            for (int ks = 0; ks < 4; ++ks) {
#pragma unroll
                for (int mi = 0; mi < 4; ++mi) { const bf16x8 Y2 = *(const LAS bf16x8*)(sQi + (16 * mi + fr) * KSTR + 32 * ks + 8 * fq);
#pragma unroll
                    for (int xi = 0; xi < 2; ++xi) acc[mi][xi] = __builtin_amdgcn_mfma_f32_16x16x32_bf16(X2[ks][xi], Y2, acc[mi][xi], 0, 0, 0); }
            }
        }
#pragma unroll
        for (int mi = 0; mi < 4; ++mi) { float ss = 0.f;
#pragma unroll
            for (int xi = 0; xi < 2; ++xi) ss += (acc[mi][xi][0] * acc[mi][xi][0] + acc[mi][xi][1] * acc[mi][xi][1]) + (acc[mi][xi][2] * acc[mi][xi][2] + acc[mi][xi][3] * acc[mi][xi][3]);
            ss += __shfl_xor(ss, 16); ss += __shfl_xor(ss, 32);
            if (fq == 0) sRed[wave * 64 + 16 * mi + fr] = ss; }
        __syncthreads();
#pragma unroll
        for (int mi = 0; mi < 4; ++mi) {
            const int c = 16 * mi + fr, row = gla_row(b, n, c);
            float tot = 0.f;
#pragma unroll
            for (int w2 = 0; w2 < 8; ++w2) tot += sRed[w2 * 64 + c];
            const float rinv = 1.0f / sqrtf(tot * (1.0f / 256.0f) + RMS_EPS);
            if (row >= 0) {
#pragma unroll
                for (int xi = 0; xi < 2; ++xi) { const int vd = 32 * wave + 16 * xi + 4 * fq;
                    const float o0 = acc[mi][xi][0] * rinv * nw[xi][0] * bf_lo(gg[mi][xi].x), o1 = acc[mi][xi][1] * rinv * nw[xi][1] * bf_hi(gg[mi][xi].x);
                    const float o2 = acc[mi][xi][2] * rinv * nw[xi][2] * bf_lo(gg[mi][xi].y), o3 = acc[mi][xi][3] * rinv * nw[xi][3] * bf_hi(gg[mi][xi].y);
                    u32x2 wv; wv.x = pk2(o0, o1); wv.y = pk2(o2, o3);
                    pg8::wt8(Ob + (size_t)row * D + h * 256 + vd, wv); }
            }
        }
        __syncthreads();
    }
}

typedef __attribute__((address_space(1))) unsigned gu32;
#define XB_TMO      128
#define XB_XCNT(j)  (256  + 64 * (j))
#define XB_XSUB(j)  (1280 + 64 * (j))
#define XB_XGEN(j)  (2304 + 64 * (j))
#define XB_TOP      3328
#define XB_TOPGEN   3392
#define XCD_BAR_WORDS 3456
#define XB_SPIN_CAP (1u << 18)

__device__ __forceinline__ unsigned xb_ld(unsigned* p)              { return __hip_atomic_load(p, __ATOMIC_RELAXED, __HIP_MEMORY_SCOPE_AGENT); }
__device__ __forceinline__ unsigned xb_add(unsigned* p, unsigned v) { return __hip_atomic_fetch_add(p, v, __ATOMIC_RELAXED, __HIP_MEMORY_SCOPE_AGENT); }
__device__ __forceinline__ unsigned xb_xcc_id() { return (unsigned)__builtin_amdgcn_s_getreg((3 << 11) | 20) & 0xFu; }
#define XB_SPIN(cond, bar) do { unsigned _sp = 0; while (cond) { __builtin_amdgcn_s_sleep(1); \
    if ((++_sp & 255u) == 0u) { if (xb_ld(&(bar)[XB_TMO])) break; if (_sp > XB_SPIN_CAP) { atomicAdd(&(bar)[XB_TMO], 1u); break; } } } } while (0)

struct XcdBarrier {
    unsigned* bar; unsigned x;
    volatile LAS unsigned* st;
};

__device__ __forceinline__ XcdBarrier xcd_barrier_post(unsigned* bar, volatile LAS unsigned* st) {
    XcdBarrier b; b.bar = bar; b.x = xb_xcc_id(); b.st = st;
    if (threadIdx.x == 0) (void)xb_add(&bar[XB_XCNT(b.x)], 1u);
    return b;
}
__device__ __forceinline__ void xcd_barrier_complete(unsigned* bar, unsigned x, unsigned& nloc, unsigned& nx) {
    const unsigned G = gridDim.x * gridDim.y * gridDim.z;
    unsigned sum, cnt, mine, sp = 0u;
    for (;;) {
        sum = 0u; cnt = 0u; mine = 0u;
#pragma unroll
        for (unsigned j = 0; j < 16; ++j) { const unsigned c = xb_ld(&bar[XB_XCNT(j)]); sum += c; cnt += (c > 0u) ? 1u : 0u; mine = (j == x) ? c : mine; }
        if (sum == G) break;
        __builtin_amdgcn_s_sleep(1);
        if ((++sp & 255u) == 0u) { if (xb_ld(&bar[XB_TMO])) break; if (sp > XB_SPIN_CAP) { atomicAdd(&bar[XB_TMO], 1u); break; } }
    }
    nloc = mine > 0u ? mine : 1u; nx = cnt > 0u ? cnt : 1u;
}

__device__ __forceinline__ void xcd_barrier(const XcdBarrier& b) {
    asm volatile("s_waitcnt vmcnt(0)" ::: "memory");
    __syncthreads();
    if (threadIdx.x == 0) {
        unsigned* bar = b.bar;
        __builtin_amdgcn_s_waitcnt(0);
        unsigned nloc = b.st[0], nx = b.st[1];
        if (nloc == 0u) { xcd_barrier_complete(bar, b.x, nloc, nx); b.st[0] = nloc; b.st[1] = nx; }
        const unsigned old = xb_add(&bar[XB_XSUB(b.x)], 1u);
        const unsigned gen = old / nloc;
        if (old + 1u == (gen + 1u) * nloc) {
            __builtin_amdgcn_fence(__ATOMIC_RELEASE, "agent");
            asm volatile("s_waitcnt vmcnt(0)" ::: "memory");
            const unsigned og = xb_add(&bar[XB_TOP], 1u);
            const unsigned tg = og / nx;
            if (og + 1u == (tg + 1u) * nx) xb_add(&bar[XB_TOPGEN], 1u);
            else XB_SPIN(xb_ld(&bar[XB_TOPGEN]) == tg, bar);
            __builtin_amdgcn_fence(__ATOMIC_ACQUIRE, "agent");
            xb_add(&bar[XB_XGEN(b.x)], 1u);
            asm volatile("s_waitcnt vmcnt(0)" ::: "memory");
        } else {
            XB_SPIN(xb_ld(&bar[XB_XGEN(b.x)]) == gen, bar);
            __builtin_amdgcn_fence(__ATOMIC_ACQUIRE, "agent");
            asm volatile("s_waitcnt vmcnt(0)" ::: "memory");
        }
    }
    __syncthreads();
}

__device__ __forceinline__ void mini_gemm(LAS unsigned char* lds, const bf16* A, const bf16* B0, const bf16* B1, int K, int wave, int lane, f32x4& r0, f32x4& r1) {
    const int fr = lane & 15, fq = lane >> 4;
    f32x4 a0 = (f32x4){0.f, 0.f, 0.f, 0.f}, a1 = a0;
    const bf16* ap = A + (size_t)fr * K + 8 * fq; const bf16* b0p = B0 + (size_t)fr * K + 8 * fq; const bf16* b1p = B1 + (size_t)fr * K + 8 * fq;
    for (int ks = wave; ks < K / 32; ks += 8) {
        const bf16x8 af = *(const bf16x8*)(ap + 32 * ks), b0 = *(const bf16x8*)(b0p + 32 * ks), b1 = *(const bf16x8*)(b1p + 32 * ks);
        a0 = __builtin_amdgcn_mfma_f32_16x16x32_bf16(b0, af, a0, 0, 0, 0);
        a1 = __builtin_amdgcn_mfma_f32_16x16x32_bf16(b1, af, a1, 0, 0, 0);
    }
    LAS f32x4* red = (LAS f32x4*)lds;
    red[(wave * 2 + 0) * 64 + lane] = a0; red[(wave * 2 + 1) * 64 + lane] = a1;
    __syncthreads();
    if (wave == 0) {
        r0 = red[lane]; r1 = red[64 + lane];
#pragma unroll
        for (int w = 1; w < 8; ++w) { r0 += red[(w * 2) * 64 + lane]; r1 += red[(w * 2 + 1) * 64 + lane]; }
    }
    __syncthreads();
}
__device__ __forceinline__ u32x2 pack4(const f32x4 v) { u32x2 w; w.x = pk2(v[0], v[1]); w.y = pk2(v[2], v[3]); return w; }
__device__ __forceinline__ void mini_ffn_in(LAS unsigned char* lds, const bf16* HB, const bf16* Wt, bf16* ACT, int t, int wave, int lane) {
    const int pn = t >> 3, j0 = (t & 7) * 16; f32x4 g, u;
    mini_gemm(lds, HB + (size_t)MMETA0 * D, Wt + (size_t)(256 * pn + j0) * D, Wt + (size_t)(256 * pn + 128 + j0) * D, D, wave, lane, g, u);
    if (wave == 0) { f32x4 a;
#pragma unroll
        for (int j = 0; j < 4; ++j) a[j] = pg8::silu_f(g[j]) * u[j];
        pg8::wt8(ACT + (size_t)(MMETA0 + (lane & 15)) * FF + 16 * t + 4 * (lane >> 4), pack4(a)); }
}
__device__ __forceinline__ void mini_resid(LAS unsigned char* lds, const bf16* A, int K, const bf16* Wt, const float* src, float* dst, const float* stats, const float* gain, const float* bias, float scale, int t, int wave, int lane) {
    f32x4 r[2];
    mini_gemm(lds, A + (size_t)MMETA0 * K, Wt + (size_t)(32 * t) * K, Wt + (size_t)(32 * t + 16) * K, K, wave, lane, r[0], r[1]);
    if (wave == 0) { const int row = lane & 15; float mean = 0.f, rstd = 1.f;
        if (stats) { mean = stats[(size_t)(MMETA0 + row) * 2]; rstd = stats[(size_t)(MMETA0 + row) * 2 + 1]; }
#pragma unroll
        for (int q = 0; q < 2; ++q) { const int col = 32 * t + 16 * q + 4 * (lane >> 4);
            const f32x4 x = *(const f32x4*)(src + (size_t)row * D + col);
            f32x4 h = x;
            if (stats) h = (x - mean) * rstd * *(const f32x4*)(gain + col) + *(const f32x4*)(bias + col);
            pg8::wt16(dst + (size_t)row * D + col, h * ALPHA + r[q] * scale); } }
}
__device__ __forceinline__ void mini_conv_in(LAS unsigned char* lds, const bf16* HB, const bf16* Wt, bf16* CU, bf16* BG, int t, int wave, int lane) {
    f32x4 a, b;
    if (t < 64) { const int pn = t >> 3, j0 = (t & 7) * 16;
        mini_gemm(lds, HB + (size_t)MMETA0 * D, Wt + (size_t)(256 * pn + j0) * D, Wt + (size_t)(256 * pn + 128 + j0) * D, D, wave, lane, a, b);
        if (wave == 0) pg8::wt8(CU + (size_t)(MMETA0 + (lane & 15)) * D + 16 * t + 4 * (lane >> 4), pack4(a * b));
    } else { const int c0 = 16 * (t - 64);
        mini_gemm(lds, HB + (size_t)MMETA0 * D, Wt + (size_t)(2048 + c0) * D, Wt + (size_t)(2048 + c0) * D, D, wave, lane, a, b);
        if (wave == 0) pg8::wt8(BG + (size_t)(MMETA0 + (lane & 15)) * D + c0 + 4 * (lane >> 4), pack4(a)); }
}
__device__ __forceinline__ void mini_gla_in(LAS unsigned char* lds, const bf16* HB, const bf16* Wt, bf16* Q, bf16* Kk, bf16* V, bf16* G, float qscale, int t, int wave, int lane) {
    f32x4 r[2];
    mini_gemm(lds, HB + (size_t)MMETA0 * D, Wt + (size_t)(32 * t) * D, Wt + (size_t)(32 * t + 16) * D, D, wave, lane, r[0], r[1]);
    if (wave == 0) { const size_t row = MMETA0 + (lane & 15);
#pragma unroll
        for (int q = 0; q < 2; ++q) { const int c = 32 * t + 16 * q + 4 * (lane >> 4); f32x4 v = r[q];
            if (c < 512) pg8::wt8(Q + row * 512 + c, pack4(v * qscale));
            else if (c < 1024) pg8::wt8(Kk + row * 512 + (c - 512), pack4(v));
            else if (c < 2048) pg8::wt8(V + row * D + (c - 1024), pack4(v));
            else {
#pragma unroll
                for (int j = 0; j < 4; ++j) v[j] = pg8::silu_f(v[j]);
                pg8::wt8(G + row * D + (c - 2048), pack4(v)); } } }
}
__device__ __forceinline__ void gz_phase(const bf16* HB, const bf16* Wgz, float* GZ, int gw, int NGW, int lane) {
    const int fr = lane & 15, fq = lane >> 4;
    for (int rb = gw; rb < MREAL / 16 + 1; rb += NGW) {
        const size_t row0 = (size_t)rb * 16;
        const bf16* ap = HB + (row0 + fr) * D + 8 * fq; const bf16* bp = Wgz + (size_t)fr * D + 8 * fq;
        f32x4 a0 = (f32x4){0.f, 0.f, 0.f, 0.f}, a1 = a0;
#pragma unroll 4
        for (int ks = 0; ks < D / 32; ks += 2) {
            a0 = __builtin_amdgcn_mfma_f32_16x16x32_bf16(*(const bf16x8*)(bp + 32 * ks), *(const bf16x8*)(ap + 32 * ks), a0, 0, 0, 0);
            a1 = __builtin_amdgcn_mfma_f32_16x16x32_bf16(*(const bf16x8*)(bp + 32 * ks + 32), *(const bf16x8*)(ap + 32 * ks + 32), a1, 0, 0, 0);
        }
        pg8::wt16(GZ + (row0 + fr) * 16 + 4 * fq, a0 + a1);
    }
}


#ifndef REP_G1
#define REP_G1 1
#endif
#ifndef REP_G2
#define REP_G2 0
#endif
#ifndef REP_LN
#define REP_LN 1
#endif
#ifndef REP_GLA
#define REP_GLA 1
#endif
#ifndef REP_SYNC
#define REP_SYNC 0
#endif
#ifndef REP_MIX
#define REP_MIX 1
#endif
template <class Epi>
__device__ __forceinline__ void run_gemm(LAS unsigned char* lds, const bf16* A, const bf16* Bt, int N, int K, const Epi& E) {
    pg8::Gemm g{A, Bt, MREAL, N, K}; pg8::StaticOrder S; S.init(MREAL, N, (int)gridDim.x, (int)blockIdx.x);
    pg8::gemm_phase<Epi, pg8::StaticOrder, true, true>(lds, g, S, E);
}

__global__ void __launch_bounds__(512, 2) fwd_megakernel(Params p) {
    extern __shared__ __attribute__((aligned(16))) unsigned char lds_raw[];
    LAS unsigned char* lds = (LAS unsigned char*)lds_raw;
    cg::grid_group grid = cg::this_grid();
    if (threadIdx.x < 16) ((LAS unsigned*)(lds + LDS_BYTES - 64))[threadIdx.x] = 0u;
    __syncthreads();
    const XcdBarrier xbar = xcd_barrier_post((unsigned*)(p.ws + WS_BAR), (volatile LAS unsigned*)(lds + LDS_BYTES - 64));
#define GSYNC() xcd_barrier(xbar)
    const int tid0 = threadIdx.x;
#define FRESH_IDS() int tid = tid0; asm volatile("" : "+v"(tid)); const int lane = tid & 63, wave = __builtin_amdgcn_readfirstlane(tid >> 6); const int gw = vcu * 8 + wave
    const int G = gridDim.x, bx = blockIdx.x;
    const int vcu = (G % 8 == 0) ? (bx % 8) * (G / 8) + bx / 8 : bx;
    const int NGW = G * 8;
    unsigned char* ws = p.ws; unsigned char* big = ws + WS_BIG;
    bf16* HB = (bf16*)(ws + WS_HB); float* XM = (float*)(ws + WS_XM); float* METAR = (float*)(ws + WS_METAR); float* STATS = (float*)(ws + WS_STATS);
    bf16* ACT = (bf16*)(big + BIG_ACT);

#ifndef NO_P0
    { FRESH_IDS(); p0_prologue(p, lds, gw, NGW, wave, lane); }
#endif
    grid.sync();

    int lnk = 0;
#pragma clang loop unroll(disable)
    for (int blk = 0; blk < 4; ++blk) {
        {
            { FRESH_IDS(); if (bx < 176) mini_ffn_in(lds, HB, (const bf16*)(ws + WS_WFI + (size_t)blk * SZ_WFI), ACT, bx, wave, lane); }
            pg8::EpiSwiGLU E1{ACT, FF};
            for (int rep = 0; rep < REP_G1; ++rep) run_gemm(lds, HB, (const bf16*)(ws + WS_WFI + (size_t)blk * SZ_WFI), 2 * FF, D, E1);
            GSYNC();
            pg8::EpiResid E2;
            if (lnk == 0) E2 = pg8::EpiResid{p.x, METAR, p.out, XM, nullptr, nullptr, nullptr, ALPHA, 0.5f};
            else E2 = pg8::EpiResid{p.out, XM, p.out, XM, STATS, p.ln_gain + (lnk - 1) * D, p.ln_bias + (lnk - 1) * D, ALPHA, 0.5f};
            { FRESH_IDS(); if (bx >= 64 && bx < 96) mini_resid(lds, ACT, FF, (const bf16*)(ws + WS_WFO + (size_t)blk * SZ_WFO), lnk == 0 ? METAR : XM, XM, E2.stats, E2.gain, E2.bias, 0.5f, bx - 64, wave, lane); }
            for (int rep = 0; rep < REP_G2; ++rep) { pg8::EpiResid E3 = E2; E3.Oreal = (float*)(big + BIG_U); run_gemm(lds, ACT, (const bf16*)(ws + WS_WFO + (size_t)blk * SZ_WFO), D, FF, E3); }
            run_gemm(lds, ACT, (const bf16*)(ws + WS_WFO + (size_t)blk * SZ_WFO), D, FF, E2);
            GSYNC();
            if (blk == 3) { FRESH_IDS(); ln_phase<true>(p.out, XM, p.ln_gain + 5 * D, p.ln_bias + 5 * D, nullptr, nullptr, p.out, gw, NGW, lane); break; }
            for (int rep = 0; rep < REP_LN; ++rep) { FRESH_IDS(); ln_phase<false>(p.out, XM, p.ln_gain + lnk * D, p.ln_bias + lnk * D, HB, STATS, nullptr, gw, NGW, lane); } ++lnk;
            for (int rep = 0; rep < REP_SYNC; ++rep) GSYNC();
            GSYNC();
        }
        if (blk == 0 || blk == 2) {
            const bf16* Wo;
            if (blk == 0) {
                { FRESH_IDS(); if (bx < 128) mini_conv_in(lds, HB, (const bf16*)(ws + WS_WCI), (bf16*)(big + BIG_CU), (bf16*)(big + BIG_BG), bx, wave, lane); }
                pg8::EpiConvIn Ec{(bf16*)(big + BIG_CU), (bf16*)(big + BIG_BG)};
                run_gemm(lds, HB, (const bf16*)(ws + WS_WCI), 3072, D, Ec);
                GSYNC();
#ifndef NO_CM
                for (int rep = 0; rep < REP_MIX; ++rep) { FRESH_IDS(); conv_mix_phase((const bf16*)(big + BIG_BG), (const bf16*)(big + BIG_CU), p.conv_w, HB, gw, NGW, lane); }
#endif
                GSYNC();
                Wo = (const bf16*)(ws + WS_WCO);
            } else {
                { FRESH_IDS(); gz_phase(HB, (const bf16*)(ws + WS_WGI) + (size_t)3072 * D, (float*)(big + BIG_GZ), gw, NGW, lane);
                  if (bx >= 128 && bx < 224) mini_gla_in(lds, HB, (const bf16*)(ws + WS_WGI), (bf16*)(big + BIG_Q), (bf16*)(big + BIG_K), (bf16*)(big + BIG_V), (bf16*)(big + BIG_G), 0.08838834764831845f, bx - 128, wave, lane); }
                pg8::EpiGlaIn Eg{(bf16*)(big + BIG_Q), (bf16*)(big + BIG_K), (bf16*)(big + BIG_V), (bf16*)(big + BIG_G), (float*)(big + BIG_GZ), 0.08838834764831845f};
                run_gemm(lds, HB, (const bf16*)(ws + WS_WGI), 3072, D, Eg);
                GSYNC();
#ifndef NO_G1
                for (int rep = 0; rep < REP_GLA; ++rep) { FRESH_IDS(); gla_g1(p, lds, tid, wave, lane); }
#endif
                GSYNC();
#ifndef NO_G2
                { FRESH_IDS(); gla_g2(p, tid); }
#endif
                GSYNC();
#ifndef NO_G3
                for (int rep = 0; rep < REP_GLA; ++rep) { FRESH_IDS(); gla_g3(p, lds, tid, wave, lane); }
#endif
                GSYNC();
                Wo = (const bf16*)(ws + WS_WGO);
            }
            pg8::EpiResid Eo{p.out, XM, p.out, XM, STATS, p.ln_gain + (lnk - 1) * D, p.ln_bias + (lnk - 1) * D, ALPHA, 1.0f};
            { FRESH_IDS(); if (bx >= 32 && bx < 64) mini_resid(lds, HB, D, Wo, XM, XM, STATS, Eo.gain, Eo.bias, 1.0f, bx - 32, wave, lane); }
            run_gemm(lds, HB, Wo, D, D, Eo);
            GSYNC();
            for (int rep = 0; rep < REP_LN; ++rep) { FRESH_IDS(); ln_phase<false>(p.out, XM, p.ln_gain + lnk * D, p.ln_bias + lnk * D, HB, STATS, nullptr, gw, NGW, lane); } ++lnk;
            for (int rep = 0; rep < REP_SYNC; ++rep) GSYNC();
            GSYNC();
        }
    }
}

extern "C" void kernel_launch(void* const* d_in, const int* in_sizes, int n_in, void* d_out, int out_size, void* d_ws, size_t ws_size, hipStream_t stream) {
    static int grid_blocks = 0;
    if (grid_blocks == 0) {
        if (n_in != 14 || out_size != MREAL * D || ws_size < WS_END) { fprintf(stderr, "kernel_launch: unexpected shapes: n_in %d out %d ws %zu (need %zu)\n", n_in, out_size, ws_size, (size_t)WS_END); grid_blocks = -1; return; }
        int dev = 0, cus = 0, per_cu = 0;
        hipGetDevice(&dev); hipDeviceGetAttribute(&cus, hipDeviceAttributeMultiprocessorCount, dev);
        if (hipFuncSetAttribute((const void*)fwd_megakernel, hipFuncAttributeMaxDynamicSharedMemorySize, LDS_BYTES) != hipSuccess) { fprintf(stderr, "kernel_launch: hipFuncSetAttribute failed\n"); grid_blocks = -1; return; }
        if (hipOccupancyMaxActiveBlocksPerMultiprocessor(&per_cu, (const void*)fwd_megakernel, 512, LDS_BYTES) != hipSuccess || per_cu < 1) { fprintf(stderr, "kernel_launch: occupancy query says %d\n", per_cu); per_cu = 1; }
        (void)hipGetLastError();
        grid_blocks = cus * 1;
    }
    if (grid_blocks < 0) return;
    Params p{};
    p.x = (const float*)d_in[0]; p.meta = (const float*)d_in[1]; p.ln_gain = (const float*)d_in[2]; p.ln_bias = (const float*)d_in[3];
    p.ffn_w_in = (const float*)d_in[4]; p.ffn_w_out = (const float*)d_in[5]; p.conv_w_in = (const float*)d_in[6]; p.conv_w = (const float*)d_in[7];
    p.conv_w_out = (const float*)d_in[8]; p.gla_w_in = (const float*)d_in[9]; p.gla_w_up = (const float*)d_in[10]; p.gla_b_gate = (const float*)d_in[11];
    p.gla_norm_w = (const float*)d_in[12]; p.gla_w_out = (const float*)d_in[13]; p.out = (float*)d_out; p.ws = (unsigned char*)d_ws;
    if (hipMemsetAsync((char*)d_ws + WS_BAR, 0, WS_BAR_BYTES, stream) != hipSuccess) { fprintf(stderr, "kernel_launch: memset of barrier words failed\n"); return; }
    void* args[] = {&p};
    hipError_t e = hipLaunchCooperativeKernel((const void*)fwd_megakernel, dim3(grid_blocks), dim3(512), args, LDS_BYTES, stream);
    if (e != hipSuccess) fprintf(stderr, "cooperative launch failed: %s (grid %d)\n", hipGetErrorString(e), grid_blocks);
}
```

```cpp
#include <hip/hip_runtime.h>
#include <hip/hip_cooperative_groups.h>
#include <cstdio>
#include <cstdint>
namespace cg = cooperative_groups;

namespace pg8 {
#define PG8_LAS __attribute__((address_space(3)))
typedef unsigned short bf16_t;
typedef short bf16x8 __attribute__((ext_vector_type(8)));
typedef float f32x4 __attribute__((ext_vector_type(4)));
typedef unsigned u32x4 __attribute__((ext_vector_type(4)));
typedef unsigned u32x2 __attribute__((ext_vector_type(2)));
constexpr int BM = 256, BK = 64, HALF = 128, HTB = HALF * BK * 2  , STAGE_BYTES = 8 * HTB, NXCD = 8, WGM = 8;

__host__ __device__ __forceinline__ int lds_byte(int r, int c) { const int st = (r >> 4) * 2 + (c >> 5), rr = r & 15, cc = c & 31, ob = rr * 64 + cc * 2; return st * 1024 + (ob ^ (((ob >> 9) & 1) << 5)); }
__host__ __device__ __forceinline__ void stage_rc(int b, int& R, int& C) { const int st = b / 1024, sb = b % 1024, swz = sb ^ (((sb >> 9) & 1) << 5); R = (st >> 1) * 16 + swz / 64; C = (st & 1) * 32 + (swz % 64) / 2; }
__host__ __device__ __forceinline__ int perm32(int rho) { const int n = rho >> 4, i = rho & 15; return 8 * (i >> 2) + 4 * n + (i & 3); }

struct Unit { int pm, pn; };
struct Gemm { const bf16_t* A; const bf16_t* Bt; int M, N, K; };

struct StaticOrder {
    int nM, nN, nwg, G, c;
    __host__ __device__ void init(int M, int N, int G_, int c_) { nM = M / BM; nN = N / BM; nwg = nM * nN; G = G_; c = c_; }
    __host__ __device__ bool next(int i, Unit& u) const {
        const long L = (long)i * G + c; if (L >= nwg) return false;
        int wgid = (int)L; { const int q = nwg / NXCD, r = nwg % NXCD, xcd = wgid % NXCD, off = wgid / NXCD; wgid = (xcd < r ? xcd * (q + 1) : r * (q + 1) + (xcd - r) * q) + off; }
        const int nig = WGM * nN, gid = wgid / nig, fm = gid * WGM, gsz = (nM - fm) < WGM ? (nM - fm) : WGM;
        u.pm = fm + ((wgid % nig) % gsz); u.pn = (wgid % nig) / gsz; return true;
    }
    __device__ __forceinline__ void a_ready(const Unit&) const {}
    __device__ __forceinline__ void done(const Unit&) const {}
};

__device__ __forceinline__ unsigned cvt_pk_bf16(float lo, float hi) { unsigned r; asm volatile("v_cvt_pk_bf16_f32 %0, %1, %2" : "=v"(r) : "v"(lo), "v"(hi)); return r; }
__device__ __forceinline__ float silu_f(float x) { return x * __builtin_amdgcn_rcpf(1.0f + __builtin_amdgcn_exp2f(-1.44269504089f * x)); }
__device__ __forceinline__ u32x4 pack8(const f32x4 a, const f32x4 b) { u32x4 w; w.x = cvt_pk_bf16(a[0], a[1]); w.y = cvt_pk_bf16(a[2], a[3]); w.z = cvt_pk_bf16(b[0], b[1]); w.w = cvt_pk_bf16(b[2], b[3]); return w; }
__device__ __forceinline__ void wt16(void* p, u32x4 v) { asm volatile("global_store_dwordx4 %0, %1, off sc1\n\ts_nop 1" :: "v"(p), "v"(v)); }
__device__ __forceinline__ void wt16(void* p, f32x4 v) { asm volatile("global_store_dwordx4 %0, %1, off sc1\n\ts_nop 1" :: "v"(p), "v"(v)); }
__device__ __forceinline__ void wt8(void* p, unsigned long long v) { __hip_atomic_store((unsigned long long*)p, v, __ATOMIC_RELAXED, __HIP_MEMORY_SCOPE_AGENT); }
__device__ __forceinline__ void wt8(void* p, u32x2 v) { wt8(p, (unsigned long long)v.x | ((unsigned long long)v.y << 32)); }
__device__ __forceinline__ void wt4(float* p, float v) { __hip_atomic_store(p, v, __ATOMIC_RELAXED, __HIP_MEMORY_SCOPE_AGENT); }

constexpr int MROWS_REAL = 32768;

struct EpiSwiGLU {
    static constexpr bool PERM = true, AFTER_DRAIN = false;
    bf16_t* O; int ldc;
    __device__ __forceinline__ void operator()(const f32x4 (&acc)[2][2][4][2], const Unit& u, int wr, int wc, int fr, int fq) const {
        const int row0 = u.pm * BM + wr * 64 + fr, col0 = u.pn * HALF + wc * 32 + 8 * fq;
#pragma unroll
        for (int ai = 0; ai < 2; ++ai)
#pragma unroll
            for (int m = 0; m < 4; ++m) {
                bf16_t* rowp = O + (size_t)(row0 + ai * HALF + m * 16) * ldc + col0;
                f32x4 a0, a1;
#pragma unroll
                for (int j = 0; j < 4; ++j) { a0[j] = silu_f(acc[ai][0][m][0][j]) * acc[ai][1][m][0][j]; a1[j] = silu_f(acc[ai][0][m][1][j]) * acc[ai][1][m][1][j]; }
                wt16(rowp, pack8(a0, a1));
            }
    }
};

struct EpiResid {
    static constexpr bool PERM = false, AFTER_DRAIN = false;
    const float* Rreal; const float* Rmeta; float* Oreal; float* Ometa; const float* stats; const float* gain; const float* bias; float alpha, scale;
    __device__ __forceinline__ void operator()(const f32x4 (&acc)[2][2][4][2], const Unit& u, int wr, int wc, int fr, int fq) const {
        const float* src = Rreal + (size_t)u.pm * BM * 1024;
        float* dst = Oreal + (size_t)u.pm * BM * 1024;
        const int r0 = wr * 64 + fr, col0 = u.pn * BM + wc * 32 + 4 * fq;
        float mean[2][4], rstd[2][4];
#pragma unroll
        for (int ai = 0; ai < 2; ++ai)
#pragma unroll
            for (int m = 0; m < 4; ++m) {
                mean[ai][m] = 0.f; rstd[ai][m] = 1.f;
                if (stats) { const float2 s = *(const float2*)(stats + (size_t)(u.pm * BM + r0 + ai * HALF + m * 16) * 2); mean[ai][m] = s.x; rstd[ai][m] = s.y; }
            }
#pragma unroll
        for (int bj = 0; bj < 2; ++bj)
#pragma unroll
            for (int n = 0; n < 2; ++n) {
                const int c = col0 + bj * HALF + n * 16;
                f32x4 gv = (f32x4){1.f, 1.f, 1.f, 1.f}, bv = (f32x4){0.f, 0.f, 0.f, 0.f};
                if (stats) { gv = *(const f32x4*)(gain + c); bv = *(const f32x4*)(bias + c); }
#pragma unroll
                for (int ai = 0; ai < 2; ++ai)
#pragma unroll
                    for (int m = 0; m < 4; ++m) {
                        const size_t off = (size_t)(r0 + ai * HALF + m * 16) * 1024 + c;
                        const f32x4 x = *(const f32x4*)(src + off);
                        const f32x4 h = (x - mean[ai][m]) * rstd[ai][m] * gv + bv;
                        wt16(dst + off, h * alpha + acc[ai][bj][m][n] * scale);
                    }
                asm volatile("" ::: "memory");
            }
    }
};

struct EpiConvIn {
    static constexpr bool PERM = true, AFTER_DRAIN = false;
    bf16_t* CU; bf16_t* BG;
    __device__ __forceinline__ void operator()(const f32x4 (&acc)[2][2][4][2], const Unit& u, int wr, int wc, int fr, int fq) const {
        const int row0 = u.pm * BM + wr * 64 + fr;
        if (u.pn < 8) {
            const int col0 = u.pn * HALF + wc * 32 + 8 * fq;
#pragma unroll
            for (int ai = 0; ai < 2; ++ai)
#pragma unroll
                for (int m = 0; m < 4; ++m) {
                    bf16_t* rowp = CU + (size_t)(row0 + ai * HALF + m * 16) * 1024 + col0;
                    wt16(rowp, pack8(acc[ai][0][m][0] * acc[ai][1][m][0], acc[ai][0][m][1] * acc[ai][1][m][1]));
                }
        } else {
            const int col0 = (u.pn - 8) * BM + wc * 32 + 8 * fq;
#pragma unroll
            for (int ai = 0; ai < 2; ++ai)
#pragma unroll
                for (int m = 0; m < 4; ++m) {
                    bf16_t* rowp = BG + (size_t)(row0 + ai * HALF + m * 16) * 1024 + col0;
#pragma unroll
                    for (int bj = 0; bj < 2; ++bj) wt16(rowp + bj * HALF, pack8(acc[ai][bj][m][0], acc[ai][bj][m][1]));
                }
        }
    }
};

struct EpiGlaIn {
    static constexpr bool PERM = true, AFTER_DRAIN = false;
    bf16_t* Q; bf16_t* Kk; bf16_t* V; bf16_t* G; float* GZ; float qscale;
    __device__ __forceinline__ void operator()(const f32x4 (&acc)[2][2][4][2], const Unit& u, int wr, int wc, int fr, int fq) const {
        const int row0 = u.pm * BM + wr * 64 + fr;
        bf16_t* base; int ld, colt; float sc = 1.f; bool act = false;
        if (u.pn < 2) { base = Q; ld = 512; colt = u.pn * BM; sc = qscale; }
        else if (u.pn < 4) { base = Kk; ld = 512; colt = (u.pn - 2) * BM; }
        else if (u.pn < 8) { base = V; ld = 1024; colt = (u.pn - 4) * BM; }
        else { base = G; ld = 1024; colt = (u.pn - 8) * BM; act = true; }
        const int col0 = colt + wc * 32 + 8 * fq;
#pragma unroll
        for (int ai = 0; ai < 2; ++ai)
#pragma unroll
            for (int m = 0; m < 4; ++m) {
                bf16_t* rowp = base + (size_t)(row0 + ai * HALF + m * 16) * ld + col0;
#pragma unroll
                for (int bj = 0; bj < 2; ++bj) {
                    f32x4 v0 = acc[ai][bj][m][0] * sc, v1 = acc[ai][bj][m][1] * sc;
                    if (act) {
#pragma unroll
                        for (int j = 0; j < 4; ++j) { v0[j] = silu_f(v0[j]); v1[j] = silu_f(v1[j]); }
                    }
                    wt16(rowp + bj * HALF, pack8(v0, v1));
                }
            }
    }
};

template <class Epi, class Sched, bool ALIGN_EPI = false, bool SP2 = false>
__device__ __forceinline__ void gemm_phase(PG8_LAS unsigned char* lds, const Gemm g, const Sched& S, const Epi& E) {
    int tid_ = threadIdx.x; asm volatile("" : "+v"(tid_));
    const int tid = tid_, wid = __builtin_amdgcn_readfirstlane(tid >> 6), lane = tid & 63, wr = wid >> 2, wc = wid & 3, fr = lane & 15, fq = lane >> 4;
    const int K = g.K, nt = K / BK;
    unsigned voffA[2], voffB[2];
#pragma unroll
    for (int i = 0; i < 2; ++i) { int R, C; stage_rc(tid * 16 + i * 8192, R, C); const int Rb = Epi::PERM ? ((R & ~31) + perm32(R & 31)) : R;
        voffA[i] = (unsigned)(R * K + C) * 2u; voffB[i] = (unsigned)(Rb * K + C) * 2u; }
    const size_t kstep = (size_t)(BK * 2);
    const size_t hstep = (size_t)HALF * K * 2;
    const size_t tstep = 2 * hstep;
    const unsigned ldsw = (unsigned)wid * 1024u;
    const int aoff = lds_byte(wr * 64 + fr, fq * 8), boff = lds_byte(wc * 32 + fr, fq * 8);
#define PG8_SA(b, h) (((b) * 2 + (h)) * HTB)
#define PG8_SB(b, h) ((4 + (b) * 2 + (h)) * HTB)
#define PG8_STAGE(bufoff, gbase, voff) do { _Pragma("unroll") for (int _i = 0; _i < 2; ++_i) \
        __builtin_amdgcn_global_load_lds((const unsigned*)((const char*)(gbase) + (voff)[_i]), (PG8_LAS unsigned*)(lds + (bufoff) + ldsw + _i * 8192), 16, 0, 0); } while (0)
#define PG8_LDA(dst, b, h) do { _Pragma("unroll") for (int m = 0; m < 4; ++m) _Pragma("unroll") for (int k = 0; k < 2; ++k) dst[m][k] = *(const PG8_LAS bf16x8*)(lds + PG8_SA(b, h) + aoff + m * 2048 + k * 1024); } while (0)
#define PG8_LDB(dst, b, h) do { _Pragma("unroll") for (int n = 0; n < 2; ++n) _Pragma("unroll") for (int k = 0; k < 2; ++k) dst[n][k] = *(const PG8_LAS bf16x8*)(lds + PG8_SB(b, h) + boff + n * 2048 + k * 1024); } while (0)
#define PG8_MMA(ai, bj, At, Bt) do { __builtin_amdgcn_s_setprio(1); _Pragma("unroll") for (int m = 0; m < 4; ++m) _Pragma("unroll") for (int n = 0; n < 2; ++n) _Pragma("unroll") for (int k = 0; k < 2; ++k) \
        acc[ai][bj][m][n] = __builtin_amdgcn_mfma_f32_16x16x32_bf16(Bt[n][k], At[m][k], acc[ai][bj][m][n], 0, 0, 0); __builtin_amdgcn_s_setprio(0); } while (0)
#define PG8_WAIT_V(n) asm volatile("s_waitcnt vmcnt(" #n ")" ::: "memory")
#define PG8_WAIT_L(n) asm volatile("s_waitcnt lgkmcnt(" #n ")" ::: "memory")
#define PG8_BAR __builtin_amdgcn_s_barrier()
#define PG8_SCHED __builtin_amdgcn_sched_barrier(0)
    Unit cur, nxt; int ui = 0;
    if (!S.next(0, cur)) return;
    f32x4 acc[2][2][4][2];
#pragma unroll
    for (int a = 0; a < 2; ++a)
#pragma unroll
        for (int b = 0; b < 2; ++b)
#pragma unroll
            for (int m = 0; m < 4; ++m)
#pragma unroll
                for (int n = 0; n < 2; ++n) acc[a][b][m][n] = (f32x4){0.f, 0.f, 0.f, 0.f};
    bf16x8 At[4][2], B0[2][2], B1[2][2];
    const char* cA = (const char*)g.A + (size_t)cur.pm * tstep; const char* cB = (const char*)g.Bt + (size_t)cur.pn * tstep;
    S.a_ready(cur);
    if constexpr (SP2) {
        PG8_STAGE(PG8_SB(0, 0), cB, voffB); PG8_STAGE(PG8_SB(0, 1), cB + hstep, voffB); PG8_STAGE(PG8_SA(0, 0), cA, voffA); PG8_STAGE(PG8_SA(0, 1), cA + hstep, voffA);
        if (wr == 1) PG8_BAR;
        PG8_WAIT_V(2); PG8_BAR;
        PG8_STAGE(PG8_SB(1, 0), cB + kstep, voffB); PG8_STAGE(PG8_SA(1, 0), cA + kstep, voffA); PG8_STAGE(PG8_SB(1, 1), cB + hstep + kstep, voffB);
        PG8_WAIT_V(6); PG8_BAR;
    } else {
        PG8_STAGE(PG8_SB(0, 0), cB, voffB); PG8_STAGE(PG8_SA(0, 0), cA, voffA); PG8_STAGE(PG8_SB(0, 1), cB + hstep, voffB); PG8_STAGE(PG8_SA(0, 1), cA + hstep, voffA);
        if (wr == 1) PG8_BAR;
        PG8_WAIT_V(4); PG8_BAR;
        PG8_STAGE(PG8_SB(1, 0), cB + kstep, voffB); PG8_STAGE(PG8_SA(1, 0), cA + kstep, voffA); PG8_STAGE(PG8_SB(1, 1), cB + hstep + kstep, voffB);
        PG8_WAIT_V(6); PG8_BAR;
    }
    for (;;) {
        const bool has_next = S.next(ui + 1, nxt);
        const char* nA = has_next ? (const char*)g.A + (size_t)nxt.pm * tstep : cA; const char* nB = has_next ? (const char*)g.Bt + (size_t)nxt.pn * tstep : cB;
        for (int t = 0; t < nt; t += 2) {
            const bool last = (t == nt - 2);
            const char* a1 = cA + (size_t)(t + 1) * kstep;
            const char* a2 = last ? nA : cA + (size_t)(t + 2) * kstep; const char* b2 = last ? nB : cB + (size_t)(t + 2) * kstep;
            const char* a3 = a2 + kstep; const char* b3 = b2 + kstep;
            if (last && has_next) S.a_ready(nxt);
            if constexpr (SP2) {
            PG8_LDB(B0, 0, 0); PG8_LDB(B1, 0, 1); PG8_SCHED; PG8_LDA(At, 0, 0); PG8_STAGE(PG8_SA(1, 1), a1 + hstep, voffA);
            PG8_WAIT_V(8); PG8_WAIT_L(0); PG8_BAR; PG8_MMA(0, 0, At, B0); PG8_MMA(0, 1, At, B1); PG8_BAR; PG8_SCHED;
            PG8_LDA(At, 0, 1); PG8_STAGE(PG8_SB(0, 0), b2, voffB); PG8_STAGE(PG8_SB(0, 1), b2 + hstep, voffB); PG8_STAGE(PG8_SA(0, 0), a2, voffA);
            PG8_WAIT_V(8); PG8_WAIT_L(0); PG8_BAR; PG8_MMA(1, 0, At, B0); PG8_MMA(1, 1, At, B1); PG8_BAR; PG8_SCHED;
            PG8_LDB(B0, 1, 0); PG8_LDB(B1, 1, 1); PG8_SCHED; PG8_LDA(At, 1, 0); PG8_STAGE(PG8_SA(0, 1), a2 + hstep, voffA);
            PG8_WAIT_V(8); PG8_WAIT_L(0); PG8_BAR; PG8_MMA(0, 0, At, B0); PG8_MMA(0, 1, At, B1); PG8_BAR; PG8_SCHED;
            PG8_LDA(At, 1, 1); PG8_STAGE(PG8_SB(1, 0), b3, voffB); PG8_STAGE(PG8_SB(1, 1), b3 + hstep, voffB); PG8_STAGE(PG8_SA(1, 0), a3, voffA);
            PG8_WAIT_V(8); PG8_WAIT_L(0); PG8_BAR; PG8_MMA(1, 0, At, B0); PG8_MMA(1, 1, At, B1); PG8_BAR; PG8_SCHED;
            } else {
            PG8_LDB(B0, 0, 0); PG8_SCHED; PG8_LDA(At, 0, 0); PG8_STAGE(PG8_SA(1, 1), a1 + hstep, voffA);
            PG8_WAIT_L(8); PG8_BAR; PG8_WAIT_L(0); PG8_MMA(0, 0, At, B0); PG8_BAR; PG8_SCHED;
            PG8_LDB(B1, 0, 1); PG8_STAGE(PG8_SB(0, 0), b2, voffB);
            PG8_BAR; PG8_WAIT_L(0); PG8_MMA(0, 1, At, B1); PG8_BAR;
            PG8_LDA(At, 0, 1); PG8_STAGE(PG8_SA(0, 0), a2, voffA);
            PG8_BAR; PG8_WAIT_L(0); PG8_MMA(1, 0, At, B0); PG8_BAR; PG8_SCHED;
            PG8_STAGE(PG8_SB(0, 1), b2 + hstep, voffB);
            PG8_WAIT_V(6); PG8_BAR; PG8_MMA(1, 1, At, B1); PG8_BAR;
            PG8_LDB(B0, 1, 0); PG8_SCHED; PG8_LDA(At, 1, 0); PG8_STAGE(PG8_SA(0, 1), a2 + hstep, voffA);
            PG8_WAIT_L(8); PG8_BAR; PG8_WAIT_L(0); PG8_MMA(0, 0, At, B0); PG8_BAR; PG8_SCHED;
            PG8_LDB(B1, 1, 1); PG8_STAGE(PG8_SB(1, 0), b3, voffB);
            PG8_BAR; PG8_WAIT_L(0); PG8_MMA(0, 1, At, B1); PG8_BAR;
            PG8_LDA(At, 1, 1); PG8_STAGE(PG8_SA(1, 0), a3, voffA);
            PG8_BAR; PG8_WAIT_L(0); PG8_MMA(1, 0, At, B0); PG8_BAR; PG8_SCHED;
            PG8_STAGE(PG8_SB(1, 1), b3 + hstep, voffB);
            PG8_WAIT_V(6); PG8_BAR; PG8_MMA(1, 1, At, B1); PG8_BAR;
            }
        }
        if constexpr (ALIGN_EPI) { if (wr == 0) PG8_BAR; }
        if constexpr (!Epi::AFTER_DRAIN) { E(acc, cur, wr, wc, fr, fq); S.done(cur); }
        if (!has_next) break;
#pragma unroll
        for (int a = 0; a < 2; ++a)
#pragma unroll
            for (int b = 0; b < 2; ++b)
#pragma unroll
                for (int m = 0; m < 4; ++m)
#pragma unroll
                    for (int n = 0; n < 2; ++n) acc[a][b][m][n] = (f32x4){0.f, 0.f, 0.f, 0.f};
        cur = nxt; cA = nA; cB = nB; ++ui;
        if constexpr (ALIGN_EPI) { if (wr == 1) PG8_BAR; }
    }
    PG8_WAIT_V(0);
    if constexpr (!ALIGN_EPI) { if (wr == 0) PG8_BAR; }
    PG8_BAR;
    if constexpr (Epi::AFTER_DRAIN) { E.fused(acc, cur, wr, wc, fr, fq, lds, wid, lane); S.done(cur); }
#undef PG8_SA
#undef PG8_SB
#undef PG8_STAGE
#undef PG8_LDA
#undef PG8_LDB
#undef PG8_MMA
#undef PG8_WAIT_V
#undef PG8_WAIT_L
#undef PG8_BAR
#undef PG8_SCHED
}
}

#define LAS __attribute__((address_space(3)))
typedef unsigned short bf16;
typedef float f32x4 __attribute__((ext_vector_type(4)));
typedef short bf16x8 __attribute__((ext_vector_type(8)));
typedef short s16x4 __attribute__((ext_vector_type(4)));
typedef unsigned u32x4 __attribute__((ext_vector_type(4)));
typedef unsigned u32x2 __attribute__((ext_vector_type(2)));

constexpr int D = 1024, FF = 2816, SEQ = 8192, NB = 4, NMETA = 16;
constexpr int MREAL = NB * SEQ;
constexpr int MMETA0 = MREAL;
constexpr int MPAD = MREAL + 256;
constexpr int NCH = 129;
constexpr int GLA_NIN = 3328;
constexpr float LN_EPS = 1e-5f, RMS_EPS = 1e-6f;
constexpr float ALPHA = 1.41421356237f;

constexpr size_t al256(size_t x) { return (x + 255) & ~(size_t)255; }
constexpr size_t SZ_WFI = (size_t)2 * FF * D * 2, SZ_WFO = (size_t)D * FF * 2;
constexpr size_t WS_WFI = 0;
constexpr size_t WS_WFO = WS_WFI + 4 * SZ_WFI;
constexpr size_t WS_WCI = WS_WFO + 4 * SZ_WFO;
constexpr size_t WS_WCO = WS_WCI + (size_t)3072 * D * 2;
constexpr size_t WS_WGI = WS_WCO + (size_t)D * D * 2;
constexpr size_t WS_WGO = WS_WGI + (size_t)GLA_NIN * D * 2;
constexpr size_t WS_HB = WS_WGO + (size_t)D * D * 2;
constexpr size_t WS_XM = WS_HB + (size_t)MPAD * D * 2;
constexpr size_t WS_METAR = WS_XM + (size_t)256 * D * 4;
constexpr size_t WS_STATS = WS_METAR + (size_t)256 * D * 4;
constexpr size_t WS_BIG = al256(WS_STATS + (size_t)MPAD * 8);
constexpr size_t SZ_ROWBF = (size_t)MPAD * D * 2;
constexpr size_t BIG_ACT = 0;
constexpr size_t BIG_BG = 0, BIG_CU = SZ_ROWBF;
constexpr size_t BIG_Q = 0, BIG_K = SZ_ROWBF / 2, BIG_V = SZ_ROWBF, BIG_G = 2 * SZ_ROWBF, BIG_GZ = 3 * SZ_ROWBF;
constexpr size_t BIG_U = al256(BIG_GZ + (size_t)MPAD * 16 * 4);
constexpr size_t BIG_DEC = BIG_U + (size_t)NCH * 16 * 32768 * 2;
constexpr size_t BIG_END = BIG_DEC + (size_t)NCH * 16 * 128 * 4;
constexpr size_t WS_BAR = al256(WS_BIG + BIG_END);
constexpr size_t WS_BAR_BYTES = 16384;
constexpr size_t WS_END = WS_BAR + WS_BAR_BYTES;
static_assert((size_t)MPAD * FF * 2 <= BIG_END, "act fits");

constexpr int LDS_BYTES = 147456;

struct Params {
    const float* x; const float* meta; const float* ln_gain; const float* ln_bias; const float* ffn_w_in; const float* ffn_w_out;
    const float* conv_w_in; const float* conv_w; const float* conv_w_out; const float* gla_w_in; const float* gla_w_up; const float* gla_b_gate;
    const float* gla_norm_w; const float* gla_w_out; float* out; unsigned char* ws;
};

__device__ __forceinline__ unsigned f2bf(float f) { unsigned u = __builtin_bit_cast(unsigned, f); return (u + 0x7fffu + ((u >> 16) & 1u)) >> 16; }
__device__ __forceinline__ unsigned pk2(float lo, float hi) { return pg8::cvt_pk_bf16(lo, hi); }
__device__ __forceinline__ float bf_lo(unsigned w) { return __builtin_bit_cast(float, w << 16); }
__device__ __forceinline__ float bf_hi(unsigned w) { return __builtin_bit_cast(float, w & 0xffff0000u); }
__device__ __forceinline__ float wave_sum(float v) {
#pragma unroll
    for (int o = 1; o < 64; o <<= 1) v += __shfl_xor(v, o);
    return v;
}
#define LDS_WAIT() asm volatile("s_waitcnt lgkmcnt(0)" ::: "memory")

__device__ __forceinline__ void p0_transpose_item(const float* W, int K, int ldw, int scol, int nvalid, bf16* WT, int n0d, int k0, LAS float* scr, int lane) {
    float tv[32];
#pragma unroll
    for (int i = 0; i < 32; ++i) { const int kk = 2 * i + (lane >> 5), j = lane & 31; tv[i] = (j < nvalid) ? W[(size_t)(k0 + kk) * ldw + scol + j] : 0.f; }
#pragma unroll
    for (int i = 0; i < 32; ++i) { const int kk = 2 * i + (lane >> 5), j = lane & 31; scr[kk * 33 + j] = tv[i]; }
    LDS_WAIT(); asm volatile("" ::: "memory");
    const int c = lane & 7;
#pragma unroll
    for (int jj = 0; jj < 4; ++jj) { const int n = (lane >> 3) + 8 * jj; const LAS float* s = scr + (8 * c) * 33 + n;
        u32x4 o; o.x = pk2(s[0 * 33], s[1 * 33]); o.y = pk2(s[2 * 33], s[3 * 33]); o.z = pk2(s[4 * 33], s[5 * 33]); o.w = pk2(s[6 * 33], s[7 * 33]);
        pg8::wt16(WT + (size_t)(n0d + n) * K + k0 + 8 * c, o); }
    LDS_WAIT(); asm volatile("" ::: "memory");
}
__device__ __forceinline__ void p0_matrix(const float* W, int K, int Nsrc, int Ndst, int mode, bf16* WT, LAS float* scr, int lane, int item) {
    const int nblk = Ndst / 32, kb = item / nblk, nb = item % nblk, n0d = nb * 32, k0 = kb * 64;
    int scol = n0d, nvalid = 32;
    if (mode == 1) { const int pn = n0d >> 8, j = n0d & 255; scol = (j < 128) ? 128 * pn + j : FF + 128 * pn + (j - 128); }
    else if (mode == 2) { const int pn = n0d >> 8, j = n0d & 255; scol = (pn < 8) ? ((j < 128) ? 1024 + 128 * pn + j : 2048 + 128 * pn + (j - 128)) : 256 * (pn - 8) + j; }
    else if (mode == 3) { nvalid = Nsrc - n0d; nvalid = nvalid < 0 ? 0 : (nvalid > 32 ? 32 : nvalid); if (nvalid == 0) scol = 0; }
    p0_transpose_item(W, K, Nsrc, scol, nvalid, WT, n0d, k0, scr, lane);
}
__device__ __forceinline__ void p0_prologue(const Params& p, LAS unsigned char* lds, int gw, int NGW, int wave, int lane) {
    LAS float* scr = (LAS float*)(lds + wave * 16384);
    unsigned char* ws = p.ws;
    constexpr int I_FI = (D / 64) * (2 * FF / 32), I_FO = (FF / 64) * (D / 32), I_CI = (D / 64) * (3072 / 32), I_SQ = (D / 64) * (D / 32), I_GI = (D / 64) * (GLA_NIN / 32);
    constexpr int NITEMS = 4 * I_FI + 4 * I_FO + I_CI + I_SQ + I_GI + I_SQ;
    for (int it = gw; it < NITEMS; it += NGW) {
        int r = it;
        if (r < 4 * I_FI) { const int l = r / I_FI; p0_matrix(p.ffn_w_in + (size_t)l * D * 2 * FF, D, 2 * FF, 2 * FF, 1, (bf16*)(ws + WS_WFI + l * SZ_WFI), scr, lane, r % I_FI); continue; } r -= 4 * I_FI;
        if (r < 4 * I_FO) { const int l = r / I_FO; p0_matrix(p.ffn_w_out + (size_t)l * FF * D, FF, D, D, 0, (bf16*)(ws + WS_WFO + l * SZ_WFO), scr, lane, r % I_FO); continue; } r -= 4 * I_FO;
        if (r < I_CI) { p0_matrix(p.conv_w_in, D, 3072, 3072, 2, (bf16*)(ws + WS_WCI), scr, lane, r); continue; } r -= I_CI;
        if (r < I_SQ) { p0_matrix(p.conv_w_out, D, D, D, 0, (bf16*)(ws + WS_WCO), scr, lane, r); continue; } r -= I_SQ;
        if (r < I_GI) { p0_matrix(p.gla_w_in, D, 3088, GLA_NIN, 3, (bf16*)(ws + WS_WGI), scr, lane, r); continue; } r -= I_GI;
        p0_matrix(p.gla_w_out, D, D, D, 0, (bf16*)(ws + WS_WGO), scr, lane, r);
    }
    bf16* HB = (bf16*)(ws + WS_HB); float* METAR = (float*)(ws + WS_METAR);
    for (int m0 = gw; m0 < MREAL + NMETA; m0 += 4 * NGW) {
        f32x4 v[4][4];
#pragma unroll
        for (int r = 0; r < 4; ++r) { const int m = m0 + r * NGW;
            if (m < MREAL + NMETA) { const float* src = (m < MREAL) ? p.x + (size_t)m * D : p.meta + (size_t)(m - MREAL) * D;
#pragma unroll
                for (int j = 0; j < 4; ++j) v[r][j] = ((const f32x4*)src)[lane + 64 * j]; } }
#pragma unroll
        for (int r = 0; r < 4; ++r) { const int m = m0 + r * NGW;
            if (m < MREAL + NMETA) {
                unsigned long long* o8 = (unsigned long long*)(HB + (size_t)m * D) + lane;
#pragma unroll
                for (int j = 0; j < 4; ++j) {
                    pg8::wt8(o8 + 64 * j, (unsigned long long)pk2(v[r][j][0], v[r][j][1]) | ((unsigned long long)pk2(v[r][j][2], v[r][j][3]) << 32));
                    if (m >= MREAL) pg8::wt16((f32x4*)(METAR + (size_t)(m - MREAL) * D) + lane + 64 * j, v[r][j]);
                } } }
    }
}

template <bool FINAL>
__device__ __forceinline__ void ln_phase(const float* Zreal, const float* Zmeta, const float* gain, const float* bias, bf16* HB, float* stats, float* out, int gw, int NGW, int lane) {
    f32x4 g[4], bb[4];
#pragma unroll
    for (int j = 0; j < 4; ++j) { g[j] = ((const f32x4*)gain)[lane + 64 * j]; bb[j] = ((const f32x4*)bias)[lane + 64 * j]; }
    const int nrows = FINAL ? MREAL : MREAL + NMETA;
    for (int m0 = gw; m0 < nrows; m0 += 4 * NGW) {
        f32x4 v[4][4];
#pragma unroll
        for (int r = 0; r < 4; ++r) { const int m = m0 + r * NGW;
            if (m < nrows) { const float* zr = (m < MREAL) ? Zreal + (size_t)m * D : Zmeta + (size_t)(m - MREAL) * D;
#pragma unroll
                for (int j = 0; j < 4; ++j) v[r][j] = ((const f32x4*)zr)[lane + 64 * j]; }
            else {
#pragma unroll
                for (int j = 0; j < 4; ++j) v[r][j] = (f32x4){0.f, 0.f, 0.f, 0.f}; } }
#pragma unroll
        for (int r = 0; r < 4; ++r) { const int m = m0 + r * NGW;
            float s = 0.f;
#pragma unroll
            for (int j = 0; j < 4; ++j) s += (v[r][j][0] + v[r][j][1]) + (v[r][j][2] + v[r][j][3]);
            const float mean = wave_sum(s) * (1.f / D); float s2 = 0.f;
#pragma unroll
            for (int j = 0; j < 4; ++j) { const f32x4 d = v[r][j] - mean; s2 += (d[0] * d[0] + d[1] * d[1]) + (d[2] * d[2] + d[3] * d[3]); }
            const float rstd = 1.0f / sqrtf(wave_sum(s2) * (1.f / D) + LN_EPS);
            if (m < nrows) {
                if (FINAL) {
#pragma unroll
                    for (int j = 0; j < 4; ++j) ((f32x4*)(out + (size_t)m * D))[lane + 64 * j] = (v[r][j] - mean) * rstd * g[j] + bb[j];
                } else {
                    if (lane == 0) pg8::wt8(stats + (size_t)m * 2, (unsigned long long)__float_as_uint(mean) | ((unsigned long long)__float_as_uint(rstd) << 32));
                    unsigned long long* o8 = (unsigned long long*)(HB + (size_t)m * D) + lane;
#pragma unroll
                    for (int j = 0; j < 4; ++j) { const f32x4 y = (v[r][j] - mean) * rstd * g[j] + bb[j]; pg8::wt8(o8 + 64 * j, (unsigned long long)pk2(y[0], y[1]) | ((unsigned long long)pk2(y[2], y[3]) << 32)); }
                }
            }
        }
    }
}

__device__ __forceinline__ int conv_pred(int m, int k) {
    if (m < MREAL) { const int t = m & (SEQ - 1); return (t >= k) ? m - k : MMETA0 + (NMETA + t - k); }
    const int j = m - MMETA0; return (j >= k) ? m - k : -1;
}
__device__ __forceinline__ void conv_mix_phase(const bf16* BG, const bf16* CU, const float* cw, bf16* VO, int gw, int NGW, int lane) {
    const int nrows = MREAL + NMETA;
    const u32x4 z4 = (u32x4){0u, 0u, 0u, 0u};
    float wt[3][16];
#pragma unroll
    for (int k = 0; k < 3; ++k)
#pragma unroll
        for (int j = 0; j < 2; ++j)
#pragma unroll
            for (int q = 0; q < 2; ++q) { const f32x4 t = *(const f32x4*)(cw + k * D + 8 * (lane + 64 * j) + 4 * q);
                wt[k][8 * j + 4 * q] = t[0]; wt[k][8 * j + 4 * q + 1] = t[1]; wt[k][8 * j + 4 * q + 2] = t[2]; wt[k][8 * j + 4 * q + 3] = t[3]; }
    for (int m0 = gw; m0 < nrows; m0 += 2 * NGW) {
        u32x4 b4[2][2], x0[2][2], x1[2][2], x2[2][2];
#pragma unroll
        for (int r = 0; r < 2; ++r) { const int m = m0 + r * NGW; const bool ok = m < nrows;
            const int p1 = ok ? conv_pred(m, 1) : -1, p2 = ok ? conv_pred(m, 2) : -1;
#pragma unroll
            for (int j = 0; j < 2; ++j) { const int c0 = 8 * (lane + 64 * j);
                b4[r][j] = ok ? *(const u32x4*)(BG + (size_t)m * D + c0) : z4; x0[r][j] = ok ? *(const u32x4*)(CU + (size_t)m * D + c0) : z4;
                x1[r][j] = (p1 >= 0) ? *(const u32x4*)(CU + (size_t)p1 * D + c0) : z4; x2[r][j] = (p2 >= 0) ? *(const u32x4*)(CU + (size_t)p2 * D + c0) : z4; } }
#pragma unroll
        for (int r = 0; r < 2; ++r) { const int m = m0 + r * NGW;
            if (m < nrows) {
#pragma unroll
                for (int j = 0; j < 2; ++j) { u32x4 o;
#pragma unroll
                    for (int q = 0; q < 4; ++q) { const int e = 8 * j + 2 * q;
                        const float lo = bf_lo(b4[r][j][q]) * (wt[0][e] * bf_lo(x2[r][j][q]) + wt[1][e] * bf_lo(x1[r][j][q]) + wt[2][e] * bf_lo(x0[r][j][q]));
                        const float hi = bf_hi(b4[r][j][q]) * (wt[0][e + 1] * bf_hi(x2[r][j][q]) + wt[1][e + 1] * bf_hi(x1[r][j][q]) + wt[2][e + 1] * bf_hi(x0[r][j][q]));
                        o[q] = pk2(lo, hi); }
                    pg8::wt16(VO + (size_t)m * D + 8 * (lane + 64 * j), o); } } }
    }
}

constexpr int GL_B = 0, GL_GZ = 33792, GL_TOT = 37888, GL_RED = 39936, GL_K = 41984, GL_QS = 59392, GL_QI = 76800, GL_V = 94208, GL_P = 128000;
constexpr int BSTR = 132, KSTR = 136, VSTR = 264, PSTR = 72;
static_assert(GL_P + 64 * PSTR * 2 <= LDS_BYTES, "gla lds");
__device__ __forceinline__ int gla_row(int b, int n, int c) { return n ? b * SEQ + (n - 1) * 64 + c : (c >= 48 ? MMETA0 + (c - 48) : -1); }
__device__ __forceinline__ s16x4 tr_read(unsigned a) { s16x4 r; asm volatile("ds_read_b64_tr_b16 %0, %1\n\ts_waitcnt lgkmcnt(0)" : "=&v"(r) : "v"(a) : "memory"); return r; }
__device__ __forceinline__ bf16x8 tr_frag(unsigned a0, unsigned a1) { const s16x4 lo = tr_read(a0), hi = tr_read(a1); return __builtin_shufflevector(lo, hi, 0, 1, 2, 3, 4, 5, 6, 7); }
__device__ __forceinline__ unsigned lds_u32(const LAS void* p) { return (unsigned)(uintptr_t)p; }

constexpr int GLA_UNITS = (NCH - 1) * 16 + 4;
__device__ __forceinline__ void gla_unit(int idx, int& n, int& b, int& h) { if (idx < (NCH - 1) * 16) { n = 1 + (idx >> 4); b = (idx & 15) >> 2; h = idx & 3; } else { n = 0; b = 0; h = idx - (NCH - 1) * 16; } }
__device__ __forceinline__ void gla_cumdecay(LAS unsigned char* lds, const f32x4 gzv, const float (&w)[16], float bia, int n, int tid) {
    LAS float* sB = (LAS float*)(lds + GL_B); LAS float* sGZ = (LAS float*)(lds + GL_GZ); LAS float* sTot = (LAS float*)(lds + GL_TOT);
    if (tid < 256) *(LAS f32x4*)(sGZ + (tid >> 2) * 16 + (tid & 3) * 4) = gzv;
    const int kd = tid & 127, grp = tid >> 7;
    __syncthreads();
    float loc[16]; float run = 0.f;
#pragma unroll
    for (int i = 0; i < 16; ++i) {
        const int c = grp * 16 + i;
        float z = bia;
#pragma unroll
        for (int r4 = 0; r4 < 4; ++r4) { const f32x4 gv = *(const LAS f32x4*)(sGZ + c * 16 + r4 * 4); z += gv[0] * w[r4 * 4] + gv[1] * w[r4 * 4 + 1] + gv[2] * w[r4 * 4 + 2] + gv[3] * w[r4 * 4 + 3]; }
        float la = (fminf(z, 0.f) - __logf(1.0f + __expf(-fabsf(z)))) * (1.0f / 16.0f);
        if (n == 0 && c < 48) la = 0.f;
        run += la; loc[i] = run;
    }
    sTot[grp * 128 + kd] = run;
    __syncthreads();
    float off = 0.f;
#pragma unroll
    for (int g2 = 0; g2 < 3; ++g2) off += (g2 < grp) ? sTot[g2 * 128 + kd] : 0.f;
#pragma unroll
    for (int i = 0; i < 16; ++i) sB[(grp * 16 + i) * BSTR + kd] = loc[i] + off;
    __syncthreads();
}
__device__ __forceinline__ void unpack8(const u32x4 w, float (&f)[8]) {
#pragma unroll
    for (int q = 0; q < 4; ++q) { f[2 * q] = bf_lo(w[q]); f[2 * q + 1] = bf_hi(w[q]); }
}
__device__ __forceinline__ u32x4 pack8f(const float (&f)[8]) { u32x4 w; w.x = pk2(f[0], f[1]); w.y = pk2(f[2], f[3]); w.z = pk2(f[4], f[5]); w.w = pk2(f[6], f[7]); return w; }

__device__ __forceinline__ void gla_g1(const Params& p, LAS unsigned char* lds, int tid, int wave, int lane) {
    unsigned char* big = p.ws + WS_BIG;
    const bf16* Kb = (const bf16*)(big + BIG_K); const bf16* Vb = (const bf16*)(big + BIG_V); const float* GZ = (const float*)(big + BIG_GZ);
    bf16* Ub = (bf16*)(big + BIG_U); float* Dec = (float*)(big + BIG_DEC);
    LAS float* sB = (LAS float*)(lds + GL_B); LAS bf16* sK = (LAS bf16*)(lds + GL_K); LAS bf16* sV = (LAS bf16*)(lds + GL_V);
    const int fr = lane & 15, fq = lane >> 4;
    const u32x4 z4 = (u32x4){0u, 0u, 0u, 0u};
    for (int idx = blockIdx.x; idx < GLA_UNITS; idx += gridDim.x) {
        int n, b, h; gla_unit(idx, n, b, h); const int unit = n * 16 + b * 4 + h;
        f32x4 gzv = (f32x4){0.f, 0.f, 0.f, 0.f};
        if (tid < 256) { const int row = gla_row(b, n, tid >> 2); if (row >= 0) gzv = *(const f32x4*)(GZ + (size_t)row * 16 + (tid & 3) * 4); }
        float w[16];
#pragma unroll
        for (int r = 0; r < 16; ++r) w[r] = p.gla_w_up[r * 512 + h * 128 + (tid & 127)];
        const float bia = p.gla_b_gate[h * 128 + (tid & 127)];
        const int kd8 = (tid & 15) * 8, cb = tid >> 4;
        u32x4 kv[2], vv[4];
#pragma unroll
        for (int i = 0; i < 2; ++i) { const int row = gla_row(b, n, cb + 32 * i); kv[i] = (row >= 0) ? *(const u32x4*)(Kb + (size_t)row * 512 + h * 128 + kd8) : z4; }
#pragma unroll
        for (int i = 0; i < 4; ++i) { const int ii = tid + 512 * i, row = gla_row(b, n, ii >> 5); vv[i] = (row >= 0) ? *(const u32x4*)(Vb + (size_t)row * D + h * 256 + (ii & 31) * 8) : z4; }
        gla_cumdecay(lds, gzv, w, bia, n, tid);
        {
            float bl[8];
#pragma unroll
            for (int j = 0; j < 8; ++j) bl[j] = sB[63 * BSTR + kd8 + j];
#pragma unroll
            for (int i = 0; i < 2; ++i) { const int c = cb + 32 * i;
                float kf[8]; unpack8(kv[i], kf);
#pragma unroll
                for (int j = 0; j < 8; ++j) kf[j] *= __expf(bl[j] - sB[c * BSTR + kd8 + j]);
                *(LAS u32x4*)(sK + c * KSTR + kd8) = pack8f(kf); }
            if (tid < 128) pg8::wt4(Dec + (size_t)unit * 128 + tid, __expf(sB[63 * BSTR + tid]));
#pragma unroll
            for (int i = 0; i < 4; ++i) { const int ii = tid + 512 * i; *(LAS u32x4*)(sV + (ii >> 5) * VSTR + (ii & 31) * 8) = vv[i]; }
        }
        __syncthreads();
        f32x4 acc[8][2];
#pragma unroll
        for (int i = 0; i < 8; ++i)
#pragma unroll
            for (int j = 0; j < 2; ++j) acc[i][j] = (f32x4){0.f, 0.f, 0.f, 0.f};
#pragma unroll
        for (int ks = 0; ks < 2; ++ks) {
            const int r0 = 32 * ks + 8 * fq + (fr >> 2), cc = 4 * (fr & 3);
            bf16x8 Y[2];
#pragma unroll
            for (int j = 0; j < 2; ++j) { const int vd0 = 32 * wave + 16 * j; Y[j] = tr_frag(lds_u32(sV + r0 * VSTR + vd0 + cc), lds_u32(sV + (r0 + 4) * VSTR + vd0 + cc)); }
#pragma unroll
            for (int i = 0; i < 8; ++i) { const bf16x8 X = tr_frag(lds_u32(sK + r0 * KSTR + 16 * i + cc), lds_u32(sK + (r0 + 4) * KSTR + 16 * i + cc));
#pragma unroll
                for (int j = 0; j < 2; ++j) acc[i][j] = __builtin_amdgcn_mfma_f32_16x16x32_bf16(X, Y[j], acc[i][j], 0, 0, 0); }
        }
        bf16* Uu = Ub + (size_t)unit * 32768;
#pragma unroll
        for (int i = 0; i < 8; ++i)
#pragma unroll
            for (int j = 0; j < 2; ++j) { const int vd = 32 * wave + 16 * j + fr, kd = 16 * i + 4 * fq;
                u32x2 wv; wv.x = pk2(acc[i][j][0], acc[i][j][1]); wv.y = pk2(acc[i][j][2], acc[i][j][3]);
                pg8::wt8(Uu + vd * 128 + kd, wv); }
        __syncthreads();
    }
}

__device__ __forceinline__ void gla_g2(const Params& p, int tid) {
    unsigned char* big = p.ws + WS_BIG;
    bf16* Ub = (bf16*)(big + BIG_U); const float* Dec = (const float*)(big + BIG_DEC);
    for (int g = blockIdx.x * 512 + tid; g < 16 * 8192; g += gridDim.x * 512) {
        const int bh = g >> 13, e4 = (g & 8191) * 4, kd = e4 & 127;
        float S0, S1, S2, S3;
        { const size_t unit = (size_t)(bh & 3); const u32x2 u0 = *(const u32x2*)(Ub + unit * 32768 + e4); S0 = bf_lo(u0.x); S1 = bf_hi(u0.x); S2 = bf_lo(u0.y); S3 = bf_hi(u0.y); }
        for (int n0 = 1; n0 < NCH; n0 += 8) {
            u32x2 uu[8]; f32x4 dd[8];
#pragma unroll
            for (int i = 0; i < 8; ++i) { const size_t unit = (size_t)(n0 + i) * 16 + bh;
                uu[i] = *(const u32x2*)(Ub + unit * 32768 + e4); dd[i] = *(const f32x4*)(Dec + unit * 128 + kd); }
#pragma unroll
            for (int i = 0; i < 8; ++i) { const size_t unit = (size_t)(n0 + i) * 16 + bh;
                u32x2 wv; wv.x = pk2(S0, S1); wv.y = pk2(S2, S3); pg8::wt8(Ub + unit * 32768 + e4, wv);
                S0 = dd[i][0] * S0 + bf_lo(uu[i].x); S1 = dd[i][1] * S1 + bf_hi(uu[i].x); S2 = dd[i][2] * S2 + bf_lo(uu[i].y); S3 = dd[i][3] * S3 + bf_hi(uu[i].y); }
        }
    }
}

__device__ __forceinline__ void gla_g3(const Params& p, LAS unsigned char* lds, int tid, int wave, int lane) {
    unsigned char* big = p.ws + WS_BIG;
    const bf16* Qb = (const bf16*)(big + BIG_Q); const bf16* Kb = (const bf16*)(big + BIG_K); const bf16* Vb = (const bf16*)(big + BIG_V); const bf16* Gb = (const bf16*)(big + BIG_G);
    const float* GZ = (const float*)(big + BIG_GZ); const bf16* Sb = (const bf16*)(big + BIG_U); bf16* Ob = (bf16*)(p.ws + WS_HB);
    LAS float* sB = (LAS float*)(lds + GL_B); LAS float* sRed = (LAS float*)(lds + GL_RED);
    LAS bf16* sK = (LAS bf16*)(lds + GL_K); LAS bf16* sQs = (LAS bf16*)(lds + GL_QS); LAS bf16* sQi = (LAS bf16*)(lds + GL_QI); LAS bf16* sV = (LAS bf16*)(lds + GL_V); LAS bf16* sP = (LAS bf16*)(lds + GL_P);
    const int fr = lane & 15, fq = lane >> 4;
    const u32x4 z4 = (u32x4){0u, 0u, 0u, 0u};
    for (int idx = blockIdx.x; idx < GLA_UNITS; idx += gridDim.x) {
        int n, b, h; gla_unit(idx, n, b, h); const int unit = n * 16 + b * 4 + h;
        f32x4 gzv = (f32x4){0.f, 0.f, 0.f, 0.f};
        if (tid < 256) { const int row = gla_row(b, n, tid >> 2); if (row >= 0) gzv = *(const f32x4*)(GZ + (size_t)row * 16 + (tid & 3) * 4); }
        float w[16];
#pragma unroll
        for (int r = 0; r < 16; ++r) w[r] = p.gla_w_up[r * 512 + h * 128 + (tid & 127)];
        const float bia = p.gla_b_gate[h * 128 + (tid & 127)];
        const int kd8 = (tid & 15) * 8, cb = tid >> 4;
        u32x4 qv[2], kv[2], vv[4];
#pragma unroll
        for (int i = 0; i < 2; ++i) { const int row = gla_row(b, n, cb + 32 * i);
            qv[i] = (row >= 0) ? *(const u32x4*)(Qb + (size_t)row * 512 + h * 128 + kd8) : z4; kv[i] = (row >= 0) ? *(const u32x4*)(Kb + (size_t)row * 512 + h * 128 + kd8) : z4; }
#pragma unroll
        for (int i = 0; i < 4; ++i) { const int ii = tid + 512 * i, row = gla_row(b, n, ii >> 5); vv[i] = (row >= 0) ? *(const u32x4*)(Vb + (size_t)row * D + h * 256 + (ii & 31) * 8) : z4; }
        const bf16* Su = Sb + (size_t)unit * 32768;
        bf16x8 X2[4][2];
        if (n) {
#pragma unroll
            for (int ks = 0; ks < 4; ++ks)
#pragma unroll
                for (int xi = 0; xi < 2; ++xi) X2[ks][xi] = *(const bf16x8*)(Su + (32 * wave + 16 * xi + fr) * 128 + 32 * ks + 8 * fq);
        }
        u32x2 gg[4][2]; f32x4 nw[2];
#pragma unroll
        for (int xi = 0; xi < 2; ++xi) nw[xi] = *(const f32x4*)(p.gla_norm_w + 32 * wave + 16 * xi + 4 * fq);
#pragma unroll
        for (int mi = 0; mi < 4; ++mi) { const int row = gla_row(b, n, 16 * mi + fr);
#pragma unroll
            for (int xi = 0; xi < 2; ++xi) gg[mi][xi] = (row >= 0) ? *(const u32x2*)(Gb + (size_t)row * D + h * 256 + 32 * wave + 16 * xi + 4 * fq) : (u32x2){0u, 0u}; }
        gla_cumdecay(lds, gzv, w, bia, n, tid);
        {
            float br[8];
#pragma unroll
            for (int j = 0; j < 8; ++j) br[j] = sB[32 * BSTR + kd8 + j];
#pragma unroll
            for (int i = 0; i < 2; ++i) { const int c = cb + 32 * i;
                float qf[8], kf[8], qs[8], qi[8]; unpack8(qv[i], qf); unpack8(kv[i], kf);
#pragma unroll
                for (int j = 0; j < 8; ++j) { const float bb = sB[c * BSTR + kd8 + j]; const float e = __expf(bb - br[j]);
                    qs[j] = qf[j] * e; kf[j] = kf[j] * __expf(br[j] - bb); qi[j] = qf[j] * __expf(bb); }
                *(LAS u32x4*)(sQs + c * KSTR + kd8) = pack8f(qs); *(LAS u32x4*)(sK + c * KSTR + kd8) = pack8f(kf); *(LAS u32x4*)(sQi + c * KSTR + kd8) = pack8f(qi); }
#pragma unroll
            for (int i = 0; i < 4; ++i) { const int ii = tid + 512 * i; *(LAS u32x4*)(sV + (ii >> 5) * VSTR + (ii & 31) * 8) = vv[i]; }
        }
        __syncthreads();
        {
            const int ti = wave >> 1;
#pragma unroll
            for (int jj = 0; jj < 2; ++jj) {
                const int tj = 2 * (wave & 1) + jj;
                f32x4 a = (f32x4){0.f, 0.f, 0.f, 0.f};
                if (tj <= ti) {
#pragma unroll
                    for (int ks = 0; ks < 4; ++ks) {
                        const bf16x8 X = *(const LAS bf16x8*)(sK + (tj * 16 + fr) * KSTR + 32 * ks + 8 * fq);
                        const bf16x8 Y = *(const LAS bf16x8*)(sQs + (ti * 16 + fr) * KSTR + 32 * ks + 8 * fq);
                        a = __builtin_amdgcn_mfma_f32_16x16x32_bf16(X, Y, a, 0, 0, 0);
                    }
                }
                const int ci = ti * 16 + fr, cj = tj * 16 + 4 * fq;
                float e0 = (cj + 0 <= ci) ? a[0] : 0.f, e1 = (cj + 1 <= ci) ? a[1] : 0.f, e2 = (cj + 2 <= ci) ? a[2] : 0.f, e3 = (cj + 3 <= ci) ? a[3] : 0.f;
                u32x2 wv; wv.x = pk2(e0, e1); wv.y = pk2(e2, e3);
                *(LAS u32x2*)(sP + ci * PSTR + cj) = wv;
            }
        }
        __syncthreads();
        f32x4 acc[4][2];
#pragma unroll
        for (int mi = 0; mi < 4; ++mi)
#pragma unroll
            for (int xi = 0; xi < 2; ++xi) acc[mi][xi] = (f32x4){0.f, 0.f, 0.f, 0.f};
#pragma unroll
        for (int ks = 0; ks < 2; ++ks) {
            const int r0 = 32 * ks + 8 * fq + (fr >> 2), cc = 4 * (fr & 3);
            bf16x8 X1[2];
#pragma unroll
            for (int xi = 0; xi < 2; ++xi) { const int vd0 = 32 * wave + 16 * xi; X1[xi] = tr_frag(lds_u32(sV + r0 * VSTR + vd0 + cc), lds_u32(sV + (r0 + 4) * VSTR + vd0 + cc)); }
#pragma unroll
            for (int mi = 0; mi < 4; ++mi) { const bf16x8 Y1 = *(const LAS bf16x8*)(sP + (16 * mi + fr) * PSTR + 32 * ks + 8 * fq);
#pragma unroll
                for (int xi = 0; xi < 2; ++xi) acc[mi][xi] = __builtin_amdgcn_mfma_f32_16x16x32_bf16(X1[xi], Y1, acc[mi][xi], 0, 0, 0); }
        }
        if (n) {
#pragma unroll
            for (int ks = 0; ks < 4; ++ks) {
#pragma unroll
                for (int mi = 0; mi < 4; ++mi) { const bf16x8 Y2 = *(const LAS bf16x8*)(sQi + (16 * mi + fr) * KSTR + 32 * ks + 8 * fq);
#pragma unroll
                    for (int xi = 0; xi < 2; ++xi) acc[mi][xi] = __builtin_amdgcn_mfma_f32_16x16x32_bf16(X2[ks][xi], Y2, acc[mi][xi], 0, 0, 0); }
            }
        }
#pragma unroll
        for (int mi = 0; mi < 4; ++mi) { float ss = 0.f;
#pragma unroll
            for (int xi = 0; xi < 2; ++xi) ss += (acc[mi][xi][0] * acc[mi][xi][0] + acc[mi][xi][1] * acc[mi][xi][1]) + (acc[mi][xi][2] * acc[mi][xi][2] + acc[mi][xi][3] * acc[mi][xi][3]);
            ss += __shfl_xor(ss, 16); ss += __shfl_xor(ss, 32);
            if (fq == 0) sRed[wave * 64 + 16 * mi + fr] = ss; }
        __syncthreads();
#pragma unroll
        for (int mi = 0; mi < 4; ++mi) {
            const int c = 16 * mi + fr, row = gla_row(b, n, c);
            float tot = 0.f;
#pragma unroll
            for (int w2 = 0; w2 < 8; ++w2) tot += sRed[w2 * 64 + c];
            const float rinv = 1.0f / sqrtf(tot * (1.0f / 256.0f) + RMS_EPS);
            if (row >= 0) {
#pragma unroll
                for (int xi = 0; xi < 2; ++xi) { const int vd = 32 * wave + 16 * xi + 4 * fq;
                    const float o0 = acc[mi][xi][0] * rinv * nw[xi][0] * bf_lo(gg[mi][xi].x), o1 = acc[mi][xi][1] * rinv * nw[xi][1] * bf_hi(gg[mi][xi].x);
                    const float o2 = acc[mi][xi][2] * rinv * nw[xi][2] * bf_lo(gg[mi][xi].y), o3 = acc[mi][xi][3] * rinv * nw[xi][3] * bf_hi(gg[mi][xi].y);
                    u32x2 wv; wv.x = pk2(o0, o1); wv.y = pk2(o2, o3);
                    pg8::wt8(Ob + (size_t)row * D + h * 256 + vd, wv); }
            }
        }
        __syncthreads();
    }
}

typedef __attribute__((address_space(1))) unsigned gu32;
#define XB_TMO      128
#define XB_XCNT(j)  (256  + 64 * (j))
#define XB_XSUB(j)  (1280 + 64 * (j))
#define XB_XGEN(j)  (2304 + 64 * (j))
#define XB_TOP      3328
#define XB_TOPGEN   3392
#define XCD_BAR_WORDS 3456
#define XB_SPIN_CAP (1u << 18)

__device__ __forceinline__ unsigned xb_ld(unsigned* p)              { return __hip_atomic_load(p, __ATOMIC_RELAXED, __HIP_MEMORY_SCOPE_AGENT); }
__device__ __forceinline__ unsigned xb_add(unsigned* p, unsigned v) { return __hip_atomic_fetch_add(p, v, __ATOMIC_RELAXED, __HIP_MEMORY_SCOPE_AGENT); }
__device__ __forceinline__ unsigned xb_xcc_id() { return (unsigned)__builtin_amdgcn_s_getreg((3 << 11) | 20) & 0xFu; }
#define XB_SPIN(cond, bar) do { unsigned _sp = 0; while (cond) { __builtin_amdgcn_s_sleep(1); \
    if ((++_sp & 255u) == 0u) { if (xb_ld(&(bar)[XB_TMO])) break; if (_sp > XB_SPIN_CAP) { atomicAdd(&(bar)[XB_TMO], 1u); break; } } } } while (0)

struct XcdBarrier {
    unsigned* bar; unsigned x;
    volatile LAS unsigned* st;
};

__device__ __forceinline__ XcdBarrier xcd_barrier_post(unsigned* bar, volatile LAS unsigned* st) {
    XcdBarrier b; b.bar = bar; b.x = xb_xcc_id(); b.st = st;
    if (threadIdx.x == 0) (void)xb_add(&bar[XB_XCNT(b.x)], 1u);
    return b;
}
__device__ __forceinline__ void xcd_barrier_complete(unsigned* bar, unsigned x, unsigned& nloc, unsigned& nx) {
    const unsigned G = gridDim.x * gridDim.y * gridDim.z;
    unsigned sum, cnt, mine, sp = 0u;
    for (;;) {
        sum = 0u; cnt = 0u; mine = 0u;
#pragma unroll
        for (unsigned j = 0; j < 16; ++j) { const unsigned c = xb_ld(&bar[XB_XCNT(j)]); sum += c; cnt += (c > 0u) ? 1u : 0u; mine = (j == x) ? c : mine; }
        if (sum == G) break;
        __builtin_amdgcn_s_sleep(1);
        if ((++sp & 255u) == 0u) { if (xb_ld(&bar[XB_TMO])) break; if (sp > XB_SPIN_CAP) { atomicAdd(&bar[XB_TMO], 1u); break; } }
    }
    nloc = mine > 0u ? mine : 1u; nx = cnt > 0u ? cnt : 1u;
}

__device__ __forceinline__ void xcd_barrier(const XcdBarrier& b) {
    asm volatile("s_waitcnt vmcnt(0)" ::: "memory");
    __syncthreads();
    if (threadIdx.x == 0) {
        unsigned* bar = b.bar;
        __builtin_amdgcn_s_waitcnt(0);
        unsigned nloc = b.st[0], nx = b.st[1];
        if (nloc == 0u) { xcd_barrier_complete(bar, b.x, nloc, nx); b.st[0] = nloc; b.st[1] = nx; }
        const unsigned old = xb_add(&bar[XB_XSUB(b.x)], 1u);
        const unsigned gen = old / nloc;
        if (old + 1u == (gen + 1u) * nloc) {
            asm volatile("s_waitcnt vmcnt(0)" ::: "memory");
            const unsigned og = xb_add(&bar[XB_TOP], 1u);
            const unsigned tg = og / nx;
            if (og + 1u == (tg + 1u) * nx) xb_add(&bar[XB_TOPGEN], 1u);
            else XB_SPIN(xb_ld(&bar[XB_TOPGEN]) == tg, bar);
            __builtin_amdgcn_fence(__ATOMIC_ACQUIRE, "agent");
            xb_add(&bar[XB_XGEN(b.x)], 1u);
            asm volatile("s_waitcnt vmcnt(0)" ::: "memory");
        } else {
            XB_SPIN(xb_ld(&bar[XB_XGEN(b.x)]) == gen, bar);
            __builtin_amdgcn_fence(__ATOMIC_ACQUIRE, "agent");
            asm volatile("s_waitcnt vmcnt(0)" ::: "memory");
        }
    }
    __syncthreads();
}

__device__ __forceinline__ void mini_gemm(LAS unsigned char* lds, const bf16* A, const bf16* B0, const bf16* B1, int K, int wave, int lane, f32x4& r0, f32x4& r1) {
    const int fr = lane & 15, fq = lane >> 4;
    f32x4 a0 = (f32x4){0.f, 0.f, 0.f, 0.f}, a1 = a0;
    const bf16* ap = A + (size_t)fr * K + 8 * fq; const bf16* b0p = B0 + (size_t)fr * K + 8 * fq; const bf16* b1p = B1 + (size_t)fr * K + 8 * fq;
    for (int ks = wave; ks < K / 32; ks += 8) {
        const bf16x8 af = *(const bf16x8*)(ap + 32 * ks), b0 = *(const bf16x8*)(b0p + 32 * ks), b1 = *(const bf16x8*)(b1p + 32 * ks);
        a0 = __builtin_amdgcn_mfma_f32_16x16x32_bf16(b0, af, a0, 0, 0, 0);
        a1 = __builtin_amdgcn_mfma_f32_16x16x32_bf16(b1, af, a1, 0, 0, 0);
    }
    LAS f32x4* red = (LAS f32x4*)lds;
    red[(wave * 2 + 0) * 64 + lane] = a0; red[(wave * 2 + 1) * 64 + lane] = a1;
    __syncthreads();
    if (wave == 0) {
        r0 = red[lane]; r1 = red[64 + lane];
#pragma unroll
        for (int w = 1; w < 8; ++w) { r0 += red[(w * 2) * 64 + lane]; r1 += red[(w * 2 + 1) * 64 + lane]; }
    }
    __syncthreads();
}
__device__ __forceinline__ u32x2 pack4(const f32x4 v) { u32x2 w; w.x = pk2(v[0], v[1]); w.y = pk2(v[2], v[3]); return w; }
__device__ __forceinline__ void mini_ffn_in(LAS unsigned char* lds, const bf16* HB, const bf16* Wt, bf16* ACT, int t, int wave, int lane) {
    const int pn = t >> 3, j0 = (t & 7) * 16; f32x4 g, u;
    mini_gemm(lds, HB + (size_t)MMETA0 * D, Wt + (size_t)(256 * pn + j0) * D, Wt + (size_t)(256 * pn + 128 + j0) * D, D, wave, lane, g, u);
    if (wave == 0) { f32x4 a;
#pragma unroll
        for (int j = 0; j < 4; ++j) a[j] = pg8::silu_f(g[j]) * u[j];
        pg8::wt8(ACT + (size_t)(MMETA0 + (lane & 15)) * FF + 16 * t + 4 * (lane >> 4), pack4(a)); }
}
__device__ __forceinline__ void mini_resid(LAS unsigned char* lds, const bf16* A, int K, const bf16* Wt, const float* src, float* dst, const float* stats, const float* gain, const float* bias, float scale, int t, int wave, int lane) {
    f32x4 r[2];
    mini_gemm(lds, A + (size_t)MMETA0 * K, Wt + (size_t)(32 * t) * K, Wt + (size_t)(32 * t + 16) * K, K, wave, lane, r[0], r[1]);
    if (wave == 0) { const int row = lane & 15; float mean = 0.f, rstd = 1.f;
        if (stats) { mean = stats[(size_t)(MMETA0 + row) * 2]; rstd = stats[(size_t)(MMETA0 + row) * 2 + 1]; }
#pragma unroll
        for (int q = 0; q < 2; ++q) { const int col = 32 * t + 16 * q + 4 * (lane >> 4);
            const f32x4 x = *(const f32x4*)(src + (size_t)row * D + col);
            f32x4 h = x;
            if (stats) h = (x - mean) * rstd * *(const f32x4*)(gain + col) + *(const f32x4*)(bias + col);
            pg8::wt16(dst + (size_t)row * D + col, h * ALPHA + r[q] * scale); } }
}
__device__ __forceinline__ void mini_conv_in(LAS unsigned char* lds, const bf16* HB, const bf16* Wt, bf16* CU, bf16* BG, int t, int wave, int lane) {
    f32x4 a, b;
    if (t < 64) { const int pn = t >> 3, j0 = (t & 7) * 16;
        mini_gemm(lds, HB + (size_t)MMETA0 * D, Wt + (size_t)(256 * pn + j0) * D, Wt + (size_t)(256 * pn + 128 + j0) * D, D, wave, lane, a, b);
        if (wave == 0) pg8::wt8(CU + (size_t)(MMETA0 + (lane & 15)) * D + 16 * t + 4 * (lane >> 4), pack4(a * b));
    } else { const int c0 = 16 * (t - 64);
        mini_gemm(lds, HB + (size_t)MMETA0 * D, Wt + (size_t)(2048 + c0) * D, Wt + (size_t)(2048 + c0) * D, D, wave, lane, a, b);
        if (wave == 0) pg8::wt8(BG + (size_t)(MMETA0 + (lane & 15)) * D + c0 + 4 * (lane >> 4), pack4(a)); }
}
__device__ __forceinline__ void mini_gla_in(LAS unsigned char* lds, const bf16* HB, const bf16* Wt, bf16* Q, bf16* Kk, bf16* V, bf16* G, float qscale, int t, int wave, int lane) {
    f32x4 r[2];
    mini_gemm(lds, HB + (size_t)MMETA0 * D, Wt + (size_t)(32 * t) * D, Wt + (size_t)(32 * t + 16) * D, D, wave, lane, r[0], r[1]);
    if (wave == 0) { const size_t row = MMETA0 + (lane & 15);
#pragma unroll
        for (int q = 0; q < 2; ++q) { const int c = 32 * t + 16 * q + 4 * (lane >> 4); f32x4 v = r[q];
            if (c < 512) pg8::wt8(Q + row * 512 + c, pack4(v * qscale));
            else if (c < 1024) pg8::wt8(Kk + row * 512 + (c - 512), pack4(v));
            else if (c < 2048) pg8::wt8(V + row * D + (c - 1024), pack4(v));
            else {
#pragma unroll
                for (int j = 0; j < 4; ++j) v[j] = pg8::silu_f(v[j]);
                pg8::wt8(G + row * D + (c - 2048), pack4(v)); } } }
}
__device__ __forceinline__ void gz_phase(const bf16* HB, const bf16* Wgz, float* GZ, int gw, int NGW, int lane) {
    const int fr = lane & 15, fq = lane >> 4;
    for (int rb = gw; rb < MREAL / 16 + 1; rb += NGW) {
        const size_t row0 = (size_t)rb * 16;
        const bf16* ap = HB + (row0 + fr) * D + 8 * fq; const bf16* bp = Wgz + (size_t)fr * D + 8 * fq;
        f32x4 a0 = (f32x4){0.f, 0.f, 0.f, 0.f}, a1 = a0;
#pragma unroll 4
        for (int ks = 0; ks < D / 32; ks += 2) {
            a0 = __builtin_amdgcn_mfma_f32_16x16x32_bf16(*(const bf16x8*)(bp + 32 * ks), *(const bf16x8*)(ap + 32 * ks), a0, 0, 0, 0);
            a1 = __builtin_amdgcn_mfma_f32_16x16x32_bf16(*(const bf16x8*)(bp + 32 * ks + 32), *(const bf16x8*)(ap + 32 * ks + 32), a1, 0, 0, 0);
        }
        pg8::wt16(GZ + (row0 + fr) * 16 + 4 * fq, a0 + a1);
    }
}


#ifndef REP_G1
#define REP_G1 1
#endif
#ifndef REP_G2
#define REP_G2 0
#endif
#ifndef REP_LN
#define REP_LN 1
#endif
#ifndef REP_GLA
#define REP_GLA 1
#endif
#ifndef REP_SYNC
#define REP_SYNC 0
#endif
#ifndef REP_MIX
#define REP_MIX 1
#endif
template <class Epi>
__device__ __forceinline__ void run_gemm(LAS unsigned char* lds, const bf16* A, const bf16* Bt, int N, int K, const Epi& E) {
    pg8::Gemm g{A, Bt, MREAL, N, K}; pg8::StaticOrder S; S.init(MREAL, N, (int)gridDim.x, (int)blockIdx.x);
    pg8::gemm_phase<Epi, pg8::StaticOrder, true, true>(lds, g, S, E);
}

__global__ void __launch_bounds__(512, 2) fwd_megakernel(Params p) {
    extern __shared__ __attribute__((aligned(16))) unsigned char lds_raw[];
    LAS unsigned char* lds = (LAS unsigned char*)lds_raw;
    cg::grid_group grid = cg::this_grid();
    if (threadIdx.x < 16) ((LAS unsigned*)(lds + LDS_BYTES - 64))[threadIdx.x] = 0u;
    __syncthreads();
    const XcdBarrier xbar = xcd_barrier_post((unsigned*)(p.ws + WS_BAR), (volatile LAS unsigned*)(lds + LDS_BYTES - 64));
#define GSYNC() xcd_barrier(xbar)
    const int tid0 = threadIdx.x;
#define FRESH_IDS() int tid = tid0; asm volatile("" : "+v"(tid)); const int lane = tid & 63, wave = __builtin_amdgcn_readfirstlane(tid >> 6); const int gw = vcu * 8 + wave
    const int G = gridDim.x, bx = blockIdx.x;
    const int vcu = (G % 8 == 0) ? (bx % 8) * (G / 8) + bx / 8 : bx;
    const int NGW = G * 8;
    unsigned char* ws = p.ws; unsigned char* big = ws + WS_BIG;
    bf16* HB = (bf16*)(ws + WS_HB); float* XM = (float*)(ws + WS_XM); float* METAR = (float*)(ws + WS_METAR); float* STATS = (float*)(ws + WS_STATS);
    bf16* ACT = (bf16*)(big + BIG_ACT);

#ifndef NO_P0
    { FRESH_IDS(); p0_prologue(p, lds, gw, NGW, wave, lane); }
#endif
    grid.sync();

    int lnk = 0;
#pragma clang loop unroll(disable)
    for (int blk = 0; blk < 4; ++blk) {
        {
            { FRESH_IDS(); if (bx < 176) mini_ffn_in(lds, HB, (const bf16*)(ws + WS_WFI + (size_t)blk * SZ_WFI), ACT, bx, wave, lane); }
            pg8::EpiSwiGLU E1{ACT, FF};
            for (int rep = 0; rep < REP_G1; ++rep) run_gemm(lds, HB, (const bf16*)(ws + WS_WFI + (size_t)blk * SZ_WFI), 2 * FF, D, E1);
            GSYNC();
            pg8::EpiResid E2;
            if (lnk == 0) E2 = pg8::EpiResid{p.x, METAR, p.out, XM, nullptr, nullptr, nullptr, ALPHA, 0.5f};
            else E2 = pg8::EpiResid{p.out, XM, p.out, XM, STATS, p.ln_gain + (lnk - 1) * D, p.ln_bias + (lnk - 1) * D, ALPHA, 0.5f};
            { FRESH_IDS(); if (bx >= 64 && bx < 96) mini_resid(lds, ACT, FF, (const bf16*)(ws + WS_WFO + (size_t)blk * SZ_WFO), lnk == 0 ? METAR : XM, XM, E2.stats, E2.gain, E2.bias, 0.5f, bx - 64, wave, lane); }
            for (int rep = 0; rep < REP_G2; ++rep) { pg8::EpiResid E3 = E2; E3.Oreal = (float*)(big + BIG_U); run_gemm(lds, ACT, (const bf16*)(ws + WS_WFO + (size_t)blk * SZ_WFO), D, FF, E3); }
            run_gemm(lds, ACT, (const bf16*)(ws + WS_WFO + (size_t)blk * SZ_WFO), D, FF, E2);
            GSYNC();
            if (blk == 3) { FRESH_IDS(); ln_phase<true>(p.out, XM, p.ln_gain + 5 * D, p.ln_bias + 5 * D, nullptr, nullptr, p.out, gw, NGW, lane); break; }
            for (int rep = 0; rep < REP_LN; ++rep) { FRESH_IDS(); ln_phase<false>(p.out, XM, p.ln_gain + lnk * D, p.ln_bias + lnk * D, HB, STATS, nullptr, gw, NGW, lane); } ++lnk;
            for (int rep = 0; rep < REP_SYNC; ++rep) GSYNC();
            GSYNC();
        }
        if (blk == 0 || blk == 2) {
            const bf16* Wo;
            if (blk == 0) {
                { FRESH_IDS(); if (bx < 128) mini_conv_in(lds, HB, (const bf16*)(ws + WS_WCI), (bf16*)(big + BIG_CU), (bf16*)(big + BIG_BG), bx, wave, lane); }
                pg8::EpiConvIn Ec{(bf16*)(big + BIG_CU), (bf16*)(big + BIG_BG)};
                run_gemm(lds, HB, (const bf16*)(ws + WS_WCI), 3072, D, Ec);
                GSYNC();
#ifndef NO_CM
                for (int rep = 0; rep < REP_MIX; ++rep) { FRESH_IDS(); conv_mix_phase((const bf16*)(big + BIG_BG), (const bf16*)(big + BIG_CU), p.conv_w, HB, gw, NGW, lane); }
#endif
                GSYNC();
                Wo = (const bf16*)(ws + WS_WCO);
            } else {
                { FRESH_IDS(); gz_phase(HB, (const bf16*)(ws + WS_WGI) + (size_t)3072 * D, (float*)(big + BIG_GZ), gw, NGW, lane);
                  if (bx >= 128 && bx < 224) mini_gla_in(lds, HB, (const bf16*)(ws + WS_WGI), (bf16*)(big + BIG_Q), (bf16*)(big + BIG_K), (bf16*)(big + BIG_V), (bf16*)(big + BIG_G), 0.08838834764831845f, bx - 128, wave, lane); }
                pg8::EpiGlaIn Eg{(bf16*)(big + BIG_Q), (bf16*)(big + BIG_K), (bf16*)(big + BIG_V), (bf16*)(big + BIG_G), (float*)(big + BIG_GZ), 0.08838834764831845f};
                run_gemm(lds, HB, (const bf16*)(ws + WS_WGI), 3072, D, Eg);
                GSYNC();
#ifndef NO_G1
                for (int rep = 0; rep < REP_GLA; ++rep) { FRESH_IDS(); gla_g1(p, lds, tid, wave, lane); }
#endif
                GSYNC();
#ifndef NO_G2
                { FRESH_IDS(); gla_g2(p, tid); }
#endif
                GSYNC();
#ifndef NO_G3
                for (int rep = 0; rep < REP_GLA; ++rep) { FRESH_IDS(); gla_g3(p, lds, tid, wave, lane); }
#endif
                GSYNC();
                Wo = (const bf16*)(ws + WS_WGO);
            }
            pg8::EpiResid Eo{p.out, XM, p.out, XM, STATS, p.ln_gain + (lnk - 1) * D, p.ln_bias + (lnk - 1) * D, ALPHA, 1.0f};
            { FRESH_IDS(); if (bx >= 32 && bx < 64) mini_resid(lds, HB, D, Wo, XM, XM, STATS, Eo.gain, Eo.bias, 1.0f, bx - 32, wave, lane); }
            run_gemm(lds, HB, Wo, D, D, Eo);
            GSYNC();
            for (int rep = 0; rep < REP_LN; ++rep) { FRESH_IDS(); ln_phase<false>(p.out, XM, p.ln_gain + lnk * D, p.ln_bias + lnk * D, HB, STATS, nullptr, gw, NGW, lane); } ++lnk;
            for (int rep = 0; rep < REP_SYNC; ++rep) GSYNC();
            GSYNC();
        }
    }
}

extern "C" void kernel_launch(void* const* d_in, const int* in_sizes, int n_in, void* d_out, int out_size, void* d_ws, size_t ws_size, hipStream_t stream) {
    static int grid_blocks = 0;
    if (grid_blocks == 0) {
        if (n_in != 14 || out_size != MREAL * D || ws_size < WS_END) { fprintf(stderr, "kernel_launch: unexpected shapes: n_in %d out %d ws %zu (need %zu)\n", n_in, out_size, ws_size, (size_t)WS_END); grid_blocks = -1; return; }
        int dev = 0, cus = 0, per_cu = 0;
        hipGetDevice(&dev); hipDeviceGetAttribute(&cus, hipDeviceAttributeMultiprocessorCount, dev);
        if (hipFuncSetAttribute((const void*)fwd_megakernel, hipFuncAttributeMaxDynamicSharedMemorySize, LDS_BYTES) != hipSuccess) { fprintf(stderr, "kernel_launch: hipFuncSetAttribute failed\n"); grid_blocks = -1; return; }
        if (hipOccupancyMaxActiveBlocksPerMultiprocessor(&per_cu, (const void*)fwd_megakernel, 512, LDS_BYTES) != hipSuccess || per_cu < 1) { fprintf(stderr, "kernel_launch: occupancy query says %d\n", per_cu); per_cu = 1; }
        (void)hipGetLastError();
        grid_blocks = cus * 1;
    }
    if (grid_blocks < 0) return;
    Params p{};
    p.x = (const float*)d_in[0]; p.meta = (const float*)d_in[1]; p.ln_gain = (const float*)d_in[2]; p.ln_bias = (const float*)d_in[3];
    p.ffn_w_in = (const float*)d_in[4]; p.ffn_w_out = (const float*)d_in[5]; p.conv_w_in = (const float*)d_in[6]; p.conv_w = (const float*)d_in[7];
    p.conv_w_out = (const float*)d_in[8]; p.gla_w_in = (const float*)d_in[9]; p.gla_w_up = (const float*)d_in[10]; p.gla_b_gate = (const float*)d_in[11];
    p.gla_norm_w = (const float*)d_in[12]; p.gla_w_out = (const float*)d_in[13]; p.out = (float*)d_out; p.ws = (unsigned char*)d_ws;
    if (hipMemsetAsync((char*)d_ws + WS_BAR, 0, WS_BAR_BYTES, stream) != hipSuccess) { fprintf(stderr, "kernel_launch: memset of barrier words failed\n"); return; }
    void* args[] = {&p};
    hipError_t e = hipLaunchCooperativeKernel((const void*)fwd_megakernel, dim3(grid_blocks), dim3(512), args, LDS_BYTES, stream);
    if (e != hipSuccess) fprintf(stderr, "cooperative launch failed: %s (grid %d)\n", hipGetErrorString(e), grid_blocks);
}
```

```cpp
#include <hip/hip_runtime.h>
#include <hip/hip_cooperative_groups.h>
#include <cstdio>
#include <cstdint>
namespace cg = cooperative_groups;

namespace pg8 {
#define PG8_LAS __attribute__((address_space(3)))
typedef unsigned short bf16_t;
typedef short bf16x8 __attribute__((ext_vector_type(8)));
typedef float f32x4 __attribute__((ext_vector_type(4)));
typedef unsigned u32x4 __attribute__((ext_vector_type(4)));
typedef unsigned u32x2 __attribute__((ext_vector_type(2)));
constexpr int BM = 256, BK = 64, HALF = 128, HTB = HALF * BK * 2  , STAGE_BYTES = 8 * HTB, NXCD = 8, WGM = 8;

__host__ __device__ __forceinline__ int lds_byte(int r, int c) { const int st = (r >> 4) * 2 + (c >> 5), rr = r & 15, cc = c & 31, ob = rr * 64 + cc * 2; return st * 1024 + (ob ^ (((ob >> 9) & 1) << 5)); }
__host__ __device__ __forceinline__ void stage_rc(int b, int& R, int& C) { const int st = b / 1024, sb = b % 1024, swz = sb ^ (((sb >> 9) & 1) << 5); R = (st >> 1) * 16 + swz / 64; C = (st & 1) * 32 + (swz % 64) / 2; }
__host__ __device__ __forceinline__ int perm32(int rho) { const int n = rho >> 4, i = rho & 15; return 8 * (i >> 2) + 4 * n + (i & 3); }

struct Unit { int pm, pn; };
struct Gemm { const bf16_t* A; const bf16_t* Bt; int M, N, K; };

struct StaticOrder {
    int nM, nN, nwg, G, c;
    __host__ __device__ void init(int M, int N, int G_, int c_) { nM = M / BM; nN = N / BM; nwg = nM * nN; G = G_; c = c_; }
    __host__ __device__ bool next(int i, Unit& u) const {
        const long L = (long)i * G + c; if (L >= nwg) return false;
        int wgid = (int)L; { const int q = nwg / NXCD, r = nwg % NXCD, xcd = wgid % NXCD, off = wgid / NXCD; wgid = (xcd < r ? xcd * (q + 1) : r * (q + 1) + (xcd - r) * q) + off; }
        const int nig = WGM * nN, gid = wgid / nig, fm = gid * WGM, gsz = (nM - fm) < WGM ? (nM - fm) : WGM;
        u.pm = fm + ((wgid % nig) % gsz); u.pn = (wgid % nig) / gsz; return true;
    }
    __device__ __forceinline__ void a_ready(const Unit&) const {}
    __device__ __forceinline__ void done(const Unit&) const {}
};

__device__ __forceinline__ unsigned cvt_pk_bf16(float lo, float hi) { unsigned r; asm volatile("v_cvt_pk_bf16_f32 %0, %1, %2" : "=v"(r) : "v"(lo), "v"(hi)); return r; }
__device__ __forceinline__ float silu_f(float x) { return x * __builtin_amdgcn_rcpf(1.0f + __builtin_amdgcn_exp2f(-1.44269504089f * x)); }
__device__ __forceinline__ u32x4 pack8(const f32x4 a, const f32x4 b) { u32x4 w; w.x = cvt_pk_bf16(a[0], a[1]); w.y = cvt_pk_bf16(a[2], a[3]); w.z = cvt_pk_bf16(b[0], b[1]); w.w = cvt_pk_bf16(b[2], b[3]); return w; }
__device__ __forceinline__ void wt16(void* p, u32x4 v) { asm volatile("global_store_dwordx4 %0, %1, off sc1\n\ts_nop 1" :: "v"(p), "v"(v)); }
__device__ __forceinline__ void wt16(void* p, f32x4 v) { asm volatile("global_store_dwordx4 %0, %1, off sc1\n\ts_nop 1" :: "v"(p), "v"(v)); }
__device__ __forceinline__ void wt8(void* p, unsigned long long v) { __hip_atomic_store((unsigned long long*)p, v, __ATOMIC_RELAXED, __HIP_MEMORY_SCOPE_AGENT); }
__device__ __forceinline__ void wt8(void* p, u32x2 v) { wt8(p, (unsigned long long)v.x | ((unsigned long long)v.y << 32)); }
__device__ __forceinline__ void wt4(float* p, float v) { __hip_atomic_store(p, v, __ATOMIC_RELAXED, __HIP_MEMORY_SCOPE_AGENT); }

constexpr int MROWS_REAL = 32768;

struct EpiSwiGLU {
    static constexpr bool PERM = true, AFTER_DRAIN = false;
    bf16_t* O; int ldc;
    __device__ __forceinline__ void operator()(const f32x4 (&acc)[2][2][4][2], const Unit& u, int wr, int wc, int fr, int fq) const {
        const int row0 = u.pm * BM + wr * 64 + fr, col0 = u.pn * HALF + wc * 32 + 8 * fq;
#pragma unroll
        for (int ai = 0; ai < 2; ++ai)
#pragma unroll
            for (int m = 0; m < 4; ++m) {
                bf16_t* rowp = O + (size_t)(row0 + ai * HALF + m * 16) * ldc + col0;
                f32x4 a0, a1;
#pragma unroll
                for (int j = 0; j < 4; ++j) { a0[j] = silu_f(acc[ai][0][m][0][j]) * acc[ai][1][m][0][j]; a1[j] = silu_f(acc[ai][0][m][1][j]) * acc[ai][1][m][1][j]; }
                wt16(rowp, pack8(a0, a1));
            }
    }
};

struct EpiResid {
    static constexpr bool PERM = false, AFTER_DRAIN = false;
    const float* Rreal; const float* Rmeta; float* Oreal; float* Ometa; const float* stats; const float* gain; const float* bias; float alpha, scale;
    __device__ __forceinline__ void operator()(const f32x4 (&acc)[2][2][4][2], const Unit& u, int wr, int wc, int fr, int fq) const {
        const float* src = Rreal + (size_t)u.pm * BM * 1024;
        float* dst = Oreal + (size_t)u.pm * BM * 1024;
        const int r0 = wr * 64 + fr, col0 = u.pn * BM + wc * 32 + 4 * fq;
        float mean[2][4], rstd[2][4];
#pragma unroll
        for (int ai = 0; ai < 2; ++ai)
#pragma unroll
            for (int m = 0; m < 4; ++m) {
                mean[ai][m] = 0.f; rstd[ai][m] = 1.f;
                if (stats) { const float2 s = *(const float2*)(stats + (size_t)(u.pm * BM + r0 + ai * HALF + m * 16) * 2); mean[ai][m] = s.x; rstd[ai][m] = s.y; }
            }
#pragma unroll
        for (int bj = 0; bj < 2; ++bj)
#pragma unroll
            for (int n = 0; n < 2; ++n) {
                const int c = col0 + bj * HALF + n * 16;
                f32x4 gv = (f32x4){1.f, 1.f, 1.f, 1.f}, bv = (f32x4){0.f, 0.f, 0.f, 0.f};
                if (stats) { gv = *(const f32x4*)(gain + c); bv = *(const f32x4*)(bias + c); }
#pragma unroll
                for (int ai = 0; ai < 2; ++ai)
#pragma unroll
                    for (int m = 0; m < 4; ++m) {
                        const size_t off = (size_t)(r0 + ai * HALF + m * 16) * 1024 + c;
                        const f32x4 x = *(const f32x4*)(src + off);
                        const f32x4 h = (x - mean[ai][m]) * rstd[ai][m] * gv + bv;
                        wt16(dst + off, h * alpha + acc[ai][bj][m][n] * scale);
                    }
                asm volatile("" ::: "memory");
            }
    }
};

struct EpiConvIn {
    static constexpr bool PERM = true, AFTER_DRAIN = false;
    bf16_t* CU; bf16_t* BG;
    __device__ __forceinline__ void operator()(const f32x4 (&acc)[2][2][4][2], const Unit& u, int wr, int wc, int fr, int fq) const {
        const int row0 = u.pm * BM + wr * 64 + fr;
        if (u.pn < 8) {
            const int col0 = u.pn * HALF + wc * 32 + 8 * fq;
#pragma unroll
            for (int ai = 0; ai < 2; ++ai)
#pragma unroll
                for (int m = 0; m < 4; ++m) {
                    bf16_t* rowp = CU + (size_t)(row0 + ai * HALF + m * 16) * 1024 + col0;
                    wt16(rowp, pack8(acc[ai][0][m][0] * acc[ai][1][m][0], acc[ai][0][m][1] * acc[ai][1][m][1]));
                }
        } else {
            const int col0 = (u.pn - 8) * BM + wc * 32 + 8 * fq;
#pragma unroll
            for (int ai = 0; ai < 2; ++ai)
#pragma unroll
                for (int m = 0; m < 4; ++m) {
                    bf16_t* rowp = BG + (size_t)(row0 + ai * HALF + m * 16) * 1024 + col0;
#pragma unroll
                    for (int bj = 0; bj < 2; ++bj) wt16(rowp + bj * HALF, pack8(acc[ai][bj][m][0], acc[ai][bj][m][1]));
                }
        }
    }
};

struct EpiGlaIn {
    static constexpr bool PERM = true, AFTER_DRAIN = false;
    bf16_t* Q; bf16_t* Kk; bf16_t* V; bf16_t* G; float* GZ; float qscale;
    __device__ __forceinline__ void operator()(const f32x4 (&acc)[2][2][4][2], const Unit& u, int wr, int wc, int fr, int fq) const {
        const int row0 = u.pm * BM + wr * 64 + fr;
        bf16_t* base; int ld, colt; float sc = 1.f; bool act = false;
        if (u.pn < 2) { base = Q; ld = 512; colt = u.pn * BM; sc = qscale; }
        else if (u.pn < 4) { base = Kk; ld = 512; colt = (u.pn - 2) * BM; }
        else if (u.pn < 8) { base = V; ld = 1024; colt = (u.pn - 4) * BM; }
        else { base = G; ld = 1024; colt = (u.pn - 8) * BM; act = true; }
        const int col0 = colt + wc * 32 + 8 * fq;
#pragma unroll
        for (int ai = 0; ai < 2; ++ai)
#pragma unroll
            for (int m = 0; m < 4; ++m) {
                bf16_t* rowp = base + (size_t)(row0 + ai * HALF + m * 16) * ld + col0;
#pragma unroll
                for (int bj = 0; bj < 2; ++bj) {
                    f32x4 v0 = acc[ai][bj][m][0] * sc, v1 = acc[ai][bj][m][1] * sc;
                    if (act) {
#pragma unroll
                        for (int j = 0; j < 4; ++j) { v0[j] = silu_f(v0[j]); v1[j] = silu_f(v1[j]); }
                    }
                    wt16(rowp + bj * HALF, pack8(v0, v1));
                }
            }
    }
};

template <class Epi, class Sched, bool ALIGN_EPI = false, bool SP2 = false>
__device__ __forceinline__ void gemm_phase(PG8_LAS unsigned char* lds, const Gemm g, const Sched& S, const Epi& E) {
    int tid_ = threadIdx.x; asm volatile("" : "+v"(tid_));
    const int tid = tid_, wid = __builtin_amdgcn_readfirstlane(tid >> 6), lane = tid & 63, wr = wid >> 2, wc = wid & 3, fr = lane & 15, fq = lane >> 4;
    const int K = g.K, nt = K / BK;
    unsigned voffA[2], voffB[2];
#pragma unroll
    for (int i = 0; i < 2; ++i) { int R, C; stage_rc(tid * 16 + i * 8192, R, C); const int Rb = Epi::PERM ? ((R & ~31) + perm32(R & 31)) : R;
        voffA[i] = (unsigned)(R * K + C) * 2u; voffB[i] = (unsigned)(Rb * K + C) * 2u; }
    const size_t kstep = (size_t)(BK * 2);
    const size_t hstep = (size_t)HALF * K * 2;
    const size_t tstep = 2 * hstep;
    const unsigned ldsw = (unsigned)wid * 1024u;
    const int aoff = lds_byte(wr * 64 + fr, fq * 8), boff = lds_byte(wc * 32 + fr, fq * 8);
#define PG8_SA(b, h) (((b) * 2 + (h)) * HTB)
#define PG8_SB(b, h) ((4 + (b) * 2 + (h)) * HTB)
#define PG8_STAGE(bufoff, gbase, voff) do { _Pragma("unroll") for (int _i = 0; _i < 2; ++_i) \
        __builtin_amdgcn_global_load_lds((const unsigned*)((const char*)(gbase) + (voff)[_i]), (PG8_LAS unsigned*)(lds + (bufoff) + ldsw + _i * 8192), 16, 0, 0); } while (0)
#define PG8_LDA(dst, b, h) do { _Pragma("unroll") for (int m = 0; m < 4; ++m) _Pragma("unroll") for (int k = 0; k < 2; ++k) dst[m][k] = *(const PG8_LAS bf16x8*)(lds + PG8_SA(b, h) + aoff + m * 2048 + k * 1024); } while (0)
#define PG8_LDB(dst, b, h) do { _Pragma("unroll") for (int n = 0; n < 2; ++n) _Pragma("unroll") for (int k = 0; k < 2; ++k) dst[n][k] = *(const PG8_LAS bf16x8*)(lds + PG8_SB(b, h) + boff + n * 2048 + k * 1024); } while (0)
#define PG8_MMA(ai, bj, At, Bt) do { __builtin_amdgcn_s_setprio(1); _Pragma("unroll") for (int m = 0; m < 4; ++m) _Pragma("unroll") for (int n = 0; n < 2; ++n) _Pragma("unroll") for (int k = 0; k < 2; ++k) \
        acc[ai][bj][m][n] = __builtin_amdgcn_mfma_f32_16x16x32_bf16(Bt[n][k], At[m][k], acc[ai][bj][m][n], 0, 0, 0); __builtin_amdgcn_s_setprio(0); } while (0)
#define PG8_WAIT_V(n) asm volatile("s_waitcnt vmcnt(" #n ")" ::: "memory")
#define PG8_WAIT_L(n) asm volatile("s_waitcnt lgkmcnt(" #n ")" ::: "memory")
#define PG8_BAR __builtin_amdgcn_s_barrier()
#define PG8_SCHED __builtin_amdgcn_sched_barrier(0)
    Unit cur, nxt; int ui = 0;
    if (!S.next(0, cur)) return;
    f32x4 acc[2][2][4][2];
#pragma unroll
    for (int a = 0; a < 2; ++a)
#pragma unroll
        for (int b = 0; b < 2; ++b)
#pragma unroll
            for (int m = 0; m < 4; ++m)
#pragma unroll
                for (int n = 0; n < 2; ++n) acc[a][b][m][n] = (f32x4){0.f, 0.f, 0.f, 0.f};
    bf16x8 At[4][2], B0[2][2], B1[2][2];
    const char* cA = (const char*)g.A + (size_t)cur.pm * tstep; const char* cB = (const char*)g.Bt + (size_t)cur.pn * tstep;
    S.a_ready(cur);
    if constexpr (SP2) {
        PG8_STAGE(PG8_SB(0, 0), cB, voffB); PG8_STAGE(PG8_SB(0, 1), cB + hstep, voffB); PG8_STAGE(PG8_SA(0, 0), cA, voffA); PG8_STAGE(PG8_SA(0, 1), cA + hstep, voffA);
        if (wr == 1) PG8_BAR;
        PG8_WAIT_V(2); PG8_BAR;
        PG8_STAGE(PG8_SB(1, 0), cB + kstep, voffB); PG8_STAGE(PG8_SA(1, 0), cA + kstep, voffA); PG8_STAGE(PG8_SB(1, 1), cB + hstep + kstep, voffB);
        PG8_WAIT_V(6); PG8_BAR;
    } else {
        PG8_STAGE(PG8_SB(0, 0), cB, voffB); PG8_STAGE(PG8_SA(0, 0), cA, voffA); PG8_STAGE(PG8_SB(0, 1), cB + hstep, voffB); PG8_STAGE(PG8_SA(0, 1), cA + hstep, voffA);
        if (wr == 1) PG8_BAR;
        PG8_WAIT_V(4); PG8_BAR;
        PG8_STAGE(PG8_SB(1, 0), cB + kstep, voffB); PG8_STAGE(PG8_SA(1, 0), cA + kstep, voffA); PG8_STAGE(PG8_SB(1, 1), cB + hstep + kstep, voffB);
        PG8_WAIT_V(6); PG8_BAR;
    }
    for (;;) {
        const bool has_next = S.next(ui + 1, nxt);
        const char* nA = has_next ? (const char*)g.A + (size_t)nxt.pm * tstep : cA; const char* nB = has_next ? (const char*)g.Bt + (size_t)nxt.pn * tstep : cB;
        for (int t = 0; t < nt; t += 2) {
            const bool last = (t == nt - 2);
            const char* a1 = cA + (size_t)(t + 1) * kstep;
            const char* a2 = last ? nA : cA + (size_t)(t + 2) * kstep; const char* b2 = last ? nB : cB + (size_t)(t + 2) * kstep;
            const char* a3 = a2 + kstep; const char* b3 = b2 + kstep;
            if (last && has_next) S.a_ready(nxt);
            if constexpr (SP2) {
            PG8_LDB(B0, 0, 0); PG8_LDB(B1, 0, 1); PG8_SCHED; PG8_LDA(At, 0, 0); PG8_STAGE(PG8_SA(1, 1), a1 + hstep, voffA);
            PG8_WAIT_V(8); PG8_WAIT_L(0); PG8_BAR; PG8_MMA(0, 0, At, B0); PG8_MMA(0, 1, At, B1); PG8_BAR; PG8_SCHED;
            PG8_LDA(At, 0, 1); PG8_STAGE(PG8_SB(0, 0), b2, voffB); PG8_STAGE(PG8_SB(0, 1), b2 + hstep, voffB); PG8_STAGE(PG8_SA(0, 0), a2, voffA);
            PG8_WAIT_V(8); PG8_WAIT_L(0); PG8_BAR; PG8_MMA(1, 0, At, B0); PG8_MMA(1, 1, At, B1); PG8_BAR; PG8_SCHED;
            PG8_LDB(B0, 1, 0); PG8_LDB(B1, 1, 1); PG8_SCHED; PG8_LDA(At, 1, 0); PG8_STAGE(PG8_SA(0, 1), a2 + hstep, voffA);
            PG8_WAIT_V(8); PG8_WAIT_L(0); PG8_BAR; PG8_MMA(0, 0, At, B0); PG8_MMA(0, 1, At, B1); PG8_BAR; PG8_SCHED;
            PG8_LDA(At, 1, 1); PG8_STAGE(PG8_SB(1, 0), b3, voffB); PG8_STAGE(PG8_SB(1, 1), b3 + hstep, voffB); PG8_STAGE(PG8_SA(1, 0), a3, voffA);
            PG8_WAIT_V(8); PG8_WAIT_L(0); PG8_BAR; PG8_MMA(1, 0, At, B0); PG8_MMA(1, 1, At, B1); PG8_BAR; PG8_SCHED;
            } else {
            PG8_LDB(B0, 0, 0); PG8_SCHED; PG8_LDA(At, 0, 0); PG8_STAGE(PG8_SA(1, 1), a1 + hstep, voffA);
            PG8_WAIT_L(8); PG8_BAR; PG8_WAIT_L(0); PG8_MMA(0, 0, At, B0); PG8_BAR; PG8_SCHED;
            PG8_LDB(B1, 0, 1); PG8_STAGE(PG8_SB(0, 0), b2, voffB);
            PG8_BAR; PG8_WAIT_L(0); PG8_MMA(0, 1, At, B1); PG8_BAR;
            PG8_LDA(At, 0, 1); PG8_STAGE(PG8_SA(0, 0), a2, voffA);
            PG8_BAR; PG8_WAIT_L(0); PG8_MMA(1, 0, At, B0); PG8_BAR; PG8_SCHED;
            PG8_STAGE(PG8_SB(0, 1), b2 + hstep, voffB);
            PG8_WAIT_V(6); PG8_BAR; PG8_MMA(1, 1, At, B1); PG8_BAR;
            PG8_LDB(B0, 1, 0); PG8_SCHED; PG8_LDA(At, 1, 0); PG8_STAGE(PG8_SA(0, 1), a2 + hstep, voffA);
            PG8_WAIT_L(8); PG8_BAR; PG8_WAIT_L(0); PG8_MMA(0, 0, At, B0); PG8_BAR; PG8_SCHED;
            PG8_LDB(B1, 1, 1); PG8_STAGE(PG8_SB(1, 0), b3, voffB);
            PG8_BAR; PG8_WAIT_L(0); PG8_MMA(0, 1, At, B1); PG8_BAR;
            PG8_LDA(At, 1, 1); PG8_STAGE(PG8_SA(1, 0), a3, voffA);
            PG8_BAR; PG8_WAIT_L(0); PG8_MMA(1, 0, At, B0); PG8_BAR; PG8_SCHED;
            PG8_STAGE(PG8_SB(1, 1), b3 + hstep, voffB);
            PG8_WAIT_V(6); PG8_BAR; PG8_MMA(1, 1, At, B1); PG8_BAR;
            }
        }
        if constexpr (ALIGN_EPI) { if (wr == 0) PG8_BAR; }
        if constexpr (!Epi::AFTER_DRAIN) { E(acc, cur, wr, wc, fr, fq); S.done(cur); }
        if (!has_next) break;
#pragma unroll
        for (int a = 0; a < 2; ++a)
#pragma unroll
            for (int b = 0; b < 2; ++b)
#pragma unroll
                for (int m = 0; m < 4; ++m)
#pragma unroll
                    for (int n = 0; n < 2; ++n) acc[a][b][m][n] = (f32x4){0.f, 0.f, 0.f, 0.f};
        cur = nxt; cA = nA; cB = nB; ++ui;
        if constexpr (ALIGN_EPI) { if (wr == 1) PG8_BAR; }
    }
    PG8_WAIT_V(0);
    if constexpr (!ALIGN_EPI) { if (wr == 0) PG8_BAR; }
    PG8_BAR;
    if constexpr (Epi::AFTER_DRAIN) { E.fused(acc, cur, wr, wc, fr, fq, lds, wid, lane); S.done(cur); }
#undef PG8_SA
#undef PG8_SB
#undef PG8_STAGE
#undef PG8_LDA
#undef PG8_LDB
#undef PG8_MMA
#undef PG8_WAIT_V
#undef PG8_WAIT_L
#undef PG8_BAR
#undef PG8_SCHED
}
}

#define LAS __attribute__((address_space(3)))
typedef unsigned short bf16;
typedef float f32x4 __attribute__((ext_vector_type(4)));
typedef short bf16x8 __attribute__((ext_vector_type(8)));
typedef short s16x4 __attribute__((ext_vector_type(4)));
typedef unsigned u32x4 __attribute__((ext_vector_type(4)));
typedef unsigned u32x2 __attribute__((ext_vector_type(2)));

constexpr int D = 1024, FF = 2816, SEQ = 8192, NB = 4, NMETA = 16;
constexpr int MREAL = NB * SEQ;
constexpr int MMETA0 = MREAL;
constexpr int MPAD = MREAL + 256;
constexpr int NCH = 129;
constexpr int GLA_NIN = 3328;
constexpr float LN_EPS = 1e-5f, RMS_EPS = 1e-6f;
constexpr float ALPHA = 1.41421356237f;

constexpr size_t al256(size_t x) { return (x + 255) & ~(size_t)255; }
constexpr size_t SZ_WFI = (size_t)2 * FF * D * 2, SZ_WFO = (size_t)D * FF * 2;
constexpr size_t WS_WFI = 0;
constexpr size_t WS_WFO = WS_WFI + 4 * SZ_WFI;
constexpr size_t WS_WCI = WS_WFO + 4 * SZ_WFO;
constexpr size_t WS_WCO = WS_WCI + (size_t)3072 * D * 2;
constexpr size_t WS_WGI = WS_WCO + (size_t)D * D * 2;
constexpr size_t WS_WGO = WS_WGI + (size_t)GLA_NIN * D * 2;
constexpr size_t WS_HB = WS_WGO + (size_t)D * D * 2;
constexpr size_t WS_XM = WS_HB + (size_t)MPAD * D * 2;
constexpr size_t WS_METAR = WS_XM + (size_t)256 * D * 4;
constexpr size_t WS_STATS = WS_METAR + (size_t)256 * D * 4;
constexpr size_t WS_BIG = al256(WS_STATS + (size_t)MPAD * 8);
constexpr size_t SZ_ROWBF = (size_t)MPAD * D * 2;
constexpr size_t BIG_ACT = 0;
constexpr size_t BIG_BG = 0, BIG_CU = SZ_ROWBF;
constexpr size_t BIG_Q = 0, BIG_K = SZ_ROWBF / 2, BIG_V = SZ_ROWBF, BIG_G = 2 * SZ_ROWBF, BIG_GZ = 3 * SZ_ROWBF;
constexpr size_t BIG_U = al256(BIG_GZ + (size_t)MPAD * 16 * 4);
constexpr size_t BIG_DEC = BIG_U + (size_t)NCH * 16 * 32768 * 2;
constexpr size_t BIG_END = BIG_DEC + (size_t)NCH * 16 * 128 * 4;
constexpr size_t WS_BAR = al256(WS_BIG + BIG_END);
constexpr size_t WS_BAR_BYTES = 16384;
constexpr size_t WS_END = WS_BAR + WS_BAR_BYTES;
static_assert((size_t)MPAD * FF * 2 <= BIG_END, "act fits");

constexpr int LDS_BYTES = 147456;

struct Params {
    const float* x; const float* meta; const float* ln_gain; const float* ln_bias; const float* ffn_w_in; const float* ffn_w_out;
    const float* conv_w_in; const float* conv_w; const float* conv_w_out; const float* gla_w_in; const float* gla_w_up; const float* gla_b_gate;
    const float* gla_norm_w; const float* gla_w_out; float* out; unsigned char* ws;
};

__device__ __forceinline__ unsigned f2bf(float f) { unsigned u = __builtin_bit_cast(unsigned, f); return (u + 0x7fffu + ((u >> 16) & 1u)) >> 16; }
__device__ __forceinline__ unsigned pk2(float lo, float hi) { return pg8::cvt_pk_bf16(lo, hi); }
__device__ __forceinline__ float bf_lo(unsigned w) { return __builtin_bit_cast(float, w << 16); }
__device__ __forceinline__ float bf_hi(unsigned w) { return __builtin_bit_cast(float, w & 0xffff0000u); }
__device__ __forceinline__ float wave_sum(float v) {
#pragma unroll
    for (int o = 1; o < 64; o <<= 1) v += __shfl_xor(v, o);
    return v;
}
#define LDS_WAIT() asm volatile("s_waitcnt lgkmcnt(0)" ::: "memory")

__device__ __forceinline__ void p0_transpose_item(const float* W, int K, int ldw, int scol, int nvalid, bf16* WT, int n0d, int k0, LAS float* scr, int lane) {
    float tv[32];
#pragma unroll
    for (int i = 0; i < 32; ++i) { const int kk = 2 * i + (lane >> 5), j = lane & 31; tv[i] = (j < nvalid) ? W[(size_t)(k0 + kk) * ldw + scol + j] : 0.f; }
#pragma unroll
    for (int i = 0; i < 32; ++i) { const int kk = 2 * i + (lane >> 5), j = lane & 31; scr[kk * 33 + j] = tv[i]; }
    LDS_WAIT(); asm volatile("" ::: "memory");
    const int c = lane & 7;
#pragma unroll
    for (int jj = 0; jj < 4; ++jj) { const int n = (lane >> 3) + 8 * jj; const LAS float* s = scr + (8 * c) * 33 + n;
        u32x4 o; o.x = pk2(s[0 * 33], s[1 * 33]); o.y = pk2(s[2 * 33], s[3 * 33]); o.z = pk2(s[4 * 33], s[5 * 33]); o.w = pk2(s[6 * 33], s[7 * 33]);
        pg8::wt16(WT + (size_t)(n0d + n) * K + k0 + 8 * c, o); }
    LDS_WAIT(); asm volatile("" ::: "memory");
}
__device__ __forceinline__ void p0_matrix(const float* W, int K, int Nsrc, int Ndst, int mode, bf16* WT, LAS float* scr, int lane, int item) {
    const int nblk = Ndst / 32, kb = item / nblk, nb = item % nblk, n0d = nb * 32, k0 = kb * 64;
    int scol = n0d, nvalid = 32;
    if (mode == 1) { const int pn = n0d >> 8, j = n0d & 255; scol = (j < 128) ? 128 * pn + j : FF + 128 * pn + (j - 128); }
    else if (mode == 2) { const int pn = n0d >> 8, j = n0d & 255; scol = (pn < 8) ? ((j < 128) ? 1024 + 128 * pn + j : 2048 + 128 * pn + (j - 128)) : 256 * (pn - 8) + j; }
    else if (mode == 3) { nvalid = Nsrc - n0d; nvalid = nvalid < 0 ? 0 : (nvalid > 32 ? 32 : nvalid); if (nvalid == 0) scol = 0; }
    p0_transpose_item(W, K, Nsrc, scol, nvalid, WT, n0d, k0, scr, lane);
}
__device__ __forceinline__ void p0_prologue(const Params& p, LAS unsigned char* lds, int gw, int NGW, int wave, int lane) {
    LAS float* scr = (LAS float*)(lds + wave * 16384);
    unsigned char* ws = p.ws;
    constexpr int I_FI = (D / 64) * (2 * FF / 32), I_FO = (FF / 64) * (D / 32), I_CI = (D / 64) * (3072 / 32), I_SQ = (D / 64) * (D / 32), I_GI = (D / 64) * (GLA_NIN / 32);
    constexpr int NITEMS = 4 * I_FI + 4 * I_FO + I_CI + I_SQ + I_GI + I_SQ;
    for (int it = gw; it < NITEMS; it += NGW) {
        int r = it;
        if (r < 4 * I_FI) { const int l = r / I_FI; p0_matrix(p.ffn_w_in + (size_t)l * D * 2 * FF, D, 2 * FF, 2 * FF, 1, (bf16*)(ws + WS_WFI + l * SZ_WFI), scr, lane, r % I_FI); continue; } r -= 4 * I_FI;
        if (r < 4 * I_FO) { const int l = r / I_FO; p0_matrix(p.ffn_w_out + (size_t)l * FF * D, FF, D, D, 0, (bf16*)(ws + WS_WFO + l * SZ_WFO), scr, lane, r % I_FO); continue; } r -= 4 * I_FO;
        if (r < I_CI) { p0_matrix(p.conv_w_in, D, 3072, 3072, 2, (bf16*)(ws + WS_WCI), scr, lane, r); continue; } r -= I_CI;
        if (r < I_SQ) { p0_matrix(p.conv_w_out, D, D, D, 0, (bf16*)(ws + WS_WCO), scr, lane, r); continue; } r -= I_SQ;
        if (r < I_GI) { p0_matrix(p.gla_w_in, D, 3088, GLA_NIN, 3, (bf16*)(ws + WS_WGI), scr, lane, r); continue; } r -= I_GI;
        p0_matrix(p.gla_w_out, D, D, D, 0, (bf16*)(ws + WS_WGO), scr, lane, r);
    }
    bf16* HB = (bf16*)(ws + WS_HB); float* METAR = (float*)(ws + WS_METAR);
    for (int m0 = gw; m0 < MREAL + NMETA; m0 += 4 * NGW) {
        f32x4 v[4][4];
#pragma unroll
        for (int r = 0; r < 4; ++r) { const int m = m0 + r * NGW;
            if (m < MREAL + NMETA) { const float* src = (m < MREAL) ? p.x + (size_t)m * D : p.meta + (size_t)(m - MREAL) * D;
#pragma unroll
                for (int j = 0; j < 4; ++j) v[r][j] = ((const f32x4*)src)[lane + 64 * j]; } }
#pragma unroll
        for (int r = 0; r < 4; ++r) { const int m = m0 + r * NGW;
            if (m < MREAL + NMETA) {
                unsigned long long* o8 = (unsigned long long*)(HB + (size_t)m * D) + lane;
#pragma unroll
                for (int j = 0; j < 4; ++j) {
                    pg8::wt8(o8 + 64 * j, (unsigned long long)pk2(v[r][j][0], v[r][j][1]) | ((unsigned long long)pk2(v[r][j][2], v[r][j][3]) << 32));
                    if (m >= MREAL) pg8::wt16((f32x4*)(METAR + (size_t)(m - MREAL) * D) + lane + 64 * j, v[r][j]);
                } } }
    }
}

template <bool FINAL>
__device__ __forceinline__ void ln_phase(const float* Zreal, const float* Zmeta, const float* gain, const float* bias, bf16* HB, float* stats, float* out, int gw, int NGW, int lane) {
    f32x4 g[4], bb[4];
#pragma unroll
    for (int j = 0; j < 4; ++j) { g[j] = ((const f32x4*)gain)[lane + 64 * j]; bb[j] = ((const f32x4*)bias)[lane + 64 * j]; }
    const int nrows = FINAL ? MREAL : MREAL + NMETA;
    for (int m0 = gw; m0 < nrows; m0 += 4 * NGW) {
        f32x4 v[4][4];
#pragma unroll
        for (int r = 0; r < 4; ++r) { const int m = m0 + r * NGW;
            if (m < nrows) { const float* zr = (m < MREAL) ? Zreal + (size_t)m * D : Zmeta + (size_t)(m - MREAL) * D;
#pragma unroll
                for (int j = 0; j < 4; ++j) v[r][j] = ((const f32x4*)zr)[lane + 64 * j]; }
            else {
#pragma unroll
                for (int j = 0; j < 4; ++j) v[r][j] = (f32x4){0.f, 0.f, 0.f, 0.f}; } }
#pragma unroll
        for (int r = 0; r < 4; ++r) { const int m = m0 + r * NGW;
            float s = 0.f;
#pragma unroll
            for (int j = 0; j < 4; ++j) s += (v[r][j][0] + v[r][j][1]) + (v[r][j][2] + v[r][j][3]);
            const float mean = wave_sum(s) * (1.f / D); float s2 = 0.f;
#pragma unroll
            for (int j = 0; j < 4; ++j) { const f32x4 d = v[r][j] - mean; s2 += (d[0] * d[0] + d[1] * d[1]) + (d[2] * d[2] + d[3] * d[3]); }
            const float rstd = 1.0f / sqrtf(wave_sum(s2) * (1.f / D) + LN_EPS);
            if (m < nrows) {
                if (FINAL) {
#pragma unroll
                    for (int j = 0; j < 4; ++j) ((f32x4*)(out + (size_t)m * D))[lane + 64 * j] = (v[r][j] - mean) * rstd * g[j] + bb[j];
                } else {
                    if (lane == 0) pg8::wt8(stats + (size_t)m * 2, (unsigned long long)__float_as_uint(mean) | ((unsigned long long)__float_as_uint(rstd) << 32));
                    unsigned long long* o8 = (unsigned long long*)(HB + (size_t)m * D) + lane;
#pragma unroll
                    for (int j = 0; j < 4; ++j) { const f32x4 y = (v[r][j] - mean) * rstd * g[j] + bb[j]; pg8::wt8(o8 + 64 * j, (unsigned long long)pk2(y[0], y[1]) | ((unsigned long long)pk2(y[2], y[3]) << 32)); }
                }
            }
        }
    }
}

__device__ __forceinline__ int conv_pred(int m, int k) {
    if (m < MREAL) { const int t = m & (SEQ - 1); return (t >= k) ? m - k : MMETA0 + (NMETA + t - k); }
    const int j = m - MMETA0; return (j >= k) ? m - k : -1;
}
__device__ __forceinline__ void conv_mix_phase(const bf16* BG, const bf16* CU, const float* cw, bf16* VO, int gw, int NGW, int lane) {
    const int nrows = MREAL + NMETA;
    const u32x4 z4 = (u32x4){0u, 0u, 0u, 0u};
    float wt[3][16];
#pragma unroll
    for (int k = 0; k < 3; ++k)
#pragma unroll
        for (int j = 0; j < 2; ++j)
#pragma unroll
            for (int q = 0; q < 2; ++q) { const f32x4 t = *(const f32x4*)(cw + k * D + 8 * (lane + 64 * j) + 4 * q);
                wt[k][8 * j + 4 * q] = t[0]; wt[k][8 * j + 4 * q + 1] = t[1]; wt[k][8 * j + 4 * q + 2] = t[2]; wt[k][8 * j + 4 * q + 3] = t[3]; }
    for (int m0 = gw; m0 < nrows; m0 += 2 * NGW) {
        u32x4 b4[2][2], x0[2][2], x1[2][2], x2[2][2];
#pragma unroll
        for (int r = 0; r < 2; ++r) { const int m = m0 + r * NGW; const bool ok = m < nrows;
            const int p1 = ok ? conv_pred(m, 1) : -1, p2 = ok ? conv_pred(m, 2) : -1;
#pragma unroll
            for (int j = 0; j < 2; ++j) { const int c0 = 8 * (lane + 64 * j);
                b4[r][j] = ok ? *(const u32x4*)(BG + (size_t)m * D + c0) : z4; x0[r][j] = ok ? *(const u32x4*)(CU + (size_t)m * D + c0) : z4;
                x1[r][j] = (p1 >= 0) ? *(const u32x4*)(CU + (size_t)p1 * D + c0) : z4; x2[r][j] = (p2 >= 0) ? *(const u32x4*)(CU + (size_t)p2 * D + c0) : z4; } }
#pragma unroll
        for (int r = 0; r < 2; ++r) { const int m = m0 + r * NGW;
            if (m < nrows) {
#pragma unroll
                for (int j = 0; j < 2; ++j) { u32x4 o;
#pragma unroll
                    for (int q = 0; q < 4; ++q) { const int e = 8 * j + 2 * q;
                        const float lo = bf_lo(b4[r][j][q]) * (wt[0][e] * bf_lo(x2[r][j][q]) + wt[1][e] * bf_lo(x1[r][j][q]) + wt[2][e] * bf_lo(x0[r][j][q]));
                        const float hi = bf_hi(b4[r][j][q]) * (wt[0][e + 1] * bf_hi(x2[r][j][q]) + wt[1][e + 1] * bf_hi(x1[r][j][q]) + wt[2][e + 1] * bf_hi(x0[r][j][q]));
                        o[q] = pk2(lo, hi); }
                    pg8::wt16(VO + (size_t)m * D + 8 * (lane + 64 * j), o); } } }
    }
}

constexpr int GL_B = 0, GL_GZ = 33792, GL_TOT = 37888, GL_RED = 39936, GL_K = 41984, GL_QS = 59392, GL_QI = 76800, GL_V = 94208, GL_P = 128000;
constexpr int BSTR = 132, KSTR = 136, VSTR = 264, PSTR = 72;
static_assert(GL_P + 64 * PSTR * 2 <= LDS_BYTES, "gla lds");
__device__ __forceinline__ int gla_row(int b, int n, int c) { return n ? b * SEQ + (n - 1) * 64 + c : (c >= 48 ? MMETA0 + (c - 48) : -1); }
__device__ __forceinline__ s16x4 tr_read(unsigned a) { s16x4 r; asm volatile("ds_read_b64_tr_b16 %0, %1\n\ts_waitcnt lgkmcnt(0)" : "=&v"(r) : "v"(a) : "memory"); return r; }
__device__ __forceinline__ bf16x8 tr_frag(unsigned a0, unsigned a1) { const s16x4 lo = tr_read(a0), hi = tr_read(a1); return __builtin_shufflevector(lo, hi, 0, 1, 2, 3, 4, 5, 6, 7); }
__device__ __forceinline__ unsigned lds_u32(const LAS void* p) { return (unsigned)(uintptr_t)p; }

constexpr int GLA_UNITS = (NCH - 1) * 16 + 4;
__device__ __forceinline__ void gla_unit(int idx, int& n, int& b, int& h) { if (idx < (NCH - 1) * 16) { n = 1 + (idx >> 4); b = (idx & 15) >> 2; h = idx & 3; } else { n = 0; b = 0; h = idx - (NCH - 1) * 16; } }
__device__ __forceinline__ void gla_cumdecay(LAS unsigned char* lds, const f32x4 gzv, const float (&w)[16], float bia, int n, int tid) {
    LAS float* sB = (LAS float*)(lds + GL_B); LAS float* sGZ = (LAS float*)(lds + GL_GZ); LAS float* sTot = (LAS float*)(lds + GL_TOT);
    if (tid < 256) *(LAS f32x4*)(sGZ + (tid >> 2) * 16 + (tid & 3) * 4) = gzv;
    const int kd = tid & 127, grp = tid >> 7;
    __syncthreads();
    float loc[16]; float run = 0.f;
#pragma unroll
    for (int i = 0; i < 16; ++i) {
        const int c = grp * 16 + i;
        float z = bia;
#pragma unroll
        for (int r4 = 0; r4 < 4; ++r4) { const f32x4 gv = *(const LAS f32x4*)(sGZ + c * 16 + r4 * 4); z += gv[0] * w[r4 * 4] + gv[1] * w[r4 * 4 + 1] + gv[2] * w[r4 * 4 + 2] + gv[3] * w[r4 * 4 + 3]; }
        float la = (fminf(z, 0.f) - __logf(1.0f + __expf(-fabsf(z)))) * (1.0f / 16.0f);
        if (n == 0 && c < 48) la = 0.f;
        run += la; loc[i] = run;
    }
    sTot[grp * 128 + kd] = run;
    __syncthreads();
    float off = 0.f;
#pragma unroll
    for (int g2 = 0; g2 < 3; ++g2) off += (g2 < grp) ? sTot[g2 * 128 + kd] : 0.f;
#pragma unroll
    for (int i = 0; i < 16; ++i) sB[(grp * 16 + i) * BSTR + kd] = loc[i] + off;
    __syncthreads();
}
__device__ __forceinline__ void unpack8(const u32x4 w, float (&f)[8]) {
#pragma unroll
    for (int q = 0; q < 4; ++q) { f[2 * q] = bf_lo(w[q]); f[2 * q + 1] = bf_hi(w[q]); }
}
__device__ __forceinline__ u32x4 pack8f(const float (&f)[8]) { u32x4 w; w.x = pk2(f[0], f[1]); w.y = pk2(f[2], f[3]); w.z = pk2(f[4], f[5]); w.w = pk2(f[6], f[7]); return w; }

__device__ __forceinline__ void gla_g1(const Params& p, LAS unsigned char* lds, int tid, int wave, int lane) {
    unsigned char* big = p.ws + WS_BIG;
    const bf16* Kb = (const bf16*)(big + BIG_K); const bf16* Vb = (const bf16*)(big + BIG_V); const float* GZ = (const float*)(big + BIG_GZ);
    bf16* Ub = (bf16*)(big + BIG_U); float* Dec = (float*)(big + BIG_DEC);
    LAS float* sB = (LAS float*)(lds + GL_B); LAS bf16* sK = (LAS bf16*)(lds + GL_K); LAS bf16* sV = (LAS bf16*)(lds + GL_V);
    const int fr = lane & 15, fq = lane >> 4;
    const u32x4 z4 = (u32x4){0u, 0u, 0u, 0u};
    for (int idx = blockIdx.x; idx < GLA_UNITS; idx += gridDim.x) {
        int n, b, h; gla_unit(idx, n, b, h); const int unit = n * 16 + b * 4 + h;
        f32x4 gzv = (f32x4){0.f, 0.f, 0.f, 0.f};
        if (tid < 256) { const int row = gla_row(b, n, tid >> 2); if (row >= 0) gzv = *(const f32x4*)(GZ + (size_t)row * 16 + (tid & 3) * 4); }
        float w[16];
#pragma unroll
        for (int r = 0; r < 16; ++r) w[r] = p.gla_w_up[r * 512 + h * 128 + (tid & 127)];
        const float bia = p.gla_b_gate[h * 128 + (tid & 127)];
        const int kd8 = (tid & 15) * 8, cb = tid >> 4;
        u32x4 kv[2], vv[4];
#pragma unroll
        for (int i = 0; i < 2; ++i) { const int row = gla_row(b, n, cb + 32 * i); kv[i] = (row >= 0) ? *(const u32x4*)(Kb + (size_t)row * 512 + h * 128 + kd8) : z4; }
#pragma unroll
        for (int i = 0; i < 4; ++i) { const int ii = tid + 512 * i, row = gla_row(b, n, ii >> 5); vv[i] = (row >= 0) ? *(const u32x4*)(Vb + (size_t)row * D + h * 256 + (ii & 31) * 8) : z4; }
        gla_cumdecay(lds, gzv, w, bia, n, tid);
        {
            float* Bu = (float*)(p.ws + WS_HB) + (size_t)unit * 8192;
#pragma unroll
            for (int i = 0; i < 4; ++i) { const int ii = tid + 512 * i, c = ii >> 5, k4 = (ii & 31) * 4; pg8::wt16(Bu + c * 128 + k4, *(const LAS f32x4*)(sB + c * BSTR + k4)); }
        }
        {
            float bl[8];
#pragma unroll
            for (int j = 0; j < 8; ++j) bl[j] = sB[63 * BSTR + kd8 + j];
#pragma unroll
            for (int i = 0; i < 2; ++i) { const int c = cb + 32 * i;
                float kf[8]; unpack8(kv[i], kf);
#pragma unroll
                for (int j = 0; j < 8; ++j) kf[j] *= __expf(bl[j] - sB[c * BSTR + kd8 + j]);
                *(LAS u32x4*)(sK + c * KSTR + kd8) = pack8f(kf); }
            if (tid < 128) pg8::wt4(Dec + (size_t)unit * 128 + tid, __expf(sB[63 * BSTR + tid]));
#pragma unroll
            for (int i = 0; i < 4; ++i) { const int ii = tid + 512 * i; *(LAS u32x4*)(sV + (ii >> 5) * VSTR + (ii & 31) * 8) = vv[i]; }
        }
        __syncthreads();
        f32x4 acc[8][2];
#pragma unroll
        for (int i = 0; i < 8; ++i)
#pragma unroll
            for (int j = 0; j < 2; ++j) acc[i][j] = (f32x4){0.f, 0.f, 0.f, 0.f};
#pragma unroll
        for (int ks = 0; ks < 2; ++ks) {
            const int r0 = 32 * ks + 8 * fq + (fr >> 2), cc = 4 * (fr & 3);
            bf16x8 Y[2];
#pragma unroll
            for (int j = 0; j < 2; ++j) { const int vd0 = 32 * wave + 16 * j; Y[j] = tr_frag(lds_u32(sV + r0 * VSTR + vd0 + cc), lds_u32(sV + (r0 + 4) * VSTR + vd0 + cc)); }
#pragma unroll
            for (int i = 0; i < 8; ++i) { const bf16x8 X = tr_frag(lds_u32(sK + r0 * KSTR + 16 * i + cc), lds_u32(sK + (r0 + 4) * KSTR + 16 * i + cc));
#pragma unroll
                for (int j = 0; j < 2; ++j) acc[i][j] = __builtin_amdgcn_mfma_f32_16x16x32_bf16(X, Y[j], acc[i][j], 0, 0, 0); }
        }
        bf16* Uu = Ub + (size_t)unit * 32768;
#pragma unroll
        for (int i = 0; i < 8; ++i)
#pragma unroll
            for (int j = 0; j < 2; ++j) { const int vd = 32 * wave + 16 * j + fr, kd = 16 * i + 4 * fq;
                u32x2 wv; wv.x = pk2(acc[i][j][0], acc[i][j][1]); wv.y = pk2(acc[i][j][2], acc[i][j][3]);
                pg8::wt8(Uu + vd * 128 + kd, wv); }
        __syncthreads();
    }
}

__device__ __forceinline__ void gla_g2(const Params& p, int tid) {
    unsigned char* big = p.ws + WS_BIG;
    bf16* Ub = (bf16*)(big + BIG_U); const float* Dec = (const float*)(big + BIG_DEC);
    for (int g = blockIdx.x * 512 + tid; g < 16 * 8192; g += gridDim.x * 512) {
        const int bh = g >> 13, e4 = (g & 8191) * 4, kd = e4 & 127;
        float S0, S1, S2, S3;
        { const size_t unit = (size_t)(bh & 3); const u32x2 u0 = *(const u32x2*)(Ub + unit * 32768 + e4); S0 = bf_lo(u0.x); S1 = bf_hi(u0.x); S2 = bf_lo(u0.y); S3 = bf_hi(u0.y); }
        for (int n0 = 1; n0 < NCH; n0 += 8) {
            u32x2 uu[8]; f32x4 dd[8];
#pragma unroll
            for (int i = 0; i < 8; ++i) { const size_t unit = (size_t)(n0 + i) * 16 + bh;
                uu[i] = *(const u32x2*)(Ub + unit * 32768 + e4); dd[i] = *(const f32x4*)(Dec + unit * 128 + kd); }
#pragma unroll
            for (int i = 0; i < 8; ++i) { const size_t unit = (size_t)(n0 + i) * 16 + bh;
                u32x2 wv; wv.x = pk2(S0, S1); wv.y = pk2(S2, S3); pg8::wt8(Ub + unit * 32768 + e4, wv);
                S0 = dd[i][0] * S0 + bf_lo(uu[i].x); S1 = dd[i][1] * S1 + bf_hi(uu[i].x); S2 = dd[i][2] * S2 + bf_lo(uu[i].y); S3 = dd[i][3] * S3 + bf_hi(uu[i].y); }
        }
    }
}

__device__ __forceinline__ void gla_g3(const Params& p, LAS unsigned char* lds, int tid, int wave, int lane) {
    unsigned char* big = p.ws + WS_BIG;
    const bf16* Qb = (const bf16*)(big + BIG_Q); const bf16* Kb = (const bf16*)(big + BIG_K); const bf16* Vb = (const bf16*)(big + BIG_V); const bf16* Gb = (const bf16*)(big + BIG_G);
    const bf16* Sb = (const bf16*)(big + BIG_U); bf16* Ob = (bf16*)(big + BIG_V);
    LAS float* sB = (LAS float*)(lds + GL_B); LAS float* sRed = (LAS float*)(lds + GL_RED);
    LAS bf16* sK = (LAS bf16*)(lds + GL_K); LAS bf16* sQs = (LAS bf16*)(lds + GL_QS); LAS bf16* sQi = (LAS bf16*)(lds + GL_QI); LAS bf16* sV = (LAS bf16*)(lds + GL_V); LAS bf16* sP = (LAS bf16*)(lds + GL_P);
    const int fr = lane & 15, fq = lane >> 4;
    const u32x4 z4 = (u32x4){0u, 0u, 0u, 0u};
    for (int idx = blockIdx.x; idx < GLA_UNITS; idx += gridDim.x) {
        int n, b, h; gla_unit(idx, n, b, h); const int unit = n * 16 + b * 4 + h;
        const float* Bu = (const float*)(p.ws + WS_HB) + (size_t)unit * 8192;
        f32x4 bt[4];
#pragma unroll
        for (int i = 0; i < 4; ++i) { const int ii = tid + 512 * i; bt[i] = *(const f32x4*)(Bu + (ii >> 5) * 128 + (ii & 31) * 4); }
        const int kd8 = (tid & 15) * 8, cb = tid >> 4;
        u32x4 qv[2], kv[2], vv[4];
#pragma unroll
        for (int i = 0; i < 2; ++i) { const int row = gla_row(b, n, cb + 32 * i);
            qv[i] = (row >= 0) ? *(const u32x4*)(Qb + (size_t)row * 512 + h * 128 + kd8) : z4; kv[i] = (row >= 0) ? *(const u32x4*)(Kb + (size_t)row * 512 + h * 128 + kd8) : z4; }
#pragma unroll
        for (int i = 0; i < 4; ++i) { const int ii = tid + 512 * i, row = gla_row(b, n, ii >> 5); vv[i] = (row >= 0) ? *(const u32x4*)(Vb + (size_t)row * D + h * 256 + (ii & 31) * 8) : z4; }
        const bf16* Su = Sb + (size_t)unit * 32768;
        bf16x8 X2[4][2];
        if (n) {
#pragma unroll
            for (int ks = 0; ks < 4; ++ks)
#pragma unroll
                for (int xi = 0; xi < 2; ++xi) X2[ks][xi] = *(const bf16x8*)(Su + (32 * wave + 16 * xi + fr) * 128 + 32 * ks + 8 * fq);
        }
        u32x2 gg[4][2]; f32x4 nw[2];
#pragma unroll
        for (int xi = 0; xi < 2; ++xi) nw[xi] = *(const f32x4*)(p.gla_norm_w + 32 * wave + 16 * xi + 4 * fq);
#pragma unroll
        for (int mi = 0; mi < 4; ++mi) { const int row = gla_row(b, n, 16 * mi + fr);
#pragma unroll
            for (int xi = 0; xi < 2; ++xi) gg[mi][xi] = (row >= 0) ? *(const u32x2*)(Gb + (size_t)row * D + h * 256 + 32 * wave + 16 * xi + 4 * fq) : (u32x2){0u, 0u}; }
#pragma unroll
        for (int i = 0; i < 4; ++i) { const int ii = tid + 512 * i; *(LAS f32x4*)(sB + (ii >> 5) * BSTR + (ii & 31) * 4) = bt[i]; }
        __syncthreads();
        {
            float br[8];
#pragma unroll
            for (int j = 0; j < 8; ++j) br[j] = sB[32 * BSTR + kd8 + j];
#pragma unroll
            for (int i = 0; i < 2; ++i) { const int c = cb + 32 * i;
                float qf[8], kf[8], qs[8], qi[8]; unpack8(qv[i], qf); unpack8(kv[i], kf);
#pragma unroll
                for (int j = 0; j < 8; ++j) { const float bb = sB[c * BSTR + kd8 + j]; const float e = __expf(bb - br[j]);
                    qs[j] = qf[j] * e; kf[j] = kf[j] * __expf(br[j] - bb); qi[j] = qf[j] * __expf(bb); }
                *(LAS u32x4*)(sQs + c * KSTR + kd8) = pack8f(qs); *(LAS u32x4*)(sK + c * KSTR + kd8) = pack8f(kf); *(LAS u32x4*)(sQi + c * KSTR + kd8) = pack8f(qi); }
#pragma unroll
            for (int i = 0; i < 4; ++i) { const int ii = tid + 512 * i; *(LAS u32x4*)(sV + (ii >> 5) * VSTR + (ii & 31) * 8) = vv[i]; }
        }
        __syncthreads();
        {
            const int ti = wave >> 1;
#pragma unroll
            for (int jj = 0; jj < 2; ++jj) {
                const int tj = 2 * (wave & 1) + jj;
                f32x4 a = (f32x4){0.f, 0.f, 0.f, 0.f};
                if (tj <= ti) {
#pragma unroll
                    for (int ks = 0; ks < 4; ++ks) {
                        const bf16x8 X = *(const LAS bf16x8*)(sK + (tj * 16 + fr) * KSTR + 32 * ks + 8 * fq);
                        const bf16x8 Y = *(const LAS bf16x8*)(sQs + (ti * 16 + fr) * KSTR + 32 * ks + 8 * fq);
                        a = __builtin_amdgcn_mfma_f32_16x16x32_bf16(X, Y, a, 0, 0, 0);
                    }
                }
                const int ci = ti * 16 + fr, cj = tj * 16 + 4 * fq;
                float e0 = (cj + 0 <= ci) ? a[0] : 0.f, e1 = (cj + 1 <= ci) ? a[1] : 0.f, e2 = (cj + 2 <= ci) ? a[2] : 0.f, e3 = (cj + 3 <= ci) ? a[3] : 0.f;
                u32x2 wv; wv.x = pk2(e0, e1); wv.y = pk2(e2, e3);
                *(LAS u32x2*)(sP + ci * PSTR + cj) = wv;
            }
        }
        __syncthreads();
        f32x4 acc[4][2];
#pragma unroll
        for (int mi = 0; mi < 4; ++mi)
#pragma unroll
            for (int xi = 0; xi < 2; ++xi) acc[mi][xi] = (f32x4){0.f, 0.f, 0.f, 0.f};
#pragma unroll
        for (int ks = 0; ks < 2; ++ks) {
            const int r0 = 32 * ks + 8 * fq + (fr >> 2), cc = 4 * (fr & 3);
            bf16x8 X1[2];
#pragma unroll
            for (int xi = 0; xi < 2; ++xi) { const int vd0 = 32 * wave + 16 * xi; X1[xi] = tr_frag(lds_u32(sV + r0 * VSTR + vd0 + cc), lds_u32(sV + (r0 + 4) * VSTR + vd0 + cc)); }
#pragma unroll
            for (int mi = 0; mi < 4; ++mi) { const bf16x8 Y1 = *(const LAS bf16x8*)(sP + (16 * mi + fr) * PSTR + 32 * ks + 8 * fq);
#pragma unroll
                for (int xi = 0; xi < 2; ++xi) acc[mi][xi] = __builtin_amdgcn_mfma_f32_16x16x32_bf16(X1[xi], Y1, acc[mi][xi], 0, 0, 0); }
        }
        if (n) {
#pragma unroll
            for (int ks = 0; ks < 4; ++ks) {
#pragma unroll
                for (int mi = 0; mi < 4; ++mi) { const bf16x8 Y2 = *(const LAS bf16x8*)(sQi + (16 * mi + fr) * KSTR + 32 * ks + 8 * fq);
#pragma unroll
                    for (int xi = 0; xi < 2; ++xi) acc[mi][xi] = __builtin_amdgcn_mfma_f32_16x16x32_bf16(X2[ks][xi], Y2, acc[mi][xi], 0, 0, 0); }
            }
        }
#pragma unroll
        for (int mi = 0; mi < 4; ++mi) { float ss = 0.f;
#pragma unroll
            for (int xi = 0; xi < 2; ++xi) ss += (acc[mi][xi][0] * acc[mi][xi][0] + acc[mi][xi][1] * acc[mi][xi][1]) + (acc[mi][xi][2] * acc[mi][xi][2] + acc[mi][xi][3] * acc[mi][xi][3]);
            ss += __shfl_xor(ss, 16); ss += __shfl_xor(ss, 32);
            if (fq == 0) sRed[wave * 64 + 16 * mi + fr] = ss; }
        __syncthreads();
#pragma unroll
        for (int mi = 0; mi < 4; ++mi) {
            const int c = 16 * mi + fr, row = gla_row(b, n, c);
            float tot = 0.f;
#pragma unroll
            for (int w2 = 0; w2 < 8; ++w2) tot += sRed[w2 * 64 + c];
            const float rinv = 1.0f / sqrtf(tot * (1.0f / 256.0f) + RMS_EPS);
            if (row >= 0) {
#pragma unroll
                for (int xi = 0; xi < 2; ++xi) { const int vd = 32 * wave + 16 * xi + 4 * fq;
                    const float o0 = acc[mi][xi][0] * rinv * nw[xi][0] * bf_lo(gg[mi][xi].x), o1 = acc[mi][xi][1] * rinv * nw[xi][1] * bf_hi(gg[mi][xi].x);
                    const float o2 = acc[mi][xi][2] * rinv * nw[xi][2] * bf_lo(gg[mi][xi].y), o3 = acc[mi][xi][3] * rinv * nw[xi][3] * bf_hi(gg[mi][xi].y);
                    u32x2 wv; wv.x = pk2(o0, o1); wv.y = pk2(o2, o3);
                    pg8::wt8(Ob + (size_t)row * D + h * 256 + vd, wv); }
            }
        }
        __syncthreads();
    }
}

typedef __attribute__((address_space(1))) unsigned gu32;
#define XB_TMO      128
#define XB_XCNT(j)  (256  + 64 * (j))
#define XB_XSUB(j)  (1280 + 64 * (j))
#define XB_XGEN(j)  (2304 + 64 * (j))
#define XB_TOP      3328
#define XB_TOPGEN   3392
#define XCD_BAR_WORDS 3456
#define XB_SPIN_CAP (1u << 18)

__device__ __forceinline__ unsigned xb_ld(unsigned* p)              { return __hip_atomic_load(p, __ATOMIC_RELAXED, __HIP_MEMORY_SCOPE_AGENT); }
__device__ __forceinline__ unsigned xb_add(unsigned* p, unsigned v) { return __hip_atomic_fetch_add(p, v, __ATOMIC_RELAXED, __HIP_MEMORY_SCOPE_AGENT); }
__device__ __forceinline__ unsigned xb_xcc_id() { return (unsigned)__builtin_amdgcn_s_getreg((3 << 11) | 20) & 0xFu; }
#define XB_SPIN(cond, bar) do { unsigned _sp = 0; while (cond) { __builtin_amdgcn_s_sleep(1); \
    if ((++_sp & 255u) == 0u) { if (xb_ld(&(bar)[XB_TMO])) break; if (_sp > XB_SPIN_CAP) { atomicAdd(&(bar)[XB_TMO], 1u); break; } } } } while (0)

struct XcdBarrier {
    unsigned* bar; unsigned x;
    volatile LAS unsigned* st;
};

__device__ __forceinline__ XcdBarrier xcd_barrier_post(unsigned* bar, volatile LAS unsigned* st) {
    XcdBarrier b; b.bar = bar; b.x = xb_xcc_id(); b.st = st;
    if (threadIdx.x == 0) (void)xb_add(&bar[XB_XCNT(b.x)], 1u);
    return b;
}
__device__ __forceinline__ void xcd_barrier_complete(unsigned* bar, unsigned x, unsigned& nloc, unsigned& nx) {
    const unsigned G = gridDim.x * gridDim.y * gridDim.z;
    unsigned sum, cnt, mine, sp = 0u;
    for (;;) {
        sum = 0u; cnt = 0u; mine = 0u;
#pragma unroll
        for (unsigned j = 0; j < 16; ++j) { const unsigned c = xb_ld(&bar[XB_XCNT(j)]); sum += c; cnt += (c > 0u) ? 1u : 0u; mine = (j == x) ? c : mine; }
        if (sum == G) break;
        __builtin_amdgcn_s_sleep(1);
        if ((++sp & 255u) == 0u) { if (xb_ld(&bar[XB_TMO])) break; if (sp > XB_SPIN_CAP) { atomicAdd(&bar[XB_TMO], 1u); break; } }
    }
    nloc = mine > 0u ? mine : 1u; nx = cnt > 0u ? cnt : 1u;
}

__device__ __forceinline__ void xcd_barrier(const XcdBarrier& b) {
    asm volatile("s_waitcnt vmcnt(0)" ::: "memory");
    __syncthreads();
    if (threadIdx.x == 0) {
        unsigned* bar = b.bar;
        __builtin_amdgcn_s_waitcnt(0);
        unsigned nloc = b.st[0], nx = b.st[1];
        if (nloc == 0u) { xcd_barrier_complete(bar, b.x, nloc, nx); b.st[0] = nloc; b.st[1] = nx; }
        const unsigned old = xb_add(&bar[XB_XSUB(b.x)], 1u);
        const unsigned gen = old / nloc;
        if (old + 1u == (gen + 1u) * nloc) {
            asm volatile("s_waitcnt vmcnt(0)" ::: "memory");
            const unsigned og = xb_add(&bar[XB_TOP], 1u);
            const unsigned tg = og / nx;
            if (og + 1u == (tg + 1u) * nx) xb_add(&bar[XB_TOPGEN], 1u);
            else XB_SPIN(xb_ld(&bar[XB_TOPGEN]) == tg, bar);
            __builtin_amdgcn_fence(__ATOMIC_ACQUIRE, "agent");
            xb_add(&bar[XB_XGEN(b.x)], 1u);
            asm volatile("s_waitcnt vmcnt(0)" ::: "memory");
        } else {
            XB_SPIN(xb_ld(&bar[XB_XGEN(b.x)]) == gen, bar);
            __builtin_amdgcn_fence(__ATOMIC_ACQUIRE, "agent");
            asm volatile("s_waitcnt vmcnt(0)" ::: "memory");
        }
    }
    __syncthreads();
}

__device__ __forceinline__ void mini_gemm(LAS unsigned char* lds, const bf16* A, const bf16* B0, const bf16* B1, int K, int wave, int lane, f32x4& r0, f32x4& r1) {
    const int fr = lane & 15, fq = lane >> 4;
    f32x4 a0 = (f32x4){0.f, 0.f, 0.f, 0.f}, a1 = a0;
    const bf16* ap = A + (size_t)fr * K + 8 * fq; const bf16* b0p = B0 + (size_t)fr * K + 8 * fq; const bf16* b1p = B1 + (size_t)fr * K + 8 * fq;
    for (int ks = wave; ks < K / 32; ks += 8) {
        const bf16x8 af = *(const bf16x8*)(ap + 32 * ks), b0 = *(const bf16x8*)(b0p + 32 * ks), b1 = *(const bf16x8*)(b1p + 32 * ks);
        a0 = __builtin_amdgcn_mfma_f32_16x16x32_bf16(b0, af, a0, 0, 0, 0);
        a1 = __builtin_amdgcn_mfma_f32_16x16x32_bf16(b1, af, a1, 0, 0, 0);
    }
    LAS f32x4* red = (LAS f32x4*)lds;
    red[(wave * 2 + 0) * 64 + lane] = a0; red[(wave * 2 + 1) * 64 + lane] = a1;
    __syncthreads();
    if (wave == 0) {
        r0 = red[lane]; r1 = red[64 + lane];
#pragma unroll
        for (int w = 1; w < 8; ++w) { r0 += red[(w * 2) * 64 + lane]; r1 += red[(w * 2 + 1) * 64 + lane]; }
    }
    __syncthreads();
}
__device__ __forceinline__ u32x2 pack4(const f32x4 v) { u32x2 w; w.x = pk2(v[0], v[1]); w.y = pk2(v[2], v[3]); return w; }
__device__ __forceinline__ void mini_ffn_in(LAS unsigned char* lds, const bf16* HB, const bf16* Wt, bf16* ACT, int t, int wave, int lane) {
    const int pn = t >> 3, j0 = (t & 7) * 16; f32x4 g, u;
    mini_gemm(lds, HB + (size_t)MMETA0 * D, Wt + (size_t)(256 * pn + j0) * D, Wt + (size_t)(256 * pn + 128 + j0) * D, D, wave, lane, g, u);
    if (wave == 0) { f32x4 a;
#pragma unroll
        for (int j = 0; j < 4; ++j) a[j] = pg8::silu_f(g[j]) * u[j];
        pg8::wt8(ACT + (size_t)(MMETA0 + (lane & 15)) * FF + 16 * t + 4 * (lane >> 4), pack4(a)); }
}
__device__ __forceinline__ void mini_resid(LAS unsigned char* lds, const bf16* A, int K, const bf16* Wt, const float* src, float* dst, const float* stats, const float* gain, const float* bias, float scale, int t, int wave, int lane) {
    f32x4 r[2];
    mini_gemm(lds, A + (size_t)MMETA0 * K, Wt + (size_t)(32 * t) * K, Wt + (size_t)(32 * t + 16) * K, K, wave, lane, r[0], r[1]);
    if (wave == 0) { const int row = lane & 15; float mean = 0.f, rstd = 1.f;
        if (stats) { mean = stats[(size_t)(MMETA0 + row) * 2]; rstd = stats[(size_t)(MMETA0 + row) * 2 + 1]; }
#pragma unroll
        for (int q = 0; q < 2; ++q) { const int col = 32 * t + 16 * q + 4 * (lane >> 4);
            const f32x4 x = *(const f32x4*)(src + (size_t)row * D + col);
            f32x4 h = x;
            if (stats) h = (x - mean) * rstd * *(const f32x4*)(gain + col) + *(const f32x4*)(bias + col);
            pg8::wt16(dst + (size_t)row * D + col, h * ALPHA + r[q] * scale); } }
}
__device__ __forceinline__ void mini_conv_in(LAS unsigned char* lds, const bf16* HB, const bf16* Wt, bf16* CU, bf16* BG, int t, int wave, int lane) {
    f32x4 a, b;
    if (t < 64) { const int pn = t >> 3, j0 = (t & 7) * 16;
        mini_gemm(lds, HB + (size_t)MMETA0 * D, Wt + (size_t)(256 * pn + j0) * D, Wt + (size_t)(256 * pn + 128 + j0) * D, D, wave, lane, a, b);
        if (wave == 0) pg8::wt8(CU + (size_t)(MMETA0 + (lane & 15)) * D + 16 * t + 4 * (lane >> 4), pack4(a * b));
    } else { const int c0 = 16 * (t - 64);
        mini_gemm(lds, HB + (size_t)MMETA0 * D, Wt + (size_t)(2048 + c0) * D, Wt + (size_t)(2048 + c0) * D, D, wave, lane, a, b);
        if (wave == 0) pg8::wt8(BG + (size_t)(MMETA0 + (lane & 15)) * D + c0 + 4 * (lane >> 4), pack4(a)); }
}
__device__ __forceinline__ void mini_gla_in(LAS unsigned char* lds, const bf16* HB, const bf16* Wt, bf16* Q, bf16* Kk, bf16* V, bf16* G, float qscale, int t, int wave, int lane) {
    f32x4 r[2];
    mini_gemm(lds, HB + (size_t)MMETA0 * D, Wt + (size_t)(32 * t) * D, Wt + (size_t)(32 * t + 16) * D, D, wave, lane, r[0], r[1]);
    if (wave == 0) { const size_t row = MMETA0 + (lane & 15);
#pragma unroll
        for (int q = 0; q < 2; ++q) { const int c = 32 * t + 16 * q + 4 * (lane >> 4); f32x4 v = r[q];
            if (c < 512) pg8::wt8(Q + row * 512 + c, pack4(v * qscale));
            else if (c < 1024) pg8::wt8(Kk + row * 512 + (c - 512), pack4(v));
            else if (c < 2048) pg8::wt8(V + row * D + (c - 1024), pack4(v));
            else {
#pragma unroll
                for (int j = 0; j < 4; ++j) v[j] = pg8::silu_f(v[j]);
                pg8::wt8(G + row * D + (c - 2048), pack4(v)); } } }
}
__device__ __forceinline__ void gz_phase(const bf16* HB, const bf16* Wgz, float* GZ, int gw, int NGW, int lane) {
    const int fr = lane & 15, fq = lane >> 4;
    for (int rb = gw; rb < MREAL / 16 + 1; rb += NGW) {
        const size_t row0 = (size_t)rb * 16;
        const bf16* ap = HB + (row0 + fr) * D + 8 * fq; const bf16* bp = Wgz + (size_t)fr * D + 8 * fq;
        f32x4 a0 = (f32x4){0.f, 0.f, 0.f, 0.f}, a1 = a0;
#pragma unroll 4
        for (int ks = 0; ks < D / 32; ks += 2) {
            a0 = __builtin_amdgcn_mfma_f32_16x16x32_bf16(*(const bf16x8*)(bp + 32 * ks), *(const bf16x8*)(ap + 32 * ks), a0, 0, 0, 0);
            a1 = __builtin_amdgcn_mfma_f32_16x16x32_bf16(*(const bf16x8*)(bp + 32 * ks + 32), *(const bf16x8*)(ap + 32 * ks + 32), a1, 0, 0, 0);
        }
        pg8::wt16(GZ + (row0 + fr) * 16 + 4 * fq, a0 + a1);
    }
}


#ifndef REP_G1
#define REP_G1 1
#endif
#ifndef REP_G2
#define REP_G2 0
#endif
#ifndef REP_LN
#define REP_LN 1
#endif
#ifndef REP_GLA
#define REP_GLA 1
#endif
#ifndef REP_SYNC
#define REP_SYNC 0
#endif
#ifndef REP_MIX
#define REP_MIX 1
#endif
template <class Epi>
__device__ __forceinline__ void run_gemm(LAS unsigned char* lds, const bf16* A, const bf16* Bt, int N, int K, const Epi& E) {
    pg8::Gemm g{A, Bt, MREAL, N, K}; pg8::StaticOrder S; S.init(MREAL, N, (int)gridDim.x, (int)blockIdx.x);
    pg8::gemm_phase<Epi, pg8::StaticOrder, true, true>(lds, g, S, E);
}

__global__ void __launch_bounds__(512, 2) fwd_megakernel(Params p) {
    extern __shared__ __attribute__((aligned(16))) unsigned char lds_raw[];
    LAS unsigned char* lds = (LAS unsigned char*)lds_raw;
    cg::grid_group grid = cg::this_grid();
    if (threadIdx.x < 16) ((LAS unsigned*)(lds + LDS_BYTES - 64))[threadIdx.x] = 0u;
    __syncthreads();
    const XcdBarrier xbar = xcd_barrier_post((unsigned*)(p.ws + WS_BAR), (volatile LAS unsigned*)(lds + LDS_BYTES - 64));
#define GSYNC() xcd_barrier(xbar)
    const int tid0 = threadIdx.x;
#define FRESH_IDS() int tid = tid0; asm volatile("" : "+v"(tid)); const int lane = tid & 63, wave = __builtin_amdgcn_readfirstlane(tid >> 6); const int gw = vcu * 8 + wave
    const int G = gridDim.x, bx = blockIdx.x;
    const int vcu = (G % 8 == 0) ? (bx % 8) * (G / 8) + bx / 8 : bx;
    const int NGW = G * 8;
    unsigned char* ws = p.ws; unsigned char* big = ws + WS_BIG;
    bf16* HB = (bf16*)(ws + WS_HB); float* XM = (float*)(ws + WS_XM); float* METAR = (float*)(ws + WS_METAR); float* STATS = (float*)(ws + WS_STATS);
    bf16* ACT = (bf16*)(big + BIG_ACT);

#ifndef NO_P0
    { FRESH_IDS(); p0_prologue(p, lds, gw, NGW, wave, lane); }
#endif
    grid.sync();

    int lnk = 0;
#pragma clang loop unroll(disable)
    for (int blk = 0; blk < 4; ++blk) {
        {
            { FRESH_IDS(); if (bx < 176) mini_ffn_in(lds, HB, (const bf16*)(ws + WS_WFI + (size_t)blk * SZ_WFI), ACT, bx, wave, lane); }
            pg8::EpiSwiGLU E1{ACT, FF};
            for (int rep = 0; rep < REP_G1; ++rep) run_gemm(lds, HB, (const bf16*)(ws + WS_WFI + (size_t)blk * SZ_WFI), 2 * FF, D, E1);
            GSYNC();
            pg8::EpiResid E2;
            if (lnk == 0) E2 = pg8::EpiResid{p.x, METAR, p.out, XM, nullptr, nullptr, nullptr, ALPHA, 0.5f};
            else E2 = pg8::EpiResid{p.out, XM, p.out, XM, STATS, p.ln_gain + (lnk - 1) * D, p.ln_bias + (lnk - 1) * D, ALPHA, 0.5f};
            { FRESH_IDS(); if (bx >= 64 && bx < 96) mini_resid(lds, ACT, FF, (const bf16*)(ws + WS_WFO + (size_t)blk * SZ_WFO), lnk == 0 ? METAR : XM, XM, E2.stats, E2.gain, E2.bias, 0.5f, bx - 64, wave, lane); }
            for (int rep = 0; rep < REP_G2; ++rep) { pg8::EpiResid E3 = E2; E3.Oreal = (float*)(big + BIG_U); run_gemm(lds, ACT, (const bf16*)(ws + WS_WFO + (size_t)blk * SZ_WFO), D, FF, E3); }
            run_gemm(lds, ACT, (const bf16*)(ws + WS_WFO + (size_t)blk * SZ_WFO), D, FF, E2);
            GSYNC();
            if (blk == 3) { FRESH_IDS(); ln_phase<true>(p.out, XM, p.ln_gain + 5 * D, p.ln_bias + 5 * D, nullptr, nullptr, p.out, gw, NGW, lane); break; }
            for (int rep = 0; rep < REP_LN; ++rep) { FRESH_IDS(); ln_phase<false>(p.out, XM, p.ln_gain + lnk * D, p.ln_bias + lnk * D, HB, STATS, nullptr, gw, NGW, lane); } ++lnk;
            for (int rep = 0; rep < REP_SYNC; ++rep) GSYNC();
            GSYNC();
        }
        if (blk == 0 || blk == 2) {
            const bf16* Wo; const bf16* Ao = HB;
            if (blk == 0) {
                { FRESH_IDS(); if (bx < 128) mini_conv_in(lds, HB, (const bf16*)(ws + WS_WCI), (bf16*)(big + BIG_CU), (bf16*)(big + BIG_BG), bx, wave, lane); }
                pg8::EpiConvIn Ec{(bf16*)(big + BIG_CU), (bf16*)(big + BIG_BG)};
                run_gemm(lds, HB, (const bf16*)(ws + WS_WCI), 3072, D, Ec);
                GSYNC();
#ifndef NO_CM
                for (int rep = 0; rep < REP_MIX; ++rep) { FRESH_IDS(); conv_mix_phase((const bf16*)(big + BIG_BG), (const bf16*)(big + BIG_CU), p.conv_w, HB, gw, NGW, lane); }
#endif
                GSYNC();
                Wo = (const bf16*)(ws + WS_WCO);
            } else {
                { FRESH_IDS(); gz_phase(HB, (const bf16*)(ws + WS_WGI) + (size_t)3072 * D, (float*)(big + BIG_GZ), gw, NGW, lane);
                  if (bx >= 128 && bx < 224) mini_gla_in(lds, HB, (const bf16*)(ws + WS_WGI), (bf16*)(big + BIG_Q), (bf16*)(big + BIG_K), (bf16*)(big + BIG_V), (bf16*)(big + BIG_G), 0.08838834764831845f, bx - 128, wave, lane); }
                pg8::EpiGlaIn Eg{(bf16*)(big + BIG_Q), (bf16*)(big + BIG_K), (bf16*)(big + BIG_V), (bf16*)(big + BIG_G), (float*)(big + BIG_GZ), 0.08838834764831845f};
                run_gemm(lds, HB, (const bf16*)(ws + WS_WGI), 3072, D, Eg);
                GSYNC();
#ifndef NO_G1
                for (int rep = 0; rep < REP_GLA; ++rep) { FRESH_IDS(); gla_g1(p, lds, tid, wave, lane); }
#endif
                GSYNC();
#ifndef NO_G2
                { FRESH_IDS(); gla_g2(p, tid); }
#endif
                GSYNC();
#ifndef NO_G3
                for (int rep = 0; rep < REP_GLA; ++rep) { FRESH_IDS(); gla_g3(p, lds, tid, wave, lane); }
#endif
                GSYNC();
                Wo = (const bf16*)(ws + WS_WGO); Ao = (const bf16*)(big + BIG_V);
            }
            pg8::EpiResid Eo{p.out, XM, p.out, XM, STATS, p.ln_gain + (lnk - 1) * D, p.ln_bias + (lnk - 1) * D, ALPHA, 1.0f};
            { FRESH_IDS(); if (bx >= 32 && bx < 64) mini_resid(lds, Ao, D, Wo, XM, XM, STATS, Eo.gain, Eo.bias, 1.0f, bx - 32, wave, lane); }
            run_gemm(lds, Ao, Wo, D, D, Eo);
            GSYNC();
            for (int rep = 0; rep < REP_LN; ++rep) { FRESH_IDS(); ln_phase<false>(p.out, XM, p.ln_gain + lnk * D, p.ln_bias + lnk * D, HB, STATS, nullptr, gw, NGW, lane); } ++lnk;
            for (int rep = 0; rep < REP_SYNC; ++rep) GSYNC();
            GSYNC();
        }
    }
}

extern "C" void kernel_launch(void* const* d_in, const int* in_sizes, int n_in, void* d_out, int out_size, void* d_ws, size_t ws_size, hipStream_t stream) {
    static int grid_blocks = 0;
    if (grid_blocks == 0) {
        if (n_in != 14 || out_size != MREAL * D || ws_size < WS_END) { fprintf(stderr, "kernel_launch: unexpected shapes: n_in %d out %d ws %zu (need %zu)\n", n_in, out_size, ws_size, (size_t)WS_END); grid_blocks = -1; return; }
        int dev = 0, cus = 0, per_cu = 0;
        hipGetDevice(&dev); hipDeviceGetAttribute(&cus, hipDeviceAttributeMultiprocessorCount, dev);
        if (hipFuncSetAttribute((const void*)fwd_megakernel, hipFuncAttributeMaxDynamicSharedMemorySize, LDS_BYTES) != hipSuccess) { fprintf(stderr, "kernel_launch: hipFuncSetAttribute failed\n"); grid_blocks = -1; return; }
        if (hipOccupancyMaxActiveBlocksPerMultiprocessor(&per_cu, (const void*)fwd_megakernel, 512, LDS_BYTES) != hipSuccess || per_cu < 1) { fprintf(stderr, "kernel_launch: occupancy query says %d\n", per_cu); per_cu = 1; }
        (void)hipGetLastError();
        grid_blocks = cus * 1;
    }
    if (grid_blocks < 0) return;
    Params p{};
    p.x = (const float*)d_in[0]; p.meta = (const float*)d_in[1]; p.ln_gain = (const float*)d_in[2]; p.ln_bias = (const float*)d_in[3];
    p.ffn_w_in = (const float*)d_in[4]; p.ffn_w_out = (const float*)d_in[5]; p.conv_w_in = (const float*)d_in[6]; p.conv_w = (const float*)d_in[7];
    p.conv_w_out = (const float*)d_in[8]; p.gla_w_in = (const float*)d_in[9]; p.gla_w_up = (const float*)d_in[10]; p.gla_b_gate = (const float*)d_in[11];
    p.gla_norm_w = (const float*)d_in[12]; p.gla_w_out = (const float*)d_in[13]; p.out = (float*)d_out; p.ws = (unsigned char*)d_ws;
    if (hipMemsetAsync((char*)d_ws + WS_BAR, 0, WS_BAR_BYTES, stream) != hipSuccess) { fprintf(stderr, "kernel_launch: memset of barrier words failed\n"); return; }
    void* args[] = {&p};
    hipError_t e = hipLaunchCooperativeKernel((const void*)fwd_megakernel, dim3(grid_blocks), dim3(512), args, LDS_BYTES, stream);
    if (e != hipSuccess) fprintf(stderr, "cooperative launch failed: %s (grid %d)\n", hipGetErrorString(e), grid_blocks);
}
```

```cpp
#include <hip/hip_runtime.h>
#include <hip/hip_cooperative_groups.h>
#include <cstdio>
#include <cstdint>
namespace cg = cooperative_groups;

namespace pg8 {
#define PG8_LAS __attribute__((address_space(3)))
typedef unsigned short bf16_t;
typedef short bf16x8 __attribute__((ext_vector_type(8)));
typedef float f32x4 __attribute__((ext_vector_type(4)));
typedef unsigned u32x4 __attribute__((ext_vector_type(4)));
typedef unsigned u32x2 __attribute__((ext_vector_type(2)));
constexpr int BM = 256, BK = 64, HALF = 128, HTB = HALF * BK * 2  , STAGE_BYTES = 8 * HTB, NXCD = 8, WGM = 8;

__host__ __device__ __forceinline__ int lds_byte(int r, int c) { const int st = (r >> 4) * 2 + (c >> 5), rr = r & 15, cc = c & 31, ob = rr * 64 + cc * 2; return st * 1024 + (ob ^ (((ob >> 9) & 1) << 5)); }
__host__ __device__ __forceinline__ void stage_rc(int b, int& R, int& C) { const int st = b / 1024, sb = b % 1024, swz = sb ^ (((sb >> 9) & 1) << 5); R = (st >> 1) * 16 + swz / 64; C = (st & 1) * 32 + (swz % 64) / 2; }
__host__ __device__ __forceinline__ int perm32(int rho) { const int n = rho >> 4, i = rho & 15; return 8 * (i >> 2) + 4 * n + (i & 3); }

struct Unit { int pm, pn; };
struct Gemm { const bf16_t* A; const bf16_t* Bt; int M, N, K; };

struct StaticOrder {
    int nM, nN, nwg, G, c;
    __host__ __device__ void init(int M, int N, int G_, int c_) { nM = M / BM; nN = N / BM; nwg = nM * nN; G = G_; c = c_; }
    __host__ __device__ bool next(int i, Unit& u) const {
        const long L = (long)i * G + c; if (L >= nwg) return false;
        int wgid = (int)L; { const int q = nwg / NXCD, r = nwg % NXCD, xcd = wgid % NXCD, off = wgid / NXCD; wgid = (xcd < r ? xcd * (q + 1) : r * (q + 1) + (xcd - r) * q) + off; }
        const int nig = WGM * nN, gid = wgid / nig, fm = gid * WGM, gsz = (nM - fm) < WGM ? (nM - fm) : WGM;
        u.pm = fm + ((wgid % nig) % gsz); u.pn = (wgid % nig) / gsz; return true;
    }
    __device__ __forceinline__ void a_ready(const Unit&) const {}
    __device__ __forceinline__ void done(const Unit&) const {}
};

__device__ __forceinline__ unsigned cvt_pk_bf16(float lo, float hi) { unsigned r; asm volatile("v_cvt_pk_bf16_f32 %0, %1, %2" : "=v"(r) : "v"(lo), "v"(hi)); return r; }
__device__ __forceinline__ float silu_f(float x) { return x * __builtin_amdgcn_rcpf(1.0f + __builtin_amdgcn_exp2f(-1.44269504089f * x)); }
__device__ __forceinline__ u32x4 pack8(const f32x4 a, const f32x4 b) { u32x4 w; w.x = cvt_pk_bf16(a[0], a[1]); w.y = cvt_pk_bf16(a[2], a[3]); w.z = cvt_pk_bf16(b[0], b[1]); w.w = cvt_pk_bf16(b[2], b[3]); return w; }
__device__ __forceinline__ void wt16(void* p, u32x4 v) { asm volatile("global_store_dwordx4 %0, %1, off sc1\n\ts_nop 1" :: "v"(p), "v"(v)); }
__device__ __forceinline__ void wt16(void* p, f32x4 v) { asm volatile("global_store_dwordx4 %0, %1, off sc1\n\ts_nop 1" :: "v"(p), "v"(v)); }
__device__ __forceinline__ void wt8(void* p, unsigned long long v) { __hip_atomic_store((unsigned long long*)p, v, __ATOMIC_RELAXED, __HIP_MEMORY_SCOPE_AGENT); }
__device__ __forceinline__ void wt8(void* p, u32x2 v) { wt8(p, (unsigned long long)v.x | ((unsigned long long)v.y << 32)); }
__device__ __forceinline__ void wt4(float* p, float v) { __hip_atomic_store(p, v, __ATOMIC_RELAXED, __HIP_MEMORY_SCOPE_AGENT); }

constexpr int MROWS_REAL = 32768;

struct EpiSwiGLU {
    static constexpr bool PERM = true, AFTER_DRAIN = false;
    bf16_t* O; int ldc;
    __device__ __forceinline__ void operator()(const f32x4 (&acc)[2][2][4][2], const Unit& u, int wr, int wc, int fr, int fq) const {
        const int row0 = u.pm * BM + wr * 64 + fr, col0 = u.pn * HALF + wc * 32 + 8 * fq;
#pragma unroll
        for (int ai = 0; ai < 2; ++ai)
#pragma unroll
            for (int m = 0; m < 4; ++m) {
                bf16_t* rowp = O + (size_t)(row0 + ai * HALF + m * 16) * ldc + col0;
                f32x4 a0, a1;
#pragma unroll
                for (int j = 0; j < 4; ++j) { a0[j] = silu_f(acc[ai][0][m][0][j]) * acc[ai][1][m][0][j]; a1[j] = silu_f(acc[ai][0][m][1][j]) * acc[ai][1][m][1][j]; }
                wt16(rowp, pack8(a0, a1));
            }
    }
};

struct EpiResid {
    static constexpr bool PERM = false, AFTER_DRAIN = false;
    const float* Rreal; const float* Rmeta; float* Oreal; float* Ometa; const float* stats; const float* gain; const float* bias; float alpha, scale;
    __device__ __forceinline__ void operator()(const f32x4 (&acc)[2][2][4][2], const Unit& u, int wr, int wc, int fr, int fq) const {
        const float* src = Rreal + (size_t)u.pm * BM * 1024;
        float* dst = Oreal + (size_t)u.pm * BM * 1024;
        const int r0 = wr * 64 + fr, col0 = u.pn * BM + wc * 32 + 4 * fq;
        float mean[2][4], rstd[2][4];
#pragma unroll
        for (int ai = 0; ai < 2; ++ai)
#pragma unroll
            for (int m = 0; m < 4; ++m) {
                mean[ai][m] = 0.f; rstd[ai][m] = 1.f;
                if (stats) { const float2 s = *(const float2*)(stats + (size_t)(u.pm * BM + r0 + ai * HALF + m * 16) * 2); mean[ai][m] = s.x; rstd[ai][m] = s.y; }
            }
#pragma unroll
        for (int bj = 0; bj < 2; ++bj)
#pragma unroll
            for (int n = 0; n < 2; ++n) {
                const int c = col0 + bj * HALF + n * 16;
                f32x4 gv = (f32x4){1.f, 1.f, 1.f, 1.f}, bv = (f32x4){0.f, 0.f, 0.f, 0.f};
                if (stats) { gv = *(const f32x4*)(gain + c); bv = *(const f32x4*)(bias + c); }
#pragma unroll
                for (int ai = 0; ai < 2; ++ai)
#pragma unroll
                    for (int m = 0; m < 4; ++m) {
                        const size_t off = (size_t)(r0 + ai * HALF + m * 16) * 1024 + c;
                        const f32x4 x = *(const f32x4*)(src + off);
                        const f32x4 h = (x - mean[ai][m]) * rstd[ai][m] * gv + bv;
                        wt16(dst + off, h * alpha + acc[ai][bj][m][n] * scale);
                    }
                asm volatile("" ::: "memory");
            }
    }
};

struct EpiConvIn {
    static constexpr bool PERM = true, AFTER_DRAIN = false;
    bf16_t* CU; bf16_t* BG;
    __device__ __forceinline__ void operator()(const f32x4 (&acc)[2][2][4][2], const Unit& u, int wr, int wc, int fr, int fq) const {
        const int row0 = u.pm * BM + wr * 64 + fr;
        if (u.pn < 8) {
            const int col0 = u.pn * HALF + wc * 32 + 8 * fq;
#pragma unroll
            for (int ai = 0; ai < 2; ++ai)
#pragma unroll
                for (int m = 0; m < 4; ++m) {
                    bf16_t* rowp = CU + (size_t)(row0 + ai * HALF + m * 16) * 1024 + col0;
                    wt16(rowp, pack8(acc[ai][0][m][0] * acc[ai][1][m][0], acc[ai][0][m][1] * acc[ai][1][m][1]));
                }
        } else {
            const int col0 = (u.pn - 8) * BM + wc * 32 + 8 * fq;
#pragma unroll
            for (int ai = 0; ai < 2; ++ai)
#pragma unroll
                for (int m = 0; m < 4; ++m) {
                    bf16_t* rowp = BG + (size_t)(row0 + ai * HALF + m * 16) * 1024 + col0;
#pragma unroll
                    for (int bj = 0; bj < 2; ++bj) wt16(rowp + bj * HALF, pack8(acc[ai][bj][m][0], acc[ai][bj][m][1]));
                }
        }
    }
};

struct EpiGlaIn {
    static constexpr bool PERM = true, AFTER_DRAIN = false;
    bf16_t* Q; bf16_t* Kk; bf16_t* V; bf16_t* G; float* GZ; float qscale;
    __device__ __forceinline__ void operator()(const f32x4 (&acc)[2][2][4][2], const Unit& u, int wr, int wc, int fr, int fq) const {
        const int row0 = u.pm * BM + wr * 64 + fr;
        bf16_t* base; int ld, colt; float sc = 1.f; bool act = false;
        if (u.pn < 2) { base = Q; ld = 512; colt = u.pn * BM; sc = qscale; }
        else if (u.pn < 4) { base = Kk; ld = 512; colt = (u.pn - 2) * BM; }
        else if (u.pn < 8) { base = V; ld = 1024; colt = (u.pn - 4) * BM; }
        else { base = G; ld = 1024; colt = (u.pn - 8) * BM; act = true; }
        const int col0 = colt + wc * 32 + 8 * fq;
#pragma unroll
        for (int ai = 0; ai < 2; ++ai)
#pragma unroll
            for (int m = 0; m < 4; ++m) {
                bf16_t* rowp = base + (size_t)(row0 + ai * HALF + m * 16) * ld + col0;
#pragma unroll
                for (int bj = 0; bj < 2; ++bj) {
                    f32x4 v0 = acc[ai][bj][m][0] * sc, v1 = acc[ai][bj][m][1] * sc;
                    if (act) {
#pragma unroll
                        for (int j = 0; j < 4; ++j) { v0[j] = silu_f(v0[j]); v1[j] = silu_f(v1[j]); }
                    }
                    wt16(rowp + bj * HALF, pack8(v0, v1));
                }
            }
    }
};

template <class Epi, class Sched, bool ALIGN_EPI = false, bool SP2 = false>
__device__ __forceinline__ void gemm_phase(PG8_LAS unsigned char* lds, const Gemm g, const Sched& S, const Epi& E) {
    int tid_ = threadIdx.x; asm volatile("" : "+v"(tid_));
    const int tid = tid_, wid = __builtin_amdgcn_readfirstlane(tid >> 6), lane = tid & 63, wr = wid >> 2, wc = wid & 3, fr = lane & 15, fq = lane >> 4;
    const int K = g.K, nt = K / BK;
    unsigned voffA[2], voffB[2];
#pragma unroll
    for (int i = 0; i < 2; ++i) { int R, C; stage_rc(tid * 16 + i * 8192, R, C); const int Rb = Epi::PERM ? ((R & ~31) + perm32(R & 31)) : R;
        voffA[i] = (unsigned)(R * K + C) * 2u; voffB[i] = (unsigned)(Rb * K + C) * 2u; }
    const size_t kstep = (size_t)(BK * 2);
    const size_t hstep = (size_t)HALF * K * 2;
    const size_t tstep = 2 * hstep;
    const unsigned ldsw = (unsigned)wid * 1024u;
    const int aoff = lds_byte(wr * 64 + fr, fq * 8), boff = lds_byte(wc * 32 + fr, fq * 8);
#define PG8_SA(b, h) (((b) * 2 + (h)) * HTB)
#define PG8_SB(b, h) ((4 + (b) * 2 + (h)) * HTB)
#define PG8_STAGE(bufoff, gbase, voff) do { _Pragma("unroll") for (int _i = 0; _i < 2; ++_i) \
        __builtin_amdgcn_global_load_lds((const unsigned*)((const char*)(gbase) + (voff)[_i]), (PG8_LAS unsigned*)(lds + (bufoff) + ldsw + _i * 8192), 16, 0, 0); } while (0)
#define PG8_LDA(dst, b, h) do { _Pragma("unroll") for (int m = 0; m < 4; ++m) _Pragma("unroll") for (int k = 0; k < 2; ++k) dst[m][k] = *(const PG8_LAS bf16x8*)(lds + PG8_SA(b, h) + aoff + m * 2048 + k * 1024); } while (0)
#define PG8_LDB(dst, b, h) do { _Pragma("unroll") for (int n = 0; n < 2; ++n) _Pragma("unroll") for (int k = 0; k < 2; ++k) dst[n][k] = *(const PG8_LAS bf16x8*)(lds + PG8_SB(b, h) + boff + n * 2048 + k * 1024); } while (0)
#define PG8_MMA(ai, bj, At, Bt) do { __builtin_amdgcn_s_setprio(1); _Pragma("unroll") for (int m = 0; m < 4; ++m) _Pragma("unroll") for (int n = 0; n < 2; ++n) _Pragma("unroll") for (int k = 0; k < 2; ++k) \
        acc[ai][bj][m][n] = __builtin_amdgcn_mfma_f32_16x16x32_bf16(Bt[n][k], At[m][k], acc[ai][bj][m][n], 0, 0, 0); __builtin_amdgcn_s_setprio(0); } while (0)
#define PG8_WAIT_V(n) asm volatile("s_waitcnt vmcnt(" #n ")" ::: "memory")
#define PG8_WAIT_L(n) asm volatile("s_waitcnt lgkmcnt(" #n ")" ::: "memory")
#define PG8_BAR __builtin_amdgcn_s_barrier()
#define PG8_SCHED __builtin_amdgcn_sched_barrier(0)
    Unit cur, nxt; int ui = 0;
    if (!S.next(0, cur)) return;
    f32x4 acc[2][2][4][2];
#pragma unroll
    for (int a = 0; a < 2; ++a)
#pragma unroll
        for (int b = 0; b < 2; ++b)
#pragma unroll
            for (int m = 0; m < 4; ++m)
#pragma unroll
                for (int n = 0; n < 2; ++n) acc[a][b][m][n] = (f32x4){0.f, 0.f, 0.f, 0.f};
    bf16x8 At[4][2], B0[2][2], B1[2][2];
    const char* cA = (const char*)g.A + (size_t)cur.pm * tstep; const char* cB = (const char*)g.Bt + (size_t)cur.pn * tstep;
    S.a_ready(cur);
    if constexpr (SP2) {
        PG8_STAGE(PG8_SB(0, 0), cB, voffB); PG8_STAGE(PG8_SB(0, 1), cB + hstep, voffB); PG8_STAGE(PG8_SA(0, 0), cA, voffA); PG8_STAGE(PG8_SA(0, 1), cA + hstep, voffA);
        if (wr == 1) PG8_BAR;
        PG8_WAIT_V(2); PG8_BAR;
        PG8_STAGE(PG8_SB(1, 0), cB + kstep, voffB); PG8_STAGE(PG8_SA(1, 0), cA + kstep, voffA); PG8_STAGE(PG8_SB(1, 1), cB + hstep + kstep, voffB);
        PG8_WAIT_V(6); PG8_BAR;
    } else {
        PG8_STAGE(PG8_SB(0, 0), cB, voffB); PG8_STAGE(PG8_SA(0, 0), cA, voffA); PG8_STAGE(PG8_SB(0, 1), cB + hstep, voffB); PG8_STAGE(PG8_SA(0, 1), cA + hstep, voffA);
        if (wr == 1) PG8_BAR;
        PG8_WAIT_V(4); PG8_BAR;
        PG8_STAGE(PG8_SB(1, 0), cB + kstep, voffB); PG8_STAGE(PG8_SA(1, 0), cA + kstep, voffA); PG8_STAGE(PG8_SB(1, 1), cB + hstep + kstep, voffB);
        PG8_WAIT_V(6); PG8_BAR;
    }
    for (;;) {
        const bool has_next = S.next(ui + 1, nxt);
        const char* nA = has_next ? (const char*)g.A + (size_t)nxt.pm * tstep : cA; const char* nB = has_next ? (const char*)g.Bt + (size_t)nxt.pn * tstep : cB;
        for (int t = 0; t < nt; t += 2) {
            const bool last = (t == nt - 2);
            const char* a1 = cA + (size_t)(t + 1) * kstep;
            const char* a2 = last ? nA : cA + (size_t)(t + 2) * kstep; const char* b2 = last ? nB : cB + (size_t)(t + 2) * kstep;
            const char* a3 = a2 + kstep; const char* b3 = b2 + kstep;
            if (last && has_next) S.a_ready(nxt);
            if constexpr (SP2) {
            PG8_LDB(B0, 0, 0); PG8_LDB(B1, 0, 1); PG8_SCHED; PG8_LDA(At, 0, 0); PG8_STAGE(PG8_SA(1, 1), a1 + hstep, voffA);
            PG8_WAIT_V(8); PG8_WAIT_L(0); PG8_BAR; PG8_MMA(0, 0, At, B0); PG8_MMA(0, 1, At, B1); PG8_BAR; PG8_SCHED;
            PG8_LDA(At, 0, 1); PG8_STAGE(PG8_SB(0, 0), b2, voffB); PG8_STAGE(PG8_SB(0, 1), b2 + hstep, voffB); PG8_STAGE(PG8_SA(0, 0), a2, voffA);
            PG8_WAIT_V(8); PG8_WAIT_L(0); PG8_BAR; PG8_MMA(1, 0, At, B0); PG8_MMA(1, 1, At, B1); PG8_BAR; PG8_SCHED;
            PG8_LDB(B0, 1, 0); PG8_LDB(B1, 1, 1); PG8_SCHED; PG8_LDA(At, 1, 0); PG8_STAGE(PG8_SA(0, 1), a2 + hstep, voffA);
            PG8_WAIT_V(8); PG8_WAIT_L(0); PG8_BAR; PG8_MMA(0, 0, At, B0); PG8_MMA(0, 1, At, B1); PG8_BAR; PG8_SCHED;
            PG8_LDA(At, 1, 1); PG8_STAGE(PG8_SB(1, 0), b3, voffB); PG8_STAGE(PG8_SB(1, 1), b3 + hstep, voffB); PG8_STAGE(PG8_SA(1, 0), a3, voffA);
            PG8_WAIT_V(8); PG8_WAIT_L(0); PG8_BAR; PG8_MMA(1, 0, At, B0); PG8_MMA(1, 1, At, B1); PG8_BAR; PG8_SCHED;
            } else {
            PG8_LDB(B0, 0, 0); PG8_SCHED; PG8_LDA(At, 0, 0); PG8_STAGE(PG8_SA(1, 1), a1 + hstep, voffA);
            PG8_WAIT_L(8); PG8_BAR; PG8_WAIT_L(0); PG8_MMA(0, 0, At, B0); PG8_BAR; PG8_SCHED;
            PG8_LDB(B1, 0, 1); PG8_STAGE(PG8_SB(0, 0), b2, voffB);
            PG8_BAR; PG8_WAIT_L(0); PG8_MMA(0, 1, At, B1); PG8_BAR;
            PG8_LDA(At, 0, 1); PG8_STAGE(PG8_SA(0, 0), a2, voffA);
            PG8_BAR; PG8_WAIT_L(0); PG8_MMA(1, 0, At, B0); PG8_BAR; PG8_SCHED;
            PG8_STAGE(PG8_SB(0, 1), b2 + hstep, voffB);
            PG8_WAIT_V(6); PG8_BAR; PG8_MMA(1, 1, At, B1); PG8_BAR;
            PG8_LDB(B0, 1, 0); PG8_SCHED; PG8_LDA(At, 1, 0); PG8_STAGE(PG8_SA(0, 1), a2 + hstep, voffA);
            PG8_WAIT_L(8); PG8_BAR; PG8_WAIT_L(0); PG8_MMA(0, 0, At, B0); PG8_BAR; PG8_SCHED;
            PG8_LDB(B1, 1, 1); PG8_STAGE(PG8_SB(1, 0), b3, voffB);
            PG8_BAR; PG8_WAIT_L(0); PG8_MMA(0, 1, At, B1); PG8_BAR;
            PG8_LDA(At, 1, 1); PG8_STAGE(PG8_SA(1, 0), a3, voffA);
            PG8_BAR; PG8_WAIT_L(0); PG8_MMA(1, 0, At, B0); PG8_BAR; PG8_SCHED;
            PG8_STAGE(PG8_SB(1, 1), b3 + hstep, voffB);
            PG8_WAIT_V(6); PG8_BAR; PG8_MMA(1, 1, At, B1); PG8_BAR;
            }
        }
        if constexpr (ALIGN_EPI) { if (wr == 0) PG8_BAR; }
        if constexpr (!Epi::AFTER_DRAIN) { E(acc, cur, wr, wc, fr, fq); S.done(cur); }
        if (!has_next) break;
#pragma unroll
        for (int a = 0; a < 2; ++a)
#pragma unroll
            for (int b = 0; b < 2; ++b)
#pragma unroll
                for (int m = 0; m < 4; ++m)
#pragma unroll
                    for (int n = 0; n < 2; ++n) acc[a][b][m][n] = (f32x4){0.f, 0.f, 0.f, 0.f};
        cur = nxt; cA = nA; cB = nB; ++ui;
        if constexpr (ALIGN_EPI) { if (wr == 1) PG8_BAR; }
    }
    PG8_WAIT_V(0);
    if constexpr (!ALIGN_EPI) { if (wr == 0) PG8_BAR; }
    PG8_BAR;
    if constexpr (Epi::AFTER_DRAIN) { E.fused(acc, cur, wr, wc, fr, fq, lds, wid, lane); S.done(cur); }
#undef PG8_SA
#undef PG8_SB
#undef PG8_STAGE
#undef PG8_LDA
#undef PG8_LDB
#undef PG8_MMA
#undef PG8_WAIT_V
#undef PG8_WAIT_L
#undef PG8_BAR
#undef PG8_SCHED
}
}

#define LAS __attribute__((address_space(3)))
typedef unsigned short bf16;
typedef float f32x4 __attribute__((ext_vector_type(4)));
typedef short bf16x8 __attribute__((ext_vector_type(8)));
typedef short s16x4 __attribute__((ext_vector_type(4)));
typedef unsigned u32x4 __attribute__((ext_vector_type(4)));
typedef unsigned u32x2 __attribute__((ext_vector_type(2)));

constexpr int D = 1024, FF = 2816, SEQ = 8192, NB = 4, NMETA = 16;
constexpr int MREAL = NB * SEQ;
constexpr int MMETA0 = MREAL;
constexpr int MPAD = MREAL + 256;
constexpr int NCH = 129;
constexpr int GLA_NIN = 3328;
constexpr float LN_EPS = 1e-5f, RMS_EPS = 1e-6f;
constexpr float ALPHA = 1.41421356237f;

constexpr size_t al256(size_t x) { return (x + 255) & ~(size_t)255; }
constexpr size_t SZ_WFI = (size_t)2 * FF * D * 2, SZ_WFO = (size_t)D * FF * 2;
constexpr size_t WS_WFI = 0;
constexpr size_t WS_WFO = WS_WFI + 4 * SZ_WFI;
constexpr size_t WS_WCI = WS_WFO + 4 * SZ_WFO;
constexpr size_t WS_WCO = WS_WCI + (size_t)3072 * D * 2;
constexpr size_t WS_WGI = WS_WCO + (size_t)D * D * 2;
constexpr size_t WS_WGO = WS_WGI + (size_t)GLA_NIN * D * 2;
constexpr size_t WS_HB = WS_WGO + (size_t)D * D * 2;
constexpr size_t WS_XM = WS_HB + (size_t)MPAD * D * 2;
constexpr size_t WS_METAR = WS_XM + (size_t)256 * D * 4;
constexpr size_t WS_STATS = WS_METAR + (size_t)256 * D * 4;
constexpr size_t WS_BIG = al256(WS_STATS + (size_t)MPAD * 8);
constexpr size_t SZ_ROWBF = (size_t)MPAD * D * 2;
constexpr size_t BIG_ACT = 0;
constexpr size_t BIG_BG = 0, BIG_CU = SZ_ROWBF;
constexpr size_t BIG_Q = 0, BIG_K = SZ_ROWBF / 2, BIG_V = SZ_ROWBF, BIG_G = 2 * SZ_ROWBF, BIG_GZ = 3 * SZ_ROWBF;
constexpr size_t BIG_U = al256(BIG_GZ + (size_t)MPAD * 16 * 4);
constexpr size_t BIG_DEC = BIG_U + (size_t)NCH * 16 * 32768 * 2;
constexpr size_t BIG_END = BIG_DEC + (size_t)NCH * 16 * 128 * 4;
constexpr size_t WS_BAR = al256(WS_BIG + BIG_END);
constexpr size_t WS_BAR_BYTES = 16384;
constexpr size_t WS_END = WS_BAR + WS_BAR_BYTES;
static_assert((size_t)MPAD * FF * 2 <= BIG_END, "act fits");

constexpr int LDS_BYTES = 147456;

struct Params {
    const float* x; const float* meta; const float* ln_gain; const float* ln_bias; const float* ffn_w_in; const float* ffn_w_out;
    const float* conv_w_in; const float* conv_w; const float* conv_w_out; const float* gla_w_in; const float* gla_w_up; const float* gla_b_gate;
    const float* gla_norm_w; const float* gla_w_out; float* out; unsigned char* ws;
};

__device__ __forceinline__ unsigned f2bf(float f) { unsigned u = __builtin_bit_cast(unsigned, f); return (u + 0x7fffu + ((u >> 16) & 1u)) >> 16; }
__device__ __forceinline__ unsigned pk2(float lo, float hi) { return pg8::cvt_pk_bf16(lo, hi); }
__device__ __forceinline__ float bf_lo(unsigned w) { return __builtin_bit_cast(float, w << 16); }
__device__ __forceinline__ float bf_hi(unsigned w) { return __builtin_bit_cast(float, w & 0xffff0000u); }
__device__ __forceinline__ float wave_sum(float v) {
#pragma unroll
    for (int o = 1; o < 64; o <<= 1) v += __shfl_xor(v, o);
    return v;
}
#define LDS_WAIT() asm volatile("s_waitcnt lgkmcnt(0)" ::: "memory")

__device__ __forceinline__ void p0_transpose_item(const float* W, int K, int ldw, int scol, int nvalid, bf16* WT, int n0d, int k0, LAS float* scr, int lane) {
    float tv[32];
#pragma unroll
    for (int i = 0; i < 32; ++i) { const int kk = 2 * i + (lane >> 5), j = lane & 31; tv[i] = (j < nvalid) ? W[(size_t)(k0 + kk) * ldw + scol + j] : 0.f; }
#pragma unroll
    for (int i = 0; i < 32; ++i) { const int kk = 2 * i + (lane >> 5), j = lane & 31; scr[kk * 33 + j] = tv[i]; }
    LDS_WAIT(); asm volatile("" ::: "memory");
    const int c = lane & 7;
#pragma unroll
    for (int jj = 0; jj < 4; ++jj) { const int n = (lane >> 3) + 8 * jj; const LAS float* s = scr + (8 * c) * 33 + n;
        u32x4 o; o.x = pk2(s[0 * 33], s[1 * 33]); o.y = pk2(s[2 * 33], s[3 * 33]); o.z = pk2(s[4 * 33], s[5 * 33]); o.w = pk2(s[6 * 33], s[7 * 33]);
        pg8::wt16(WT + (size_t)(n0d + n) * K + k0 + 8 * c, o); }
    LDS_WAIT(); asm volatile("" ::: "memory");
}
__device__ __forceinline__ void p0_matrix(const float* W, int K, int Nsrc, int Ndst, int mode, bf16* WT, LAS float* scr, int lane, int item) {
    const int nblk = Ndst / 32, kb = item / nblk, nb = item % nblk, n0d = nb * 32, k0 = kb * 64;
    int scol = n0d, nvalid = 32;
    if (mode == 1) { const int pn = n0d >> 8, j = n0d & 255; scol = (j < 128) ? 128 * pn + j : FF + 128 * pn + (j - 128); }
    else if (mode == 2) { const int pn = n0d >> 8, j = n0d & 255; scol = (pn < 8) ? ((j < 128) ? 1024 + 128 * pn + j : 2048 + 128 * pn + (j - 128)) : 256 * (pn - 8) + j; }
    else if (mode == 3) { nvalid = Nsrc - n0d; nvalid = nvalid < 0 ? 0 : (nvalid > 32 ? 32 : nvalid); if (nvalid == 0) scol = 0; }
    p0_transpose_item(W, K, Nsrc, scol, nvalid, WT, n0d, k0, scr, lane);
}
__device__ __forceinline__ void p0_prologue(const Params& p, LAS unsigned char* lds, int gw, int NGW, int wave, int lane) {
    LAS float* scr = (LAS float*)(lds + wave * 16384);
    unsigned char* ws = p.ws;
    constexpr int I_FI = (D / 64) * (2 * FF / 32), I_FO = (FF / 64) * (D / 32), I_CI = (D / 64) * (3072 / 32), I_SQ = (D / 64) * (D / 32), I_GI = (D / 64) * (GLA_NIN / 32);
    constexpr int NITEMS = 4 * I_FI + 4 * I_FO + I_CI + I_SQ + I_GI + I_SQ;
    for (int it = gw; it < NITEMS; it += NGW) {
        int r = it;
        if (r < 4 * I_FI) { const int l = r / I_FI; p0_matrix(p.ffn_w_in + (size_t)l * D * 2 * FF, D, 2 * FF, 2 * FF, 1, (bf16*)(ws + WS_WFI + l * SZ_WFI), scr, lane, r % I_FI); continue; } r -= 4 * I_FI;
        if (r < 4 * I_FO) { const int l = r / I_FO; p0_matrix(p.ffn_w_out + (size_t)l * FF * D, FF, D, D, 0, (bf16*)(ws + WS_WFO + l * SZ_WFO), scr, lane, r % I_FO); continue; } r -= 4 * I_FO;
        if (r < I_CI) { p0_matrix(p.conv_w_in, D, 3072, 3072, 2, (bf16*)(ws + WS_WCI), scr, lane, r); continue; } r -= I_CI;
        if (r < I_SQ) { p0_matrix(p.conv_w_out, D, D, D, 0, (bf16*)(ws + WS_WCO), scr, lane, r); continue; } r -= I_SQ;
        if (r < I_GI) { p0_matrix(p.gla_w_in, D, 3088, GLA_NIN, 3, (bf16*)(ws + WS_WGI), scr, lane, r); continue; } r -= I_GI;
        p0_matrix(p.gla_w_out, D, D, D, 0, (bf16*)(ws + WS_WGO), scr, lane, r);
    }
    bf16* HB = (bf16*)(ws + WS_HB); float* METAR = (float*)(ws + WS_METAR);
    for (int m0 = gw; m0 < MREAL + NMETA; m0 += 4 * NGW) {
        f32x4 v[4][4];
#pragma unroll
        for (int r = 0; r < 4; ++r) { const int m = m0 + r * NGW;
            if (m < MREAL + NMETA) { const float* src = (m < MREAL) ? p.x + (size_t)m * D : p.meta + (size_t)(m - MREAL) * D;
#pragma unroll
                for (int j = 0; j < 4; ++j) v[r][j] = ((const f32x4*)src)[lane + 64 * j]; } }
#pragma unroll
        for (int r = 0; r < 4; ++r) { const int m = m0 + r * NGW;
            if (m < MREAL + NMETA) {
                unsigned long long* o8 = (unsigned long long*)(HB + (size_t)m * D) + lane;
#pragma unroll
                for (int j = 0; j < 4; ++j) {
                    pg8::wt8(o8 + 64 * j, (unsigned long long)pk2(v[r][j][0], v[r][j][1]) | ((unsigned long long)pk2(v[r][j][2], v[r][j][3]) << 32));
                    if (m >= MREAL) pg8::wt16((f32x4*)(METAR + (size_t)(m - MREAL) * D) + lane + 64 * j, v[r][j]);
                } } }
    }
}

template <bool FINAL>
__device__ __forceinline__ void ln_phase(const float* Zreal, const float* Zmeta, const float* gain, const float* bias, bf16* HB, float* stats, float* out, int gw, int NGW, int lane) {
    f32x4 g[4], bb[4];
#pragma unroll
    for (int j = 0; j < 4; ++j) { g[j] = ((const f32x4*)gain)[lane + 64 * j]; bb[j] = ((const f32x4*)bias)[lane + 64 * j]; }
    const int nrows = FINAL ? MREAL : MREAL + NMETA;
    for (int m0 = gw; m0 < nrows; m0 += 4 * NGW) {
        f32x4 v[4][4];
#pragma unroll
        for (int r = 0; r < 4; ++r) { const int m = m0 + r * NGW;
            if (m < nrows) { const float* zr = (m < MREAL) ? Zreal + (size_t)m * D : Zmeta + (size_t)(m - MREAL) * D;
#pragma unroll
                for (int j = 0; j < 4; ++j) v[r][j] = ((const f32x4*)zr)[lane + 64 * j]; }
            else {
#pragma unroll
                for (int j = 0; j < 4; ++j) v[r][j] = (f32x4){0.f, 0.f, 0.f, 0.f}; } }
#pragma unroll
        for (int r = 0; r < 4; ++r) { const int m = m0 + r * NGW;
            float s = 0.f;
#pragma unroll
            for (int j = 0; j < 4; ++j) s += (v[r][j][0] + v[r][j][1]) + (v[r][j][2] + v[r][j][3]);
            const float mean = wave_sum(s) * (1.f / D); float s2 = 0.f;
#pragma unroll
            for (int j = 0; j < 4; ++j) { const f32x4 d = v[r][j] - mean; s2 += (d[0] * d[0] + d[1] * d[1]) + (d[2] * d[2] + d[3] * d[3]); }
            const float rstd = 1.0f / sqrtf(wave_sum(s2) * (1.f / D) + LN_EPS);
            if (m < nrows) {
                if (FINAL) {
#pragma unroll
                    for (int j = 0; j < 4; ++j) ((f32x4*)(out + (size_t)m * D))[lane + 64 * j] = (v[r][j] - mean) * rstd * g[j] + bb[j];
                } else {
                    if (lane == 0) pg8::wt8(stats + (size_t)m * 2, (unsigned long long)__float_as_uint(mean) | ((unsigned long long)__float_as_uint(rstd) << 32));
                    unsigned long long* o8 = (unsigned long long*)(HB + (size_t)m * D) + lane;
#pragma unroll
                    for (int j = 0; j < 4; ++j) { const f32x4 y = (v[r][j] - mean) * rstd * g[j] + bb[j]; pg8::wt8(o8 + 64 * j, (unsigned long long)pk2(y[0], y[1]) | ((unsigned long long)pk2(y[2], y[3]) << 32)); }
                }
            }
        }
    }
}

__device__ __forceinline__ int conv_pred(int m, int k) {
    if (m < MREAL) { const int t = m & (SEQ - 1); return (t >= k) ? m - k : MMETA0 + (NMETA + t - k); }
    const int j = m - MMETA0; return (j >= k) ? m - k : -1;
}
__device__ __forceinline__ void conv_mix_phase(const bf16* BG, const bf16* CU, const float* cw, bf16* VO, int gw, int NGW, int lane) {
    const int nrows = MREAL + NMETA;
    const u32x4 z4 = (u32x4){0u, 0u, 0u, 0u};
    float wt[3][16];
#pragma unroll
    for (int k = 0; k < 3; ++k)
#pragma unroll
        for (int j = 0; j < 2; ++j)
#pragma unroll
            for (int q = 0; q < 2; ++q) { const f32x4 t = *(const f32x4*)(cw + k * D + 8 * (lane + 64 * j) + 4 * q);
                wt[k][8 * j + 4 * q] = t[0]; wt[k][8 * j + 4 * q + 1] = t[1]; wt[k][8 * j + 4 * q + 2] = t[2]; wt[k][8 * j + 4 * q + 3] = t[3]; }
    for (int m0 = gw; m0 < nrows; m0 += 2 * NGW) {
        u32x4 b4[2][2], x0[2][2], x1[2][2], x2[2][2];
#pragma unroll
        for (int r = 0; r < 2; ++r) { const int m = m0 + r * NGW; const bool ok = m < nrows;
            const int p1 = ok ? conv_pred(m, 1) : -1, p2 = ok ? conv_pred(m, 2) : -1;
#pragma unroll
            for (int j = 0; j < 2; ++j) { const int c0 = 8 * (lane + 64 * j);
                b4[r][j] = ok ? *(const u32x4*)(BG + (size_t)m * D + c0) : z4; x0[r][j] = ok ? *(const u32x4*)(CU + (size_t)m * D + c0) : z4;
                x1[r][j] = (p1 >= 0) ? *(const u32x4*)(CU + (size_t)p1 * D + c0) : z4; x2[r][j] = (p2 >= 0) ? *(const u32x4*)(CU + (size_t)p2 * D + c0) : z4; } }
#pragma unroll
        for (int r = 0; r < 2; ++r) { const int m = m0 + r * NGW;
            if (m < nrows) {
#pragma unroll
                for (int j = 0; j < 2; ++j) { u32x4 o;
#pragma unroll
                    for (int q = 0; q < 4; ++q) { const int e = 8 * j + 2 * q;
                        const float lo = bf_lo(b4[r][j][q]) * (wt[0][e] * bf_lo(x2[r][j][q]) + wt[1][e] * bf_lo(x1[r][j][q]) + wt[2][e] * bf_lo(x0[r][j][q]));
                        const float hi = bf_hi(b4[r][j][q]) * (wt[0][e + 1] * bf_hi(x2[r][j][q]) + wt[1][e + 1] * bf_hi(x1[r][j][q]) + wt[2][e + 1] * bf_hi(x0[r][j][q]));
                        o[q] = pk2(lo, hi); }
                    pg8::wt16(VO + (size_t)m * D + 8 * (lane + 64 * j), o); } } }
    }
}

constexpr int GL_B = 0, GL_GZ = 33792, GL_TOT = 37888, GL_RED = 39936, GL_K = 41984, GL_QS = 59392, GL_QI = 76800, GL_V = 94208, GL_P = 128000;
constexpr int BSTR = 132, KSTR = 136, VSTR = 264, PSTR = 72, USTR = 136;
static_assert(GL_P + 64 * PSTR * 2 <= LDS_BYTES, "gla lds");
__device__ __forceinline__ int gla_row(int b, int n, int c) { return n ? b * SEQ + (n - 1) * 64 + c : (c >= 48 ? MMETA0 + (c - 48) : -1); }
__device__ __forceinline__ s16x4 tr_read(unsigned a) { s16x4 r; asm volatile("ds_read_b64_tr_b16 %0, %1\n\ts_waitcnt lgkmcnt(0)" : "=&v"(r) : "v"(a) : "memory"); return r; }
__device__ __forceinline__ bf16x8 tr_frag(unsigned a0, unsigned a1) { const s16x4 lo = tr_read(a0), hi = tr_read(a1); return __builtin_shufflevector(lo, hi, 0, 1, 2, 3, 4, 5, 6, 7); }
__device__ __forceinline__ unsigned lds_u32(const LAS void* p) { return (unsigned)(uintptr_t)p; }

constexpr int GLA_UNITS = (NCH - 1) * 16 + 4;
__device__ __forceinline__ void gla_unit(int idx, int& n, int& b, int& h) { if (idx < (NCH - 1) * 16) { n = 1 + (idx >> 4); b = (idx & 15) >> 2; h = idx & 3; } else { n = 0; b = 0; h = idx - (NCH - 1) * 16; } }
__device__ __forceinline__ void gla_cumdecay(LAS unsigned char* lds, const f32x4 gzv, const float (&w)[16], float bia, int n, int tid) {
    LAS float* sB = (LAS float*)(lds + GL_B); LAS float* sGZ = (LAS float*)(lds + GL_GZ); LAS float* sTot = (LAS float*)(lds + GL_TOT);
    if (tid < 256) *(LAS f32x4*)(sGZ + (tid >> 2) * 16 + (tid & 3) * 4) = gzv;
    const int kd = tid & 127, grp = tid >> 7;
    __syncthreads();
    float loc[16]; float run = 0.f;
#pragma unroll
    for (int i = 0; i < 16; ++i) {
        const int c = grp * 16 + i;
        float z = bia;
#pragma unroll
        for (int r4 = 0; r4 < 4; ++r4) { const f32x4 gv = *(const LAS f32x4*)(sGZ + c * 16 + r4 * 4); z += gv[0] * w[r4 * 4] + gv[1] * w[r4 * 4 + 1] + gv[2] * w[r4 * 4 + 2] + gv[3] * w[r4 * 4 + 3]; }
        float la = (fminf(z, 0.f) - __logf(1.0f + __expf(-fabsf(z)))) * (1.0f / 16.0f);
        if (n == 0 && c < 48) la = 0.f;
        run += la; loc[i] = run;
    }
    sTot[grp * 128 + kd] = run;
    __syncthreads();
    float off = 0.f;
#pragma unroll
    for (int g2 = 0; g2 < 3; ++g2) off += (g2 < grp) ? sTot[g2 * 128 + kd] : 0.f;
#pragma unroll
    for (int i = 0; i < 16; ++i) sB[(grp * 16 + i) * BSTR + kd] = loc[i] + off;
    __syncthreads();
}
__device__ __forceinline__ void unpack8(const u32x4 w, float (&f)[8]) {
#pragma unroll
    for (int q = 0; q < 4; ++q) { f[2 * q] = bf_lo(w[q]); f[2 * q + 1] = bf_hi(w[q]); }
}
__device__ __forceinline__ u32x4 pack8f(const float (&f)[8]) { u32x4 w; w.x = pk2(f[0], f[1]); w.y = pk2(f[2], f[3]); w.z = pk2(f[4], f[5]); w.w = pk2(f[6], f[7]); return w; }

__device__ __forceinline__ void gla_g1(const Params& p, LAS unsigned char* lds, int tid, int wave, int lane) {
    unsigned char* big = p.ws + WS_BIG;
    const bf16* Kb = (const bf16*)(big + BIG_K); const bf16* Vb = (const bf16*)(big + BIG_V); const float* GZ = (const float*)(big + BIG_GZ);
    bf16* Ub = (bf16*)(big + BIG_U); float* Dec = (float*)(big + BIG_DEC);
    LAS float* sB = (LAS float*)(lds + GL_B); LAS bf16* sK = (LAS bf16*)(lds + GL_K); LAS bf16* sV = (LAS bf16*)(lds + GL_V);
    const int fr = lane & 15, fq = lane >> 4;
    const u32x4 z4 = (u32x4){0u, 0u, 0u, 0u};
    for (int idx = blockIdx.x; idx < GLA_UNITS; idx += gridDim.x) {
        int n, b, h; gla_unit(idx, n, b, h); const int unit = n * 16 + b * 4 + h;
        f32x4 gzv = (f32x4){0.f, 0.f, 0.f, 0.f};
        if (tid < 256) { const int row = gla_row(b, n, tid >> 2); if (row >= 0) gzv = *(const f32x4*)(GZ + (size_t)row * 16 + (tid & 3) * 4); }
        float w[16];
#pragma unroll
        for (int r = 0; r < 16; ++r) w[r] = p.gla_w_up[r * 512 + h * 128 + (tid & 127)];
        const float bia = p.gla_b_gate[h * 128 + (tid & 127)];
        const int kd8 = (tid & 15) * 8, cb = tid >> 4;
        u32x4 kv[2], vv[4];
#pragma unroll
        for (int i = 0; i < 2; ++i) { const int row = gla_row(b, n, cb + 32 * i); kv[i] = (row >= 0) ? *(const u32x4*)(Kb + (size_t)row * 512 + h * 128 + kd8) : z4; }
#pragma unroll
        for (int i = 0; i < 4; ++i) { const int ii = tid + 512 * i, row = gla_row(b, n, ii >> 5); vv[i] = (row >= 0) ? *(const u32x4*)(Vb + (size_t)row * D + h * 256 + (ii & 31) * 8) : z4; }
        gla_cumdecay(lds, gzv, w, bia, n, tid);
        {
            float* Bu = (float*)(p.ws + WS_HB) + (size_t)unit * 8192;
#pragma unroll
            for (int i = 0; i < 4; ++i) { const int ii = tid + 512 * i, c = ii >> 5, k4 = (ii & 31) * 4; pg8::wt16(Bu + c * 128 + k4, *(const LAS f32x4*)(sB + c * BSTR + k4)); }
        }
        {
            float bl[8];
#pragma unroll
            for (int j = 0; j < 8; ++j) bl[j] = sB[63 * BSTR + kd8 + j];
#pragma unroll
            for (int i = 0; i < 2; ++i) { const int c = cb + 32 * i;
                float kf[8]; unpack8(kv[i], kf);
#pragma unroll
                for (int j = 0; j < 8; ++j) kf[j] *= __expf(bl[j] - sB[c * BSTR + kd8 + j]);
                *(LAS u32x4*)(sK + c * KSTR + kd8) = pack8f(kf); }
            if (tid < 128) pg8::wt4(Dec + (size_t)unit * 128 + tid, __expf(sB[63 * BSTR + tid]));
#pragma unroll
            for (int i = 0; i < 4; ++i) { const int ii = tid + 512 * i; *(LAS u32x4*)(sV + (ii >> 5) * VSTR + (ii & 31) * 8) = vv[i]; }
        }
        __syncthreads();
        f32x4 acc[8][2];
#pragma unroll
        for (int i = 0; i < 8; ++i)
#pragma unroll
            for (int j = 0; j < 2; ++j) acc[i][j] = (f32x4){0.f, 0.f, 0.f, 0.f};
#pragma unroll
        for (int ks = 0; ks < 2; ++ks) {
            const int r0 = 32 * ks + 8 * fq + (fr >> 2), cc = 4 * (fr & 3);
            bf16x8 Y[2];
#pragma unroll
            for (int j = 0; j < 2; ++j) { const int vd0 = 32 * wave + 16 * j; Y[j] = tr_frag(lds_u32(sV + r0 * VSTR + vd0 + cc), lds_u32(sV + (r0 + 4) * VSTR + vd0 + cc)); }
#pragma unroll
            for (int i = 0; i < 8; ++i) { const bf16x8 X = tr_frag(lds_u32(sK + r0 * KSTR + 16 * i + cc), lds_u32(sK + (r0 + 4) * KSTR + 16 * i + cc));
#pragma unroll
                for (int j = 0; j < 2; ++j) acc[i][j] = __builtin_amdgcn_mfma_f32_16x16x32_bf16(X, Y[j], acc[i][j], 0, 0, 0); }
        }
        bf16* Uu = Ub + (size_t)unit * 32768;
        __syncthreads();
        LAS bf16* sU = (LAS bf16*)lds;
#pragma unroll
        for (int i = 0; i < 8; ++i)
#pragma unroll
            for (int j = 0; j < 2; ++j) { const int vd = 32 * wave + 16 * j + fr, kd = 16 * i + 4 * fq;
                u32x2 wv; wv.x = pk2(acc[i][j][0], acc[i][j][1]); wv.y = pk2(acc[i][j][2], acc[i][j][3]);
                *(LAS u32x2*)(sU + vd * USTR + kd) = wv; }
        __syncthreads();
#pragma unroll
        for (int it = 0; it < 8; ++it) { const int idx = tid + 512 * it, vd = idx >> 4, part = idx & 15;
            pg8::wt16(Uu + (size_t)idx * 8, *(const LAS u32x4*)(sU + vd * USTR + part * 8)); }
        __syncthreads();
    }
}

__device__ __forceinline__ void gla_g2(const Params& p, int tid) {
    unsigned char* big = p.ws + WS_BIG;
    bf16* Ub = (bf16*)(big + BIG_U); const float* Dec = (const float*)(big + BIG_DEC);
    for (int g = blockIdx.x * 512 + tid; g < 16 * 8192; g += gridDim.x * 512) {
        const int bh = g >> 13, e4 = (g & 8191) * 4, kd = e4 & 127;
        float S0, S1, S2, S3;
        { const size_t unit = (size_t)(bh & 3); const u32x2 u0 = *(const u32x2*)(Ub + unit * 32768 + e4); S0 = bf_lo(u0.x); S1 = bf_hi(u0.x); S2 = bf_lo(u0.y); S3 = bf_hi(u0.y); }
        for (int n0 = 1; n0 < NCH; n0 += 8) {
            u32x2 uu[8]; f32x4 dd[8];
#pragma unroll
            for (int i = 0; i < 8; ++i) { const size_t unit = (size_t)(n0 + i) * 16 + bh;
                uu[i] = *(const u32x2*)(Ub + unit * 32768 + e4); dd[i] = *(const f32x4*)(Dec + unit * 128 + kd); }
#pragma unroll
            for (int i = 0; i < 8; ++i) { const size_t unit = (size_t)(n0 + i) * 16 + bh;
                u32x2 wv; wv.x = pk2(S0, S1); wv.y = pk2(S2, S3); pg8::wt8(Ub + unit * 32768 + e4, wv);
                S0 = dd[i][0] * S0 + bf_lo(uu[i].x); S1 = dd[i][1] * S1 + bf_hi(uu[i].x); S2 = dd[i][2] * S2 + bf_lo(uu[i].y); S3 = dd[i][3] * S3 + bf_hi(uu[i].y); }
        }
    }
}

__device__ __forceinline__ void gla_g3(const Params& p, LAS unsigned char* lds, int tid, int wave, int lane) {
    unsigned char* big = p.ws + WS_BIG;
    const bf16* Qb = (const bf16*)(big + BIG_Q); const bf16* Kb = (const bf16*)(big + BIG_K); const bf16* Vb = (const bf16*)(big + BIG_V); const bf16* Gb = (const bf16*)(big + BIG_G);
    const bf16* Sb = (const bf16*)(big + BIG_U); bf16* Ob = (bf16*)(big + BIG_V);
    LAS float* sB = (LAS float*)(lds + GL_B); LAS float* sRed = (LAS float*)(lds + GL_RED);
    LAS bf16* sK = (LAS bf16*)(lds + GL_K); LAS bf16* sQs = (LAS bf16*)(lds + GL_QS); LAS bf16* sQi = (LAS bf16*)(lds + GL_QI); LAS bf16* sV = (LAS bf16*)(lds + GL_V); LAS bf16* sP = (LAS bf16*)(lds + GL_P);
    const int fr = lane & 15, fq = lane >> 4;
    const u32x4 z4 = (u32x4){0u, 0u, 0u, 0u};
    for (int idx = blockIdx.x; idx < GLA_UNITS; idx += gridDim.x) {
        int n, b, h; gla_unit(idx, n, b, h); const int unit = n * 16 + b * 4 + h;
        const float* Bu = (const float*)(p.ws + WS_HB) + (size_t)unit * 8192;
        f32x4 bt[4];
#pragma unroll
        for (int i = 0; i < 4; ++i) { const int ii = tid + 512 * i; bt[i] = *(const f32x4*)(Bu + (ii >> 5) * 128 + (ii & 31) * 4); }
        const int kd8 = (tid & 15) * 8, cb = tid >> 4;
        u32x4 qv[2], kv[2], vv[4];
#pragma unroll
        for (int i = 0; i < 2; ++i) { const int row = gla_row(b, n, cb + 32 * i);
            qv[i] = (row >= 0) ? *(const u32x4*)(Qb + (size_t)row * 512 + h * 128 + kd8) : z4; kv[i] = (row >= 0) ? *(const u32x4*)(Kb + (size_t)row * 512 + h * 128 + kd8) : z4; }
#pragma unroll
        for (int i = 0; i < 4; ++i) { const int ii = tid + 512 * i, row = gla_row(b, n, ii >> 5); vv[i] = (row >= 0) ? *(const u32x4*)(Vb + (size_t)row * D + h * 256 + (ii & 31) * 8) : z4; }
        const bf16* Su = Sb + (size_t)unit * 32768;
        bf16x8 X2[4][2];
        if (n) {
#pragma unroll
            for (int ks = 0; ks < 4; ++ks)
#pragma unroll
                for (int xi = 0; xi < 2; ++xi) X2[ks][xi] = *(const bf16x8*)(Su + (32 * wave + 16 * xi + fr) * 128 + 32 * ks + 8 * fq);
        }
        u32x2 gg[4][2]; f32x4 nw[2];
#pragma unroll
        for (int xi = 0; xi < 2; ++xi) nw[xi] = *(const f32x4*)(p.gla_norm_w + 32 * wave + 16 * xi + 4 * fq);
#pragma unroll
        for (int mi = 0; mi < 4; ++mi) { const int row = gla_row(b, n, 16 * mi + fr);
#pragma unroll
            for (int xi = 0; xi < 2; ++xi) gg[mi][xi] = (row >= 0) ? *(const u32x2*)(Gb + (size_t)row * D + h * 256 + 32 * wave + 16 * xi + 4 * fq) : (u32x2){0u, 0u}; }
#pragma unroll
        for (int i = 0; i < 4; ++i) { const int ii = tid + 512 * i; *(LAS f32x4*)(sB + (ii >> 5) * BSTR + (ii & 31) * 4) = bt[i]; }
        __syncthreads();
        {
            float br[8];
#pragma unroll
            for (int j = 0; j < 8; ++j) br[j] = sB[32 * BSTR + kd8 + j];
#pragma unroll
            for (int i = 0; i < 2; ++i) { const int c = cb + 32 * i;
                float qf[8], kf[8], qs[8], qi[8]; unpack8(qv[i], qf); unpack8(kv[i], kf);
#pragma unroll
                for (int j = 0; j < 8; ++j) { const float bb = sB[c * BSTR + kd8 + j]; const float e = __expf(bb - br[j]);
                    qs[j] = qf[j] * e; kf[j] = kf[j] * __expf(br[j] - bb); qi[j] = qf[j] * __expf(bb); }
                *(LAS u32x4*)(sQs + c * KSTR + kd8) = pack8f(qs); *(LAS u32x4*)(sK + c * KSTR + kd8) = pack8f(kf); *(LAS u32x4*)(sQi + c * KSTR + kd8) = pack8f(qi); }
#pragma unroll
            for (int i = 0; i < 4; ++i) { const int ii = tid + 512 * i; *(LAS u32x4*)(sV + (ii >> 5) * VSTR + (ii & 31) * 8) = vv[i]; }
        }
        __syncthreads();
        {
            const int ti = wave >> 1;
#pragma unroll
            for (int jj = 0; jj < 2; ++jj) {
                const int tj = 2 * (wave & 1) + jj;
                f32x4 a = (f32x4){0.f, 0.f, 0.f, 0.f};
                if (tj <= ti) {
#pragma unroll
                    for (int ks = 0; ks < 4; ++ks) {
                        const bf16x8 X = *(const LAS bf16x8*)(sK + (tj * 16 + fr) * KSTR + 32 * ks + 8 * fq);
                        const bf16x8 Y = *(const LAS bf16x8*)(sQs + (ti * 16 + fr) * KSTR + 32 * ks + 8 * fq);
                        a = __builtin_amdgcn_mfma_f32_16x16x32_bf16(X, Y, a, 0, 0, 0);
                    }
                }
                const int ci = ti * 16 + fr, cj = tj * 16 + 4 * fq;
                float e0 = (cj + 0 <= ci) ? a[0] : 0.f, e1 = (cj + 1 <= ci) ? a[1] : 0.f, e2 = (cj + 2 <= ci) ? a[2] : 0.f, e3 = (cj + 3 <= ci) ? a[3] : 0.f;
                u32x2 wv; wv.x = pk2(e0, e1); wv.y = pk2(e2, e3);
                *(LAS u32x2*)(sP + ci * PSTR + cj) = wv;
            }
        }
        __syncthreads();
        f32x4 acc[4][2];
#pragma unroll
        for (int mi = 0; mi < 4; ++mi)
#pragma unroll
            for (int xi = 0; xi < 2; ++xi) acc[mi][xi] = (f32x4){0.f, 0.f, 0.f, 0.f};
#pragma unroll
        for (int ks = 0; ks < 2; ++ks) {
            const int r0 = 32 * ks + 8 * fq + (fr >> 2), cc = 4 * (fr & 3);
            bf16x8 X1[2];
#pragma unroll
            for (int xi = 0; xi < 2; ++xi) { const int vd0 = 32 * wave + 16 * xi; X1[xi] = tr_frag(lds_u32(sV + r0 * VSTR + vd0 + cc), lds_u32(sV + (r0 + 4) * VSTR + vd0 + cc)); }
#pragma unroll
            for (int mi = 0; mi < 4; ++mi) { const bf16x8 Y1 = *(const LAS bf16x8*)(sP + (16 * mi + fr) * PSTR + 32 * ks + 8 * fq);
#pragma unroll
                for (int xi = 0; xi < 2; ++xi) acc[mi][xi] = __builtin_amdgcn_mfma_f32_16x16x32_bf16(X1[xi], Y1, acc[mi][xi], 0, 0, 0); }
        }
        if (n) {
#pragma unroll
            for (int ks = 0; ks < 4; ++ks) {
#pragma unroll
                for (int mi = 0; mi < 4; ++mi) { const bf16x8 Y2 = *(const LAS bf16x8*)(sQi + (16 * mi + fr) * KSTR + 32 * ks + 8 * fq);
#pragma unroll
                    for (int xi = 0; xi < 2; ++xi) acc[mi][xi] = __builtin_amdgcn_mfma_f32_16x16x32_bf16(X2[ks][xi], Y2, acc[mi][xi], 0, 0, 0); }
            }
        }
#pragma unroll
        for (int mi = 0; mi < 4; ++mi) { float ss = 0.f;
#pragma unroll
            for (int xi = 0; xi < 2; ++xi) ss += (acc[mi][xi][0] * acc[mi][xi][0] + acc[mi][xi][1] * acc[mi][xi][1]) + (acc[mi][xi][2] * acc[mi][xi][2] + acc[mi][xi][3] * acc[mi][xi][3]);
            ss += __shfl_xor(ss, 16); ss += __shfl_xor(ss, 32);
            if (fq == 0) sRed[wave * 64 + 16 * mi + fr] = ss; }
        __syncthreads();
        LAS bf16* sO = (LAS bf16*)(lds + GL_V);
#pragma unroll
        for (int mi = 0; mi < 4; ++mi) {
            const int c = 16 * mi + fr;
            float tot = 0.f;
#pragma unroll
            for (int w2 = 0; w2 < 8; ++w2) tot += sRed[w2 * 64 + c];
            const float rinv = 1.0f / sqrtf(tot * (1.0f / 256.0f) + RMS_EPS);
#pragma unroll
            for (int xi = 0; xi < 2; ++xi) { const int vd = 32 * wave + 16 * xi + 4 * fq;
                const float o0 = acc[mi][xi][0] * rinv * nw[xi][0] * bf_lo(gg[mi][xi].x), o1 = acc[mi][xi][1] * rinv * nw[xi][1] * bf_hi(gg[mi][xi].x);
                const float o2 = acc[mi][xi][2] * rinv * nw[xi][2] * bf_lo(gg[mi][xi].y), o3 = acc[mi][xi][3] * rinv * nw[xi][3] * bf_hi(gg[mi][xi].y);
                u32x2 wv; wv.x = pk2(o0, o1); wv.y = pk2(o2, o3);
                *(LAS u32x2*)(sO + c * VSTR + vd) = wv; }
        }
        __syncthreads();
#pragma unroll
        for (int it = 0; it < 4; ++it) { const int idx = tid + 512 * it, c = idx >> 5, part = idx & 31; const int row = gla_row(b, n, c);
            if (row >= 0) pg8::wt16(Ob + (size_t)row * D + h * 256 + part * 8, *(const LAS u32x4*)(sO + c * VSTR + part * 8)); }
        __syncthreads();
    }
}

typedef __attribute__((address_space(1))) unsigned gu32;
#define XB_TMO      128
#define XB_XCNT(j)  (256  + 64 * (j))
#define XB_XSUB(j)  (1280 + 64 * (j))
#define XB_XGEN(j)  (2304 + 64 * (j))
#define XB_TOP      3328
#define XB_TOPGEN   3392
#define XCD_BAR_WORDS 3456
#define XB_SPIN_CAP (1u << 18)

__device__ __forceinline__ unsigned xb_ld(unsigned* p)              { return __hip_atomic_load(p, __ATOMIC_RELAXED, __HIP_MEMORY_SCOPE_AGENT); }
__device__ __forceinline__ unsigned xb_add(unsigned* p, unsigned v) { return __hip_atomic_fetch_add(p, v, __ATOMIC_RELAXED, __HIP_MEMORY_SCOPE_AGENT); }
__device__ __forceinline__ unsigned xb_xcc_id() { return (unsigned)__builtin_amdgcn_s_getreg((3 << 11) | 20) & 0xFu; }
#define XB_SPIN(cond, bar) do { unsigned _sp = 0; while (cond) { __builtin_amdgcn_s_sleep(1); \
    if ((++_sp & 255u) == 0u) { if (xb_ld(&(bar)[XB_TMO])) break; if (_sp > XB_SPIN_CAP) { atomicAdd(&(bar)[XB_TMO], 1u); break; } } } } while (0)

struct XcdBarrier {
    unsigned* bar; unsigned x;
    volatile LAS unsigned* st;
};

__device__ __forceinline__ XcdBarrier xcd_barrier_post(unsigned* bar, volatile LAS unsigned* st) {
    XcdBarrier b; b.bar = bar; b.x = xb_xcc_id(); b.st = st;
    if (threadIdx.x == 0) (void)xb_add(&bar[XB_XCNT(b.x)], 1u);
    return b;
}
__device__ __forceinline__ void xcd_barrier_complete(unsigned* bar, unsigned x, unsigned& nloc, unsigned& nx) {
    const unsigned G = gridDim.x * gridDim.y * gridDim.z;
    unsigned sum, cnt, mine, sp = 0u;
    for (;;) {
        sum = 0u; cnt = 0u; mine = 0u;
#pragma unroll
        for (unsigned j = 0; j < 16; ++j) { const unsigned c = xb_ld(&bar[XB_XCNT(j)]); sum += c; cnt += (c > 0u) ? 1u : 0u; mine = (j == x) ? c : mine; }
        if (sum == G) break;
        __builtin_amdgcn_s_sleep(1);
        if ((++sp & 255u) == 0u) { if (xb_ld(&bar[XB_TMO])) break; if (sp > XB_SPIN_CAP) { atomicAdd(&bar[XB_TMO], 1u); break; } }
    }
    nloc = mine > 0u ? mine : 1u; nx = cnt > 0u ? cnt : 1u;
}

__device__ __forceinline__ void xcd_barrier(const XcdBarrier& b) {
    asm volatile("s_waitcnt vmcnt(0)" ::: "memory");
    __syncthreads();
    if (threadIdx.x == 0) {
        unsigned* bar = b.bar;
        __builtin_amdgcn_s_waitcnt(0);
        unsigned nloc = b.st[0], nx = b.st[1];
        if (nloc == 0u) { xcd_barrier_complete(bar, b.x, nloc, nx); b.st[0] = nloc; b.st[1] = nx; }
        const unsigned old = xb_add(&bar[XB_XSUB(b.x)], 1u);
        const unsigned gen = old / nloc;
        if (old + 1u == (gen + 1u) * nloc) {
            asm volatile("s_waitcnt vmcnt(0)" ::: "memory");
            const unsigned og = xb_add(&bar[XB_TOP], 1u);
            const unsigned tg = og / nx;
            if (og + 1u == (tg + 1u) * nx) xb_add(&bar[XB_TOPGEN], 1u);
            else XB_SPIN(xb_ld(&bar[XB_TOPGEN]) == tg, bar);
            __builtin_amdgcn_fence(__ATOMIC_ACQUIRE, "agent");
            xb_add(&bar[XB_XGEN(b.x)], 1u);
            asm volatile("s_waitcnt vmcnt(0)" ::: "memory");
        } else {
            XB_SPIN(xb_ld(&bar[XB_XGEN(b.x)]) == gen, bar);
            __builtin_amdgcn_fence(__ATOMIC_ACQUIRE, "agent");
            asm volatile("s_waitcnt vmcnt(0)" ::: "memory");
        }
    }
    __syncthreads();
}

__device__ __forceinline__ void mini_gemm(LAS unsigned char* lds, const bf16* A, const bf16* B0, const bf16* B1, int K, int wave, int lane, f32x4& r0, f32x4& r1) {
    const int fr = lane & 15, fq = lane >> 4;
    f32x4 a0 = (f32x4){0.f, 0.f, 0.f, 0.f}, a1 = a0;
    const bf16* ap = A + (size_t)fr * K + 8 * fq; const bf16* b0p = B0 + (size_t)fr * K + 8 * fq; const bf16* b1p = B1 + (size_t)fr * K + 8 * fq;
    for (int ks = wave; ks < K / 32; ks += 8) {
        const bf16x8 af = *(const bf16x8*)(ap + 32 * ks), b0 = *(const bf16x8*)(b0p + 32 * ks), b1 = *(const bf16x8*)(b1p + 32 * ks);
        a0 = __builtin_amdgcn_mfma_f32_16x16x32_bf16(b0, af, a0, 0, 0, 0);
        a1 = __builtin_amdgcn_mfma_f32_16x16x32_bf16(b1, af, a1, 0, 0, 0);
    }
    LAS f32x4* red = (LAS f32x4*)lds;
    red[(wave * 2 + 0) * 64 + lane] = a0; red[(wave * 2 + 1) * 64 + lane] = a1;
    __syncthreads();
    if (wave == 0) {
        r0 = red[lane]; r1 = red[64 + lane];
#pragma unroll
        for (int w = 1; w < 8; ++w) { r0 += red[(w * 2) * 64 + lane]; r1 += red[(w * 2 + 1) * 64 + lane]; }
    }
    __syncthreads();
}
__device__ __forceinline__ u32x2 pack4(const f32x4 v) { u32x2 w; w.x = pk2(v[0], v[1]); w.y = pk2(v[2], v[3]); return w; }
__device__ __forceinline__ void mini_ffn_in(LAS unsigned char* lds, const bf16* HB, const bf16* Wt, bf16* ACT, int t, int wave, int lane) {
    const int pn = t >> 3, j0 = (t & 7) * 16; f32x4 g, u;
    mini_gemm(lds, HB + (size_t)MMETA0 * D, Wt + (size_t)(256 * pn + j0) * D, Wt + (size_t)(256 * pn + 128 + j0) * D, D, wave, lane, g, u);
    if (wave == 0) { f32x4 a;
#pragma unroll
        for (int j = 0; j < 4; ++j) a[j] = pg8::silu_f(g[j]) * u[j];
        pg8::wt8(ACT + (size_t)(MMETA0 + (lane & 15)) * FF + 16 * t + 4 * (lane >> 4), pack4(a)); }
}
__device__ __forceinline__ void mini_resid(LAS unsigned char* lds, const bf16* A, int K, const bf16* Wt, const float* src, float* dst, const float* stats, const float* gain, const float* bias, float scale, int t, int wave, int lane) {
    f32x4 r[2];
    mini_gemm(lds, A + (size_t)MMETA0 * K, Wt + (size_t)(32 * t) * K, Wt + (size_t)(32 * t + 16) * K, K, wave, lane, r[0], r[1]);
    if (wave == 0) { const int row = lane & 15; float mean = 0.f, rstd = 1.f;
        if (stats) { mean = stats[(size_t)(MMETA0 + row) * 2]; rstd = stats[(size_t)(MMETA0 + row) * 2 + 1]; }
#pragma unroll
        for (int q = 0; q < 2; ++q) { const int col = 32 * t + 16 * q + 4 * (lane >> 4);
            const f32x4 x = *(const f32x4*)(src + (size_t)row * D + col);
            f32x4 h = x;
            if (stats) h = (x - mean) * rstd * *(const f32x4*)(gain + col) + *(const f32x4*)(bias + col);
            pg8::wt16(dst + (size_t)row * D + col, h * ALPHA + r[q] * scale); } }
}
__device__ __forceinline__ void mini_conv_in(LAS unsigned char* lds, const bf16* HB, const bf16* Wt, bf16* CU, bf16* BG, int t, int wave, int lane) {
    f32x4 a, b;
    if (t < 64) { const int pn = t >> 3, j0 = (t & 7) * 16;
        mini_gemm(lds, HB + (size_t)MMETA0 * D, Wt + (size_t)(256 * pn + j0) * D, Wt + (size_t)(256 * pn + 128 + j0) * D, D, wave, lane, a, b);
        if (wave == 0) pg8::wt8(CU + (size_t)(MMETA0 + (lane & 15)) * D + 16 * t + 4 * (lane >> 4), pack4(a * b));
    } else { const int c0 = 16 * (t - 64);
        mini_gemm(lds, HB + (size_t)MMETA0 * D, Wt + (size_t)(2048 + c0) * D, Wt + (size_t)(2048 + c0) * D, D, wave, lane, a, b);
        if (wave == 0) pg8::wt8(BG + (size_t)(MMETA0 + (lane & 15)) * D + c0 + 4 * (lane >> 4), pack4(a)); }
}
__device__ __forceinline__ void mini_gla_in(LAS unsigned char* lds, const bf16* HB, const bf16* Wt, bf16* Q, bf16* Kk, bf16* V, bf16* G, float qscale, int t, int wave, int lane) {
    f32x4 r[2];
    mini_gemm(lds, HB + (size_t)MMETA0 * D, Wt + (size_t)(32 * t) * D, Wt + (size_t)(32 * t + 16) * D, D, wave, lane, r[0], r[1]);
    if (wave == 0) { const size_t row = MMETA0 + (lane & 15);
#pragma unroll
        for (int q = 0; q < 2; ++q) { const int c = 32 * t + 16 * q + 4 * (lane >> 4); f32x4 v = r[q];
            if (c < 512) pg8::wt8(Q + row * 512 + c, pack4(v * qscale));
            else if (c < 1024) pg8::wt8(Kk + row * 512 + (c - 512), pack4(v));
            else if (c < 2048) pg8::wt8(V + row * D + (c - 1024), pack4(v));
            else {
#pragma unroll
                for (int j = 0; j < 4; ++j) v[j] = pg8::silu_f(v[j]);
                pg8::wt8(G + row * D + (c - 2048), pack4(v)); } } }
}
__device__ __forceinline__ void gz_phase(const bf16* HB, const bf16* Wgz, float* GZ, int gw, int NGW, int lane) {
    const int fr = lane & 15, fq = lane >> 4;
    for (int rb = gw; rb < MREAL / 16 + 1; rb += NGW) {
        const size_t row0 = (size_t)rb * 16;
        const bf16* ap = HB + (row0 + fr) * D + 8 * fq; const bf16* bp = Wgz + (size_t)fr * D + 8 * fq;
        f32x4 a0 = (f32x4){0.f, 0.f, 0.f, 0.f}, a1 = a0;
#pragma unroll 4
        for (int ks = 0; ks < D / 32; ks += 2) {
            a0 = __builtin_amdgcn_mfma_f32_16x16x32_bf16(*(const bf16x8*)(bp + 32 * ks), *(const bf16x8*)(ap + 32 * ks), a0, 0, 0, 0);
            a1 = __builtin_amdgcn_mfma_f32_16x16x32_bf16(*(const bf16x8*)(bp + 32 * ks + 32), *(const bf16x8*)(ap + 32 * ks + 32), a1, 0, 0, 0);
        }
        pg8::wt16(GZ + (row0 + fr) * 16 + 4 * fq, a0 + a1);
    }
}


#ifndef REP_G1
#define REP_G1 1
#endif
#ifndef REP_G2
#define REP_G2 0
#endif
#ifndef REP_LN
#define REP_LN 1
#endif
#ifndef REP_GLA
#define REP_GLA 1
#endif
#ifndef REP_SYNC
#define REP_SYNC 0
#endif
#ifndef REP_MIX
#define REP_MIX 1
#endif
template <class Epi>
__device__ __forceinline__ void run_gemm(LAS unsigned char* lds, const bf16* A, const bf16* Bt, int N, int K, const Epi& E) {
    pg8::Gemm g{A, Bt, MREAL, N, K}; pg8::StaticOrder S; S.init(MREAL, N, (int)gridDim.x, (int)blockIdx.x);
    pg8::gemm_phase<Epi, pg8::StaticOrder, true, true>(lds, g, S, E);
}

__global__ void __launch_bounds__(512, 2) fwd_megakernel(Params p) {
    extern __shared__ __attribute__((aligned(16))) unsigned char lds_raw[];
    LAS unsigned char* lds = (LAS unsigned char*)lds_raw;
    cg::grid_group grid = cg::this_grid();
    if (threadIdx.x < 16) ((LAS unsigned*)(lds + LDS_BYTES - 64))[threadIdx.x] = 0u;
    __syncthreads();
    const XcdBarrier xbar = xcd_barrier_post((unsigned*)(p.ws + WS_BAR), (volatile LAS unsigned*)(lds + LDS_BYTES - 64));
#define GSYNC() xcd_barrier(xbar)
    const int tid0 = threadIdx.x;
#define FRESH_IDS() int tid = tid0; asm volatile("" : "+v"(tid)); const int lane = tid & 63, wave = __builtin_amdgcn_readfirstlane(tid >> 6); const int gw = vcu * 8 + wave
    const int G = gridDim.x, bx = blockIdx.x;
    const int vcu = (G % 8 == 0) ? (bx % 8) * (G / 8) + bx / 8 : bx;
    const int NGW = G * 8;
    unsigned char* ws = p.ws; unsigned char* big = ws + WS_BIG;
    bf16* HB = (bf16*)(ws + WS_HB); float* XM = (float*)(ws + WS_XM); float* METAR = (float*)(ws + WS_METAR); float* STATS = (float*)(ws + WS_STATS);
    bf16* ACT = (bf16*)(big + BIG_ACT);

#ifndef NO_P0
    { FRESH_IDS(); p0_prologue(p, lds, gw, NGW, wave, lane); }
#endif
    grid.sync();

    int lnk = 0;
#pragma clang loop unroll(disable)
    for (int blk = 0; blk < 4; ++blk) {
        {
            { FRESH_IDS(); if (bx < 176) mini_ffn_in(lds, HB, (const bf16*)(ws + WS_WFI + (size_t)blk * SZ_WFI), ACT, bx, wave, lane); }
            pg8::EpiSwiGLU E1{ACT, FF};
            for (int rep = 0; rep < REP_G1; ++rep) run_gemm(lds, HB, (const bf16*)(ws + WS_WFI + (size_t)blk * SZ_WFI), 2 * FF, D, E1);
            GSYNC();
            pg8::EpiResid E2;
            if (lnk == 0) E2 = pg8::EpiResid{p.x, METAR, p.out, XM, nullptr, nullptr, nullptr, ALPHA, 0.5f};
            else E2 = pg8::EpiResid{p.out, XM, p.out, XM, STATS, p.ln_gain + (lnk - 1) * D, p.ln_bias + (lnk - 1) * D, ALPHA, 0.5f};
            { FRESH_IDS(); if (bx >= 64 && bx < 96) mini_resid(lds, ACT, FF, (const bf16*)(ws + WS_WFO + (size_t)blk * SZ_WFO), lnk == 0 ? METAR : XM, XM, E2.stats, E2.gain, E2.bias, 0.5f, bx - 64, wave, lane); }
            for (int rep = 0; rep < REP_G2; ++rep) { pg8::EpiResid E3 = E2; E3.Oreal = (float*)(big + BIG_U); run_gemm(lds, ACT, (const bf16*)(ws + WS_WFO + (size_t)blk * SZ_WFO), D, FF, E3); }
            run_gemm(lds, ACT, (const bf16*)(ws + WS_WFO + (size_t)blk * SZ_WFO), D, FF, E2);
            GSYNC();
            if (blk == 3) { FRESH_IDS(); ln_phase<true>(p.out, XM, p.ln_gain + 5 * D, p.ln_bias + 5 * D, nullptr, nullptr, p.out, gw, NGW, lane); break; }
            for (int rep = 0; rep < REP_LN; ++rep) { FRESH_IDS(); ln_phase<false>(p.out, XM, p.ln_gain + lnk * D, p.ln_bias + lnk * D, HB, STATS, nullptr, gw, NGW, lane); } ++lnk;
            for (int rep = 0; rep < REP_SYNC; ++rep) GSYNC();
            GSYNC();
        }
        if (blk == 0 || blk == 2) {
            const bf16* Wo; const bf16* Ao = HB;
            if (blk == 0) {
                { FRESH_IDS(); if (bx < 128) mini_conv_in(lds, HB, (const bf16*)(ws + WS_WCI), (bf16*)(big + BIG_CU), (bf16*)(big + BIG_BG), bx, wave, lane); }
                pg8::EpiConvIn Ec{(bf16*)(big + BIG_CU), (bf16*)(big + BIG_BG)};
                run_gemm(lds, HB, (const bf16*)(ws + WS_WCI), 3072, D, Ec);
                GSYNC();
#ifndef NO_CM
                for (int rep = 0; rep < REP_MIX; ++rep) { FRESH_IDS(); conv_mix_phase((const bf16*)(big + BIG_BG), (const bf16*)(big + BIG_CU), p.conv_w, HB, gw, NGW, lane); }
#endif
                GSYNC();
                Wo = (const bf16*)(ws + WS_WCO);
            } else {
                { FRESH_IDS(); gz_phase(HB, (const bf16*)(ws + WS_WGI) + (size_t)3072 * D, (float*)(big + BIG_GZ), gw, NGW, lane);
                  if (bx >= 128 && bx < 224) mini_gla_in(lds, HB, (const bf16*)(ws + WS_WGI), (bf16*)(big + BIG_Q), (bf16*)(big + BIG_K), (bf16*)(big + BIG_V), (bf16*)(big + BIG_G), 0.08838834764831845f, bx - 128, wave, lane); }
                pg8::EpiGlaIn Eg{(bf16*)(big + BIG_Q), (bf16*)(big + BIG_K), (bf16*)(big + BIG_V), (bf16*)(big + BIG_G), (float*)(big + BIG_GZ), 0.08838834764831845f};
                run_gemm(lds, HB, (const bf16*)(ws + WS_WGI), 3072, D, Eg);
                GSYNC();
#ifndef NO_G1
                for (int rep = 0; rep < REP_GLA; ++rep) { FRESH_IDS(); gla_g1(p, lds, tid, wave, lane); }
#endif
                GSYNC();
#ifndef NO_G2
                { FRESH_IDS(); gla_g2(p, tid); }
#endif
                GSYNC();
#ifndef NO_G3
                for (int rep = 0; rep < REP_GLA; ++rep) { FRESH_IDS(); gla_g3(p, lds, tid, wave, lane); }
#endif
                GSYNC();
                Wo = (const bf16*)(ws + WS_WGO); Ao = (const bf16*)(big + BIG_V);
            }
            pg8::EpiResid Eo{p.out, XM, p.out, XM, STATS, p.ln_gain + (lnk - 1) * D, p.ln_bias + (lnk - 1) * D, ALPHA, 1.0f};
            { FRESH_IDS(); if (bx >= 32 && bx < 64) mini_resid(lds, Ao, D, Wo, XM, XM, STATS, Eo.gain, Eo.bias, 1.0f, bx - 32, wave, lane); }
            run_gemm(lds, Ao, Wo, D, D, Eo);
            GSYNC();
            for (int rep = 0; rep < REP_LN; ++rep) { FRESH_IDS(); ln_phase<false>(p.out, XM, p.ln_gain + lnk * D, p.ln_bias + lnk * D, HB, STATS, nullptr, gw, NGW, lane); } ++lnk;
            for (int rep = 0; rep < REP_SYNC; ++rep) GSYNC();
            GSYNC();
        }
    }
}

extern "C" void kernel_launch(void* const* d_in, const int* in_sizes, int n_in, void* d_out, int out_size, void* d_ws, size_t ws_size, hipStream_t stream) {
    static int grid_blocks = 0;
    if (grid_blocks == 0) {
        if (n_in != 14 || out_size != MREAL * D || ws_size < WS_END) { fprintf(stderr, "kernel_launch: unexpected shapes: n_in %d out %d ws %zu (need %zu)\n", n_in, out_size, ws_size, (size_t)WS_END); grid_blocks = -1; return; }
        int dev = 0, cus = 0, per_cu = 0;
        hipGetDevice(&dev); hipDeviceGetAttribute(&cus, hipDeviceAttributeMultiprocessorCount, dev);
        if (hipFuncSetAttribute((const void*)fwd_megakernel, hipFuncAttributeMaxDynamicSharedMemorySize, LDS_BYTES) != hipSuccess) { fprintf(stderr, "kernel_launch: hipFuncSetAttribute failed\n"); grid_blocks = -1; return; }
        if (hipOccupancyMaxActiveBlocksPerMultiprocessor(&per_cu, (const void*)fwd_megakernel, 512, LDS_BYTES) != hipSuccess || per_cu < 1) { fprintf(stderr, "kernel_launch: occupancy query says %d\n", per_cu); per_cu = 1; }
        (void)hipGetLastError();
        grid_blocks = cus * 1;
    }
    if (grid_blocks < 0) return;
    Params p{};
    p.x = (const float*)d_in[0]; p.meta = (const float*)d_in[1]; p.ln_gain = (const float*)d_in[2]; p.ln_bias = (const float*)d_in[3];
    p.ffn_w_in = (const float*)d_in[4]; p.ffn_w_out = (const float*)d_in[5]; p.conv_w_in = (const float*)d_in[6]; p.conv_w = (const float*)d_in[7];
    p.conv_w_out = (const float*)d_in[8]; p.gla_w_in = (const float*)d_in[9]; p.gla_w_up = (const float*)d_in[10]; p.gla_b_gate = (const float*)d_in[11];
    p.gla_norm_w = (const float*)d_in[12]; p.gla_w_out = (const float*)d_in[13]; p.out = (float*)d_out; p.ws = (unsigned char*)d_ws;
    if (hipMemsetAsync((char*)d_ws + WS_BAR, 0, WS_BAR_BYTES, stream) != hipSuccess) { fprintf(stderr, "kernel_launch: memset of barrier words failed\n"); return; }
    void* args[] = {&p};
    hipError_t e = hipLaunchCooperativeKernel((const void*)fwd_megakernel, dim3(grid_blocks), dim3(512), args, LDS_BYTES, stream);
    if (e != hipSuccess) fprintf(stderr, "cooperative launch failed: %s (grid %d)\n", hipGetErrorString(e), grid_blocks);
}
```

```cpp
#include <hip/hip_runtime.h>
#include <hip/hip_cooperative_groups.h>
#include <cstdio>
#include <cstdint>
namespace cg = cooperative_groups;

namespace pg8 {
#define PG8_LAS __attribute__((address_space(3)))
typedef unsigned short bf16_t;
typedef short bf16x8 __attribute__((ext_vector_type(8)));
typedef float f32x4 __attribute__((ext_vector_type(4)));
typedef unsigned u32x4 __attribute__((ext_vector_type(4)));
typedef unsigned u32x2 __attribute__((ext_vector_type(2)));
constexpr int BM = 256, BK = 64, HALF = 128, HTB = HALF * BK * 2  , STAGE_BYTES = 8 * HTB, NXCD = 8, WGM = 8;

__host__ __device__ __forceinline__ int lds_byte(int r, int c) { const int st = (r >> 4) * 2 + (c >> 5), rr = r & 15, cc = c & 31, ob = rr * 64 + cc * 2; return st * 1024 + (ob ^ (((ob >> 9) & 1) << 5)); }
__host__ __device__ __forceinline__ void stage_rc(int b, int& R, int& C) { const int st = b / 1024, sb = b % 1024, swz = sb ^ (((sb >> 9) & 1) << 5); R = (st >> 1) * 16 + swz / 64; C = (st & 1) * 32 + (swz % 64) / 2; }
__host__ __device__ __forceinline__ int perm32(int rho) { const int n = rho >> 4, i = rho & 15; return 8 * (i >> 2) + 4 * n + (i & 3); }

struct Unit { int pm, pn; };
struct Gemm { const bf16_t* A; const bf16_t* Bt; int M, N, K; };

struct StaticOrder {
    int nM, nN, nwg, G, c;
    __host__ __device__ void init(int M, int N, int G_, int c_) { nM = M / BM; nN = N / BM; nwg = nM * nN; G = G_; c = c_; }
    __host__ __device__ bool next(int i, Unit& u) const {
        const long L = (long)i * G + c; if (L >= nwg) return false;
        int wgid = (int)L; { const int q = nwg / NXCD, r = nwg % NXCD, xcd = wgid % NXCD, off = wgid / NXCD; wgid = (xcd < r ? xcd * (q + 1) : r * (q + 1) + (xcd - r) * q) + off; }
        const int nig = WGM * nN, gid = wgid / nig, fm = gid * WGM, gsz = (nM - fm) < WGM ? (nM - fm) : WGM;
        u.pm = fm + ((wgid % nig) % gsz); u.pn = (wgid % nig) / gsz; return true;
    }
    __device__ __forceinline__ void a_ready(const Unit&) const {}
    __device__ __forceinline__ void done(const Unit&) const {}
};

__device__ __forceinline__ unsigned cvt_pk_bf16(float lo, float hi) { unsigned r; asm volatile("v_cvt_pk_bf16_f32 %0, %1, %2" : "=v"(r) : "v"(lo), "v"(hi)); return r; }
__device__ __forceinline__ float silu_f(float x) { return x * __builtin_amdgcn_rcpf(1.0f + __builtin_amdgcn_exp2f(-1.44269504089f * x)); }
__device__ __forceinline__ u32x4 pack8(const f32x4 a, const f32x4 b) { u32x4 w; w.x = cvt_pk_bf16(a[0], a[1]); w.y = cvt_pk_bf16(a[2], a[3]); w.z = cvt_pk_bf16(b[0], b[1]); w.w = cvt_pk_bf16(b[2], b[3]); return w; }
__device__ __forceinline__ void wt16(void* p, u32x4 v) { asm volatile("global_store_dwordx4 %0, %1, off sc1\n\ts_nop 1" :: "v"(p), "v"(v)); }
__device__ __forceinline__ void wt16(void* p, f32x4 v) { asm volatile("global_store_dwordx4 %0, %1, off sc1\n\ts_nop 1" :: "v"(p), "v"(v)); }
__device__ __forceinline__ void wt8(void* p, unsigned long long v) { __hip_atomic_store((unsigned long long*)p, v, __ATOMIC_RELAXED, __HIP_MEMORY_SCOPE_AGENT); }
__device__ __forceinline__ void wt8(void* p, u32x2 v) { wt8(p, (unsigned long long)v.x | ((unsigned long long)v.y << 32)); }
__device__ __forceinline__ void wt4(float* p, float v) { __hip_atomic_store(p, v, __ATOMIC_RELAXED, __HIP_MEMORY_SCOPE_AGENT); }

constexpr int MROWS_REAL = 32768;

struct EpiSwiGLU {
    static constexpr bool PERM = true, AFTER_DRAIN = false;
    bf16_t* O; int ldc;
    __device__ __forceinline__ void operator()(const f32x4 (&acc)[2][2][4][2], const Unit& u, int wr, int wc, int fr, int fq) const {
        const int row0 = u.pm * BM + wr * 64 + fr, col0 = u.pn * HALF + wc * 32 + 8 * fq;
#pragma unroll
        for (int ai = 0; ai < 2; ++ai)
#pragma unroll
            for (int m = 0; m < 4; ++m) {
                bf16_t* rowp = O + (size_t)(row0 + ai * HALF + m * 16) * ldc + col0;
                f32x4 a0, a1;
#pragma unroll
                for (int j = 0; j < 4; ++j) { a0[j] = silu_f(acc[ai][0][m][0][j]) * acc[ai][1][m][0][j]; a1[j] = silu_f(acc[ai][0][m][1][j]) * acc[ai][1][m][1][j]; }
                wt16(rowp, pack8(a0, a1));
            }
    }
};

struct EpiResid {
    static constexpr bool PERM = false, AFTER_DRAIN = false;
    const float* Rreal; const float* Rmeta; float* Oreal; float* Ometa; const float* stats; const float* gain; const float* bias; float alpha, scale;
    __device__ __forceinline__ void operator()(const f32x4 (&acc)[2][2][4][2], const Unit& u, int wr, int wc, int fr, int fq) const {
        const float* src = Rreal + (size_t)u.pm * BM * 1024;
        float* dst = Oreal + (size_t)u.pm * BM * 1024;
        const int r0 = wr * 64 + fr, col0 = u.pn * BM + wc * 32 + 4 * fq;
        float mean[2][4], rstd[2][4];
#pragma unroll
        for (int ai = 0; ai < 2; ++ai)
#pragma unroll
            for (int m = 0; m < 4; ++m) {
                mean[ai][m] = 0.f; rstd[ai][m] = 1.f;
                if (stats) { const float2 s = *(const float2*)(stats + (size_t)(u.pm * BM + r0 + ai * HALF + m * 16) * 2); mean[ai][m] = s.x; rstd[ai][m] = s.y; }
            }
#pragma unroll
        for (int bj = 0; bj < 2; ++bj)
#pragma unroll
            for (int n = 0; n < 2; ++n) {
                const int c = col0 + bj * HALF + n * 16;
                f32x4 gv = (f32x4){1.f, 1.f, 1.f, 1.f}, bv = (f32x4){0.f, 0.f, 0.f, 0.f};
                if (stats) { gv = *(const f32x4*)(gain + c); bv = *(const f32x4*)(bias + c); }
#pragma unroll
                for (int ai = 0; ai < 2; ++ai)
#pragma unroll
                    for (int m = 0; m < 4; ++m) {
                        const size_t off = (size_t)(r0 + ai * HALF + m * 16) * 1024 + c;
                        const f32x4 x = *(const f32x4*)(src + off);
                        const f32x4 h = (x - mean[ai][m]) * rstd[ai][m] * gv + bv;
                        wt16(dst + off, h * alpha + acc[ai][bj][m][n] * scale);
                    }
                asm volatile("" ::: "memory");
            }
    }
};

struct EpiConvIn {
    static constexpr bool PERM = true, AFTER_DRAIN = false;
    bf16_t* CU; bf16_t* BG;
    __device__ __forceinline__ void operator()(const f32x4 (&acc)[2][2][4][2], const Unit& u, int wr, int wc, int fr, int fq) const {
        const int row0 = u.pm * BM + wr * 64 + fr;
        if (u.pn < 8) {
            const int col0 = u.pn * HALF + wc * 32 + 8 * fq;
#pragma unroll
            for (int ai = 0; ai < 2; ++ai)
#pragma unroll
                for (int m = 0; m < 4; ++m) {
                    bf16_t* rowp = CU + (size_t)(row0 + ai * HALF + m * 16) * 1024 + col0;
                    wt16(rowp, pack8(acc[ai][0][m][0] * acc[ai][1][m][0], acc[ai][0][m][1] * acc[ai][1][m][1]));
                }
        } else {
            const int col0 = (u.pn - 8) * BM + wc * 32 + 8 * fq;
#pragma unroll
            for (int ai = 0; ai < 2; ++ai)
#pragma unroll
                for (int m = 0; m < 4; ++m) {
                    bf16_t* rowp = BG + (size_t)(row0 + ai * HALF + m * 16) * 1024 + col0;
#pragma unroll
                    for (int bj = 0; bj < 2; ++bj) wt16(rowp + bj * HALF, pack8(acc[ai][bj][m][0], acc[ai][bj][m][1]));
                }
        }
    }
};

struct EpiGlaIn {
    static constexpr bool PERM = true, AFTER_DRAIN = false;
    bf16_t* Q; bf16_t* Kk; bf16_t* V; bf16_t* G; float* GZ; float qscale;
    __device__ __forceinline__ void operator()(const f32x4 (&acc)[2][2][4][2], const Unit& u, int wr, int wc, int fr, int fq) const {
        const int row0 = u.pm * BM + wr * 64 + fr;
        bf16_t* base; int ld, colt; float sc = 1.f; bool act = false;
        if (u.pn < 2) { base = Q; ld = 512; colt = u.pn * BM; sc = qscale; }
        else if (u.pn < 4) { base = Kk; ld = 512; colt = (u.pn - 2) * BM; }
        else if (u.pn < 8) { base = V; ld = 1024; colt = (u.pn - 4) * BM; }
        else { base = G; ld = 1024; colt = (u.pn - 8) * BM; act = true; }
        const int col0 = colt + wc * 32 + 8 * fq;
#pragma unroll
        for (int ai = 0; ai < 2; ++ai)
#pragma unroll
            for (int m = 0; m < 4; ++m) {
                bf16_t* rowp = base + (size_t)(row0 + ai * HALF + m * 16) * ld + col0;
#pragma unroll
                for (int bj = 0; bj < 2; ++bj) {
                    f32x4 v0 = acc[ai][bj][m][0] * sc, v1 = acc[ai][bj][m][1] * sc;
                    if (act) {
#pragma unroll
                        for (int j = 0; j < 4; ++j) { v0[j] = silu_f(v0[j]); v1[j] = silu_f(v1[j]); }
                    }
                    wt16(rowp + bj * HALF, pack8(v0, v1));
                }
            }
    }
};

template <class Epi, class Sched, bool ALIGN_EPI = false, bool SP2 = false>
__device__ __forceinline__ void gemm_phase(PG8_LAS unsigned char* lds, const Gemm g, const Sched& S, const Epi& E) {
    int tid_ = threadIdx.x; asm volatile("" : "+v"(tid_));
    const int tid = tid_, wid = __builtin_amdgcn_readfirstlane(tid >> 6), lane = tid & 63, wr = wid >> 2, wc = wid & 3, fr = lane & 15, fq = lane >> 4;
    const int K = g.K, nt = K / BK;
    unsigned voffA[2], voffB[2];
#pragma unroll
    for (int i = 0; i < 2; ++i) { int R, C; stage_rc(tid * 16 + i * 8192, R, C); const int Rb = Epi::PERM ? ((R & ~31) + perm32(R & 31)) : R;
        voffA[i] = (unsigned)(R * K + C) * 2u; voffB[i] = (unsigned)(Rb * K + C) * 2u; }
    const size_t kstep = (size_t)(BK * 2);
    const size_t hstep = (size_t)HALF * K * 2;
    const size_t tstep = 2 * hstep;
    const unsigned ldsw = (unsigned)wid * 1024u;
    const int aoff = lds_byte(wr * 64 + fr, fq * 8), boff = lds_byte(wc * 32 + fr, fq * 8);
#define PG8_SA(b, h) (((b) * 2 + (h)) * HTB)
#define PG8_SB(b, h) ((4 + (b) * 2 + (h)) * HTB)
#define PG8_STAGE(bufoff, gbase, voff) do { _Pragma("unroll") for (int _i = 0; _i < 2; ++_i) \
        __builtin_amdgcn_global_load_lds((const unsigned*)((const char*)(gbase) + (voff)[_i]), (PG8_LAS unsigned*)(lds + (bufoff) + ldsw + _i * 8192), 16, 0, 0); } while (0)
#define PG8_LDA(dst, b, h) do { _Pragma("unroll") for (int m = 0; m < 4; ++m) _Pragma("unroll") for (int k = 0; k < 2; ++k) dst[m][k] = *(const PG8_LAS bf16x8*)(lds + PG8_SA(b, h) + aoff + m * 2048 + k * 1024); } while (0)
#define PG8_LDB(dst, b, h) do { _Pragma("unroll") for (int n = 0; n < 2; ++n) _Pragma("unroll") for (int k = 0; k < 2; ++k) dst[n][k] = *(const PG8_LAS bf16x8*)(lds + PG8_SB(b, h) + boff + n * 2048 + k * 1024); } while (0)
#define PG8_MMA(ai, bj, At, Bt) do { __builtin_amdgcn_s_setprio(1); _Pragma("unroll") for (int m = 0; m < 4; ++m) _Pragma("unroll") for (int n = 0; n < 2; ++n) _Pragma("unroll") for (int k = 0; k < 2; ++k) \
        acc[ai][bj][m][n] = __builtin_amdgcn_mfma_f32_16x16x32_bf16(Bt[n][k], At[m][k], acc[ai][bj][m][n], 0, 0, 0); __builtin_amdgcn_s_setprio(0); } while (0)
#define PG8_WAIT_V(n) asm volatile("s_waitcnt vmcnt(" #n ")" ::: "memory")
#define PG8_WAIT_L(n) asm volatile("s_waitcnt lgkmcnt(" #n ")" ::: "memory")
#define PG8_BAR __builtin_amdgcn_s_barrier()
#define PG8_SCHED __builtin_amdgcn_sched_barrier(0)
    Unit cur, nxt; int ui = 0;
    if (!S.next(0, cur)) return;
    f32x4 acc[2][2][4][2];
#pragma unroll
    for (int a = 0; a < 2; ++a)
#pragma unroll
        for (int b = 0; b < 2; ++b)
#pragma unroll
            for (int m = 0; m < 4; ++m)
#pragma unroll
                for (int n = 0; n < 2; ++n) acc[a][b][m][n] = (f32x4){0.f, 0.f, 0.f, 0.f};
    bf16x8 At[4][2], B0[2][2], B1[2][2];
    const char* cA = (const char*)g.A + (size_t)cur.pm * tstep; const char* cB = (const char*)g.Bt + (size_t)cur.pn * tstep;
    S.a_ready(cur);
    if constexpr (SP2) {
        PG8_STAGE(PG8_SB(0, 0), cB, voffB); PG8_STAGE(PG8_SB(0, 1), cB + hstep, voffB); PG8_STAGE(PG8_SA(0, 0), cA, voffA); PG8_STAGE(PG8_SA(0, 1), cA + hstep, voffA);
        if (wr == 1) PG8_BAR;
        PG8_WAIT_V(2); PG8_BAR;
        PG8_STAGE(PG8_SB(1, 0), cB + kstep, voffB); PG8_STAGE(PG8_SA(1, 0), cA + kstep, voffA); PG8_STAGE(PG8_SB(1, 1), cB + hstep + kstep, voffB);
        PG8_WAIT_V(6); PG8_BAR;
    } else {
        PG8_STAGE(PG8_SB(0, 0), cB, voffB); PG8_STAGE(PG8_SA(0, 0), cA, voffA); PG8_STAGE(PG8_SB(0, 1), cB + hstep, voffB); PG8_STAGE(PG8_SA(0, 1), cA + hstep, voffA);
        if (wr == 1) PG8_BAR;
        PG8_WAIT_V(4); PG8_BAR;
        PG8_STAGE(PG8_SB(1, 0), cB + kstep, voffB); PG8_STAGE(PG8_SA(1, 0), cA + kstep, voffA); PG8_STAGE(PG8_SB(1, 1), cB + hstep + kstep, voffB);
        PG8_WAIT_V(6); PG8_BAR;
    }
    for (;;) {
        const bool has_next = S.next(ui + 1, nxt);
        const char* nA = has_next ? (const char*)g.A + (size_t)nxt.pm * tstep : cA; const char* nB = has_next ? (const char*)g.Bt + (size_t)nxt.pn * tstep : cB;
        for (int t = 0; t < nt; t += 2) {
            const bool last = (t == nt - 2);
            const char* a1 = cA + (size_t)(t + 1) * kstep;
            const char* a2 = last ? nA : cA + (size_t)(t + 2) * kstep; const char* b2 = last ? nB : cB + (size_t)(t + 2) * kstep;
            const char* a3 = a2 + kstep; const char* b3 = b2 + kstep;
            if (last && has_next) S.a_ready(nxt);
            if constexpr (SP2) {
            PG8_LDB(B0, 0, 0); PG8_LDB(B1, 0, 1); PG8_SCHED; PG8_LDA(At, 0, 0); PG8_STAGE(PG8_SA(1, 1), a1 + hstep, voffA);
            PG8_WAIT_V(8); PG8_WAIT_L(0); PG8_BAR; PG8_MMA(0, 0, At, B0); PG8_MMA(0, 1, At, B1); PG8_BAR; PG8_SCHED;
            PG8_LDA(At, 0, 1); PG8_STAGE(PG8_SB(0, 0), b2, voffB); PG8_STAGE(PG8_SB(0, 1), b2 + hstep, voffB); PG8_STAGE(PG8_SA(0, 0), a2, voffA);
            PG8_WAIT_V(8); PG8_WAIT_L(0); PG8_BAR; PG8_MMA(1, 0, At, B0); PG8_MMA(1, 1, At, B1); PG8_BAR; PG8_SCHED;
            PG8_LDB(B0, 1, 0); PG8_LDB(B1, 1, 1); PG8_SCHED; PG8_LDA(At, 1, 0); PG8_STAGE(PG8_SA(0, 1), a2 + hstep, voffA);
            PG8_WAIT_V(8); PG8_WAIT_L(0); PG8_BAR; PG8_MMA(0, 0, At, B0); PG8_MMA(0, 1, At, B1); PG8_BAR; PG8_SCHED;
            PG8_LDA(At, 1, 1); PG8_STAGE(PG8_SB(1, 0), b3, voffB); PG8_STAGE(PG8_SB(1, 1), b3 + hstep, voffB); PG8_STAGE(PG8_SA(1, 0), a3, voffA);
            PG8_WAIT_V(8); PG8_WAIT_L(0); PG8_BAR; PG8_MMA(1, 0, At, B0); PG8_MMA(1, 1, At, B1); PG8_BAR; PG8_SCHED;
            } else {
            PG8_LDB(B0, 0, 0); PG8_SCHED; PG8_LDA(At, 0, 0); PG8_STAGE(PG8_SA(1, 1), a1 + hstep, voffA);
            PG8_WAIT_L(8); PG8_BAR; PG8_WAIT_L(0); PG8_MMA(0, 0, At, B0); PG8_BAR; PG8_SCHED;
            PG8_LDB(B1, 0, 1); PG8_STAGE(PG8_SB(0, 0), b2, voffB);
            PG8_BAR; PG8_WAIT_L(0); PG8_MMA(0, 1, At, B1); PG8_BAR;
            PG8_LDA(At, 0, 1); PG8_STAGE(PG8_SA(0, 0), a2, voffA);
            PG8_BAR; PG8_WAIT_L(0); PG8_MMA(1, 0, At, B0); PG8_BAR; PG8_SCHED;
            PG8_STAGE(PG8_SB(0, 1), b2 + hstep, voffB);
            PG8_WAIT_V(6); PG8_BAR; PG8_MMA(1, 1, At, B1); PG8_BAR;
            PG8_LDB(B0, 1, 0); PG8_SCHED; PG8_LDA(At, 1, 0); PG8_STAGE(PG8_SA(0, 1), a2 + hstep, voffA);
            PG8_WAIT_L(8); PG8_BAR; PG8_WAIT_L(0); PG8_MMA(0, 0, At, B0); PG8_BAR; PG8_SCHED;
            PG8_LDB(B1, 1, 1); PG8_STAGE(PG8_SB(1, 0), b3, voffB);
            PG8_BAR; PG8_WAIT_L(0); PG8_MMA(0, 1, At, B1); PG8_BAR;
            PG8_LDA(At, 1, 1); PG8_STAGE(PG8_SA(1, 0), a3, voffA);
            PG8_BAR; PG8_WAIT_L(0); PG8_MMA(1, 0, At, B0); PG8_BAR; PG8_SCHED;
            PG8_STAGE(PG8_SB(1, 1), b3 + hstep, voffB);
            PG8_WAIT_V(6); PG8_BAR; PG8_MMA(1, 1, At, B1); PG8_BAR;
            }
        }
        if constexpr (ALIGN_EPI) { if (wr == 0) PG8_BAR; }
        if constexpr (!Epi::AFTER_DRAIN) { E(acc, cur, wr, wc, fr, fq); S.done(cur); }
        if (!has_next) break;
#pragma unroll
        for (int a = 0; a < 2; ++a)
#pragma unroll
            for (int b = 0; b < 2; ++b)
#pragma unroll
                for (int m = 0; m < 4; ++m)
#pragma unroll
                    for (int n = 0; n < 2; ++n) acc[a][b][m][n] = (f32x4){0.f, 0.f, 0.f, 0.f};
        cur = nxt; cA = nA; cB = nB; ++ui;
        if constexpr (ALIGN_EPI) { if (wr == 1) PG8_BAR; }
    }
    PG8_WAIT_V(0);
    if constexpr (!ALIGN_EPI) { if (wr == 0) PG8_BAR; }
    PG8_BAR;
    if constexpr (Epi::AFTER_DRAIN) { E.fused(acc, cur, wr, wc, fr, fq, lds, wid, lane); S.done(cur); }
#undef PG8_SA
#undef PG8_SB
#undef PG8_STAGE
#undef PG8_LDA
#undef PG8_LDB
#undef PG8_MMA
#undef PG8_WAIT_V
#undef PG8_WAIT_L
#undef PG8_BAR
#undef PG8_SCHED
}
}

#define LAS __attribute__((address_space(3)))
typedef unsigned short bf16;
typedef float f32x4 __attribute__((ext_vector_type(4)));
typedef short bf16x8 __attribute__((ext_vector_type(8)));
typedef short s16x4 __attribute__((ext_vector_type(4)));
typedef unsigned u32x4 __attribute__((ext_vector_type(4)));
typedef unsigned u32x2 __attribute__((ext_vector_type(2)));

constexpr int D = 1024, FF = 2816, SEQ = 8192, NB = 4, NMETA = 16;
constexpr int MREAL = NB * SEQ;
constexpr int MMETA0 = MREAL;
constexpr int MPAD = MREAL + 256;
constexpr int NCH = 129;
constexpr int GLA_NIN = 3328;
constexpr float LN_EPS = 1e-5f, RMS_EPS = 1e-6f;
constexpr float ALPHA = 1.41421356237f;

constexpr size_t al256(size_t x) { return (x + 255) & ~(size_t)255; }
constexpr size_t SZ_WFI = (size_t)2 * FF * D * 2, SZ_WFO = (size_t)D * FF * 2;
constexpr size_t WS_WFI = 0;
constexpr size_t WS_WFO = WS_WFI + 4 * SZ_WFI;
constexpr size_t WS_WCI = WS_WFO + 4 * SZ_WFO;
constexpr size_t WS_WCO = WS_WCI + (size_t)3072 * D * 2;
constexpr size_t WS_WGI = WS_WCO + (size_t)D * D * 2;
constexpr size_t WS_WGO = WS_WGI + (size_t)GLA_NIN * D * 2;
constexpr size_t WS_HB = WS_WGO + (size_t)D * D * 2;
constexpr size_t WS_XM = WS_HB + (size_t)MPAD * D * 2;
constexpr size_t WS_METAR = WS_XM + (size_t)256 * D * 4;
constexpr size_t WS_STATS = WS_METAR + (size_t)256 * D * 4;
constexpr size_t WS_BIG = al256(WS_STATS + (size_t)MPAD * 8);
constexpr size_t SZ_ROWBF = (size_t)MPAD * D * 2;
constexpr size_t BIG_ACT = 0;
constexpr size_t BIG_BG = 0, BIG_CU = SZ_ROWBF;
constexpr size_t BIG_Q = 0, BIG_K = SZ_ROWBF / 2, BIG_V = SZ_ROWBF, BIG_G = 2 * SZ_ROWBF, BIG_GZ = 3 * SZ_ROWBF;
constexpr size_t BIG_U = al256(BIG_GZ + (size_t)MPAD * 16 * 4);
constexpr size_t BIG_DEC = BIG_U + (size_t)NCH * 16 * 32768 * 2;
constexpr size_t BIG_END = BIG_DEC + (size_t)NCH * 16 * 128 * 4;
constexpr size_t WS_BAR = al256(WS_BIG + BIG_END);
constexpr size_t WS_BAR_BYTES = 16384;
constexpr size_t WS_END = WS_BAR + WS_BAR_BYTES;
static_assert((size_t)MPAD * FF * 2 <= BIG_END, "act fits");

constexpr int LDS_BYTES = 147456;

struct Params {
    const float* x; const float* meta; const float* ln_gain; const float* ln_bias; const float* ffn_w_in; const float* ffn_w_out;
    const float* conv_w_in; const float* conv_w; const float* conv_w_out; const float* gla_w_in; const float* gla_w_up; const float* gla_b_gate;
    const float* gla_norm_w; const float* gla_w_out; float* out; unsigned char* ws;
};

__device__ __forceinline__ unsigned f2bf(float f) { unsigned u = __builtin_bit_cast(unsigned, f); return (u + 0x7fffu + ((u >> 16) & 1u)) >> 16; }
__device__ __forceinline__ unsigned pk2(float lo, float hi) { return pg8::cvt_pk_bf16(lo, hi); }
__device__ __forceinline__ float bf_lo(unsigned w) { return __builtin_bit_cast(float, w << 16); }
__device__ __forceinline__ float bf_hi(unsigned w) { return __builtin_bit_cast(float, w & 0xffff0000u); }
__device__ __forceinline__ float wave_sum(float v) {
#pragma unroll
    for (int o = 1; o < 64; o <<= 1) v += __shfl_xor(v, o);
    return v;
}
#define LDS_WAIT() asm volatile("s_waitcnt lgkmcnt(0)" ::: "memory")

__device__ __forceinline__ void p0_transpose_item(const float* W, int K, int ldw, int scol, int nvalid, bf16* WT, int n0d, int k0, LAS float* scr, int lane) {
    float tv[32];
#pragma unroll
    for (int i = 0; i < 32; ++i) { const int kk = 2 * i + (lane >> 5), j = lane & 31; tv[i] = (j < nvalid) ? W[(size_t)(k0 + kk) * ldw + scol + j] : 0.f; }
#pragma unroll
    for (int i = 0; i < 32; ++i) { const int kk = 2 * i + (lane >> 5), j = lane & 31; scr[kk * 33 + j] = tv[i]; }
    LDS_WAIT(); asm volatile("" ::: "memory");
    const int c = lane & 7;
#pragma unroll
    for (int jj = 0; jj < 4; ++jj) { const int n = (lane >> 3) + 8 * jj; const LAS float* s = scr + (8 * c) * 33 + n;
        u32x4 o; o.x = pk2(s[0 * 33], s[1 * 33]); o.y = pk2(s[2 * 33], s[3 * 33]); o.z = pk2(s[4 * 33], s[5 * 33]); o.w = pk2(s[6 * 33], s[7 * 33]);
        pg8::wt16(WT + (size_t)(n0d + n) * K + k0 + 8 * c, o); }
    LDS_WAIT(); asm volatile("" ::: "memory");
}
__device__ __forceinline__ void p0_matrix(const float* W, int K, int Nsrc, int Ndst, int mode, bf16* WT, LAS float* scr, int lane, int item) {
    const int nblk = Ndst / 32, kb = item / nblk, nb = item % nblk, n0d = nb * 32, k0 = kb * 64;
    int scol = n0d, nvalid = 32;
    if (mode == 1) { const int pn = n0d >> 8, j = n0d & 255; scol = (j < 128) ? 128 * pn + j : FF + 128 * pn + (j - 128); }
    else if (mode == 2) { const int pn = n0d >> 8, j = n0d & 255; scol = (pn < 8) ? ((j < 128) ? 1024 + 128 * pn + j : 2048 + 128 * pn + (j - 128)) : 256 * (pn - 8) + j; }
    else if (mode == 3) { nvalid = Nsrc - n0d; nvalid = nvalid < 0 ? 0 : (nvalid > 32 ? 32 : nvalid); if (nvalid == 0) scol = 0; }
    p0_transpose_item(W, K, Nsrc, scol, nvalid, WT, n0d, k0, scr, lane);
}
__device__ __forceinline__ void p0_prologue(const Params& p, LAS unsigned char* lds, int gw, int NGW, int wave, int lane) {
    LAS float* scr = (LAS float*)(lds + wave * 16384);
    unsigned char* ws = p.ws;
    constexpr int I_FI = (D / 64) * (2 * FF / 32), I_FO = (FF / 64) * (D / 32), I_CI = (D / 64) * (3072 / 32), I_SQ = (D / 64) * (D / 32), I_GI = (D / 64) * (GLA_NIN / 32);
    constexpr int NITEMS = 4 * I_FI + 4 * I_FO + I_CI + I_SQ + I_GI + I_SQ;
    for (int it = gw; it < NITEMS; it += NGW) {
        int r = it;
        if (r < 4 * I_FI) { const int l = r / I_FI; p0_matrix(p.ffn_w_in + (size_t)l * D * 2 * FF, D, 2 * FF, 2 * FF, 1, (bf16*)(ws + WS_WFI + l * SZ_WFI), scr, lane, r % I_FI); continue; } r -= 4 * I_FI;
        if (r < 4 * I_FO) { const int l = r / I_FO; p0_matrix(p.ffn_w_out + (size_t)l * FF * D, FF, D, D, 0, (bf16*)(ws + WS_WFO + l * SZ_WFO), scr, lane, r % I_FO); continue; } r -= 4 * I_FO;
        if (r < I_CI) { p0_matrix(p.conv_w_in, D, 3072, 3072, 2, (bf16*)(ws + WS_WCI), scr, lane, r); continue; } r -= I_CI;
        if (r < I_SQ) { p0_matrix(p.conv_w_out, D, D, D, 0, (bf16*)(ws + WS_WCO), scr, lane, r); continue; } r -= I_SQ;
        if (r < I_GI) { p0_matrix(p.gla_w_in, D, 3088, GLA_NIN, 3, (bf16*)(ws + WS_WGI), scr, lane, r); continue; } r -= I_GI;
        p0_matrix(p.gla_w_out, D, D, D, 0, (bf16*)(ws + WS_WGO), scr, lane, r);
    }
    bf16* HB = (bf16*)(ws + WS_HB); float* METAR = (float*)(ws + WS_METAR);
    for (int m0 = gw; m0 < MREAL + NMETA; m0 += 4 * NGW) {
        f32x4 v[4][4];
#pragma unroll
        for (int r = 0; r < 4; ++r) { const int m = m0 + r * NGW;
            if (m < MREAL + NMETA) { const float* src = (m < MREAL) ? p.x + (size_t)m * D : p.meta + (size_t)(m - MREAL) * D;
#pragma unroll
                for (int j = 0; j < 4; ++j) v[r][j] = ((const f32x4*)src)[lane + 64 * j]; } }
#pragma unroll
        for (int r = 0; r < 4; ++r) { const int m = m0 + r * NGW;
            if (m < MREAL + NMETA) {
                unsigned long long* o8 = (unsigned long long*)(HB + (size_t)m * D) + lane;
#pragma unroll
                for (int j = 0; j < 4; ++j) {
                    pg8::wt8(o8 + 64 * j, (unsigned long long)pk2(v[r][j][0], v[r][j][1]) | ((unsigned long long)pk2(v[r][j][2], v[r][j][3]) << 32));
                    if (m >= MREAL) pg8::wt16((f32x4*)(METAR + (size_t)(m - MREAL) * D) + lane + 64 * j, v[r][j]);
                } } }
    }
}

template <bool FINAL>
__device__ __forceinline__ void ln_phase(const float* Zreal, const float* Zmeta, const float* gain, const float* bias, bf16* HB, float* stats, float* out, int gw, int NGW, int lane) {
    f32x4 g[4], bb[4];
#pragma unroll
    for (int j = 0; j < 4; ++j) { g[j] = ((const f32x4*)gain)[lane + 64 * j]; bb[j] = ((const f32x4*)bias)[lane + 64 * j]; }
    const int nrows = FINAL ? MREAL : MREAL + NMETA;
    for (int m0 = gw; m0 < nrows; m0 += 4 * NGW) {
        f32x4 v[4][4];
#pragma unroll
        for (int r = 0; r < 4; ++r) { const int m = m0 + r * NGW;
            if (m < nrows) { const float* zr = (m < MREAL) ? Zreal + (size_t)m * D : Zmeta + (size_t)(m - MREAL) * D;
#pragma unroll
                for (int j = 0; j < 4; ++j) v[r][j] = ((const f32x4*)zr)[lane + 64 * j]; }
            else {
#pragma unroll
                for (int j = 0; j < 4; ++j) v[r][j] = (f32x4){0.f, 0.f, 0.f, 0.f}; } }
#pragma unroll
        for (int r = 0; r < 4; ++r) { const int m = m0 + r * NGW;
            float s = 0.f;
#pragma unroll
            for (int j = 0; j < 4; ++j) s += (v[r][j][0] + v[r][j][1]) + (v[r][j][2] + v[r][j][3]);
            const float mean = wave_sum(s) * (1.f / D); float s2 = 0.f;
#pragma unroll
            for (int j = 0; j < 4; ++j) { const f32x4 d = v[r][j] - mean; s2 += (d[0] * d[0] + d[1] * d[1]) + (d[2] * d[2] + d[3] * d[3]); }
            const float rstd = 1.0f / sqrtf(wave_sum(s2) * (1.f / D) + LN_EPS);
            if (m < nrows) {
                if (FINAL) {
#pragma unroll
                    for (int j = 0; j < 4; ++j) ((f32x4*)(out + (size_t)m * D))[lane + 64 * j] = (v[r][j] - mean) * rstd * g[j] + bb[j];
                } else {
                    if (lane == 0) pg8::wt8(stats + (size_t)m * 2, (unsigned long long)__float_as_uint(mean) | ((unsigned long long)__float_as_uint(rstd) << 32));
                    unsigned long long* o8 = (unsigned long long*)(HB + (size_t)m * D) + lane;
#pragma unroll
                    for (int j = 0; j < 4; ++j) { const f32x4 y = (v[r][j] - mean) * rstd * g[j] + bb[j]; pg8::wt8(o8 + 64 * j, (unsigned long long)pk2(y[0], y[1]) | ((unsigned long long)pk2(y[2], y[3]) << 32)); }
                }
            }
        }
    }
}

__device__ __forceinline__ int conv_pred(int m, int k) {
    if (m < MREAL) { const int t = m & (SEQ - 1); return (t >= k) ? m - k : MMETA0 + (NMETA + t - k); }
    const int j = m - MMETA0; return (j >= k) ? m - k : -1;
}
__device__ __forceinline__ void conv_mix_phase(const bf16* BG, const bf16* CU, const float* cw, bf16* VO, int gw, int NGW, int lane) {
    const int nrows = MREAL + NMETA;
    const u32x4 z4 = (u32x4){0u, 0u, 0u, 0u};
    float wt[3][16];
#pragma unroll
    for (int k = 0; k < 3; ++k)
#pragma unroll
        for (int j = 0; j < 2; ++j)
#pragma unroll
            for (int q = 0; q < 2; ++q) { const f32x4 t = *(const f32x4*)(cw + k * D + 8 * (lane + 64 * j) + 4 * q);
                wt[k][8 * j + 4 * q] = t[0]; wt[k][8 * j + 4 * q + 1] = t[1]; wt[k][8 * j + 4 * q + 2] = t[2]; wt[k][8 * j + 4 * q + 3] = t[3]; }
    for (int m0 = gw; m0 < nrows; m0 += 2 * NGW) {
        u32x4 b4[2][2], x0[2][2], x1[2][2], x2[2][2];
#pragma unroll
        for (int r = 0; r < 2; ++r) { const int m = m0 + r * NGW; const bool ok = m < nrows;
            const int p1 = ok ? conv_pred(m, 1) : -1, p2 = ok ? conv_pred(m, 2) : -1;
#pragma unroll
            for (int j = 0; j < 2; ++j) { const int c0 = 8 * (lane + 64 * j);
                b4[r][j] = ok ? *(const u32x4*)(BG + (size_t)m * D + c0) : z4; x0[r][j] = ok ? *(const u32x4*)(CU + (size_t)m * D + c0) : z4;
                x1[r][j] = (p1 >= 0) ? *(const u32x4*)(CU + (size_t)p1 * D + c0) : z4; x2[r][j] = (p2 >= 0) ? *(const u32x4*)(CU + (size_t)p2 * D + c0) : z4; } }
#pragma unroll
        for (int r = 0; r < 2; ++r) { const int m = m0 + r * NGW;
            if (m < nrows) {
#pragma unroll
                for (int j = 0; j < 2; ++j) { u32x4 o;
#pragma unroll
                    for (int q = 0; q < 4; ++q) { const int e = 8 * j + 2 * q;
                        const float lo = bf_lo(b4[r][j][q]) * (wt[0][e] * bf_lo(x2[r][j][q]) + wt[1][e] * bf_lo(x1[r][j][q]) + wt[2][e] * bf_lo(x0[r][j][q]));
                        const float hi = bf_hi(b4[r][j][q]) * (wt[0][e + 1] * bf_hi(x2[r][j][q]) + wt[1][e + 1] * bf_hi(x1[r][j][q]) + wt[2][e + 1] * bf_hi(x0[r][j][q]));
                        o[q] = pk2(lo, hi); }
                    pg8::wt16(VO + (size_t)m * D + 8 * (lane + 64 * j), o); } } }
    }
}

constexpr int GL_B = 0, GL_GZ = 33792, GL_TOT = 37888, GL_RED = 39936, GL_K = 41984, GL_QS = 59392, GL_QI = 76800, GL_V = 94208, GL_P = 128000;
constexpr int BSTR = 132, KSTR = 136, VSTR = 264, PSTR = 72, USTR = 136;
static_assert(GL_P + 64 * PSTR * 2 <= LDS_BYTES, "gla lds");
__device__ __forceinline__ int gla_row(int b, int n, int c) { return n ? b * SEQ + (n - 1) * 64 + c : (c >= 48 ? MMETA0 + (c - 48) : -1); }
__device__ __forceinline__ s16x4 tr_read(unsigned a) { s16x4 r; asm volatile("ds_read_b64_tr_b16 %0, %1\n\ts_waitcnt lgkmcnt(0)" : "=&v"(r) : "v"(a) : "memory"); return r; }
__device__ __forceinline__ bf16x8 tr_frag(unsigned a0, unsigned a1) { const s16x4 lo = tr_read(a0), hi = tr_read(a1); return __builtin_shufflevector(lo, hi, 0, 1, 2, 3, 4, 5, 6, 7); }
__device__ __forceinline__ unsigned lds_u32(const LAS void* p) { return (unsigned)(uintptr_t)p; }

constexpr int GLA_UNITS = (NCH - 1) * 16 + 4;
__device__ __forceinline__ void gla_unit(int idx, int& n, int& b, int& h) { if (idx < (NCH - 1) * 16) { n = 1 + (idx >> 4); b = (idx & 15) >> 2; h = idx & 3; } else { n = 0; b = 0; h = idx - (NCH - 1) * 16; } }
__device__ __forceinline__ void gla_cumdecay(LAS unsigned char* lds, const f32x4 gzv, const float (&w)[16], float bia, int n, int tid) {
    LAS float* sB = (LAS float*)(lds + GL_B); LAS float* sGZ = (LAS float*)(lds + GL_GZ); LAS float* sTot = (LAS float*)(lds + GL_TOT);
    if (tid < 256) *(LAS f32x4*)(sGZ + (tid >> 2) * 16 + (tid & 3) * 4) = gzv;
    const int kd = tid & 127, grp = tid >> 7;
    __syncthreads();
    float loc[16]; float run = 0.f;
#pragma unroll
    for (int i = 0; i < 16; ++i) {
        const int c = grp * 16 + i;
        float z = bia;
#pragma unroll
        for (int r4 = 0; r4 < 4; ++r4) { const f32x4 gv = *(const LAS f32x4*)(sGZ + c * 16 + r4 * 4); z += gv[0] * w[r4 * 4] + gv[1] * w[r4 * 4 + 1] + gv[2] * w[r4 * 4 + 2] + gv[3] * w[r4 * 4 + 3]; }
        float la = (fminf(z, 0.f) - __logf(1.0f + __expf(-fabsf(z)))) * (1.0f / 16.0f);
        if (n == 0 && c < 48) la = 0.f;
        run += la; loc[i] = run;
    }
    sTot[grp * 128 + kd] = run;
    __syncthreads();
    float off = 0.f;
#pragma unroll
    for (int g2 = 0; g2 < 3; ++g2) off += (g2 < grp) ? sTot[g2 * 128 + kd] : 0.f;
#pragma unroll
    for (int i = 0; i < 16; ++i) sB[(grp * 16 + i) * BSTR + kd] = loc[i] + off;
    __syncthreads();
}
__device__ __forceinline__ void unpack8(const u32x4 w, float (&f)[8]) {
#pragma unroll
    for (int q = 0; q < 4; ++q) { f[2 * q] = bf_lo(w[q]); f[2 * q + 1] = bf_hi(w[q]); }
}
__device__ __forceinline__ u32x4 pack8f(const float (&f)[8]) { u32x4 w; w.x = pk2(f[0], f[1]); w.y = pk2(f[2], f[3]); w.z = pk2(f[4], f[5]); w.w = pk2(f[6], f[7]); return w; }

__device__ __forceinline__ void gla_g1(const Params& p, LAS unsigned char* lds, int tid, int wave, int lane) {
    unsigned char* big = p.ws + WS_BIG;
    const bf16* Kb = (const bf16*)(big + BIG_K); const bf16* Vb = (const bf16*)(big + BIG_V); const float* GZ = (const float*)(big + BIG_GZ);
    bf16* Ub = (bf16*)(big + BIG_U); float* Dec = (float*)(big + BIG_DEC);
    LAS float* sB = (LAS float*)(lds + GL_B); LAS bf16* sK = (LAS bf16*)(lds + GL_K); LAS bf16* sV = (LAS bf16*)(lds + GL_V);
    const int fr = lane & 15, fq = lane >> 4;
    const u32x4 z4 = (u32x4){0u, 0u, 0u, 0u};
    for (int idx = blockIdx.x; idx < GLA_UNITS; idx += gridDim.x) {
        int n, b, h; gla_unit(idx, n, b, h); const int unit = n * 16 + b * 4 + h;
        f32x4 gzv = (f32x4){0.f, 0.f, 0.f, 0.f};
        if (tid < 256) { const int row = gla_row(b, n, tid >> 2); if (row >= 0) gzv = *(const f32x4*)(GZ + (size_t)row * 16 + (tid & 3) * 4); }
        float w[16];
#pragma unroll
        for (int r = 0; r < 16; ++r) w[r] = p.gla_w_up[r * 512 + h * 128 + (tid & 127)];
        const float bia = p.gla_b_gate[h * 128 + (tid & 127)];
        const int kd8 = (tid & 15) * 8, cb = tid >> 4;
        u32x4 kv[2], vv[4];
#pragma unroll
        for (int i = 0; i < 2; ++i) { const int row = gla_row(b, n, cb + 32 * i); kv[i] = (row >= 0) ? *(const u32x4*)(Kb + (size_t)row * 512 + h * 128 + kd8) : z4; }
#pragma unroll
        for (int i = 0; i < 4; ++i) { const int ii = tid + 512 * i, row = gla_row(b, n, ii >> 5); vv[i] = (row >= 0) ? *(const u32x4*)(Vb + (size_t)row * D + h * 256 + (ii & 31) * 8) : z4; }
        gla_cumdecay(lds, gzv, w, bia, n, tid);
        {
            float* Bu = (float*)(p.ws + WS_HB) + (size_t)unit * 8192;
#pragma unroll
            for (int i = 0; i < 4; ++i) { const int ii = tid + 512 * i, c = ii >> 5, k4 = (ii & 31) * 4; pg8::wt16(Bu + c * 128 + k4, *(const LAS f32x4*)(sB + c * BSTR + k4)); }
        }
        {
            float bl[8];
#pragma unroll
            for (int j = 0; j < 8; ++j) bl[j] = sB[63 * BSTR + kd8 + j];
#pragma unroll
            for (int i = 0; i < 2; ++i) { const int c = cb + 32 * i;
                float kf[8]; unpack8(kv[i], kf);
#pragma unroll
                for (int j = 0; j < 8; ++j) kf[j] *= __expf(bl[j] - sB[c * BSTR + kd8 + j]);
                *(LAS u32x4*)(sK + c * KSTR + kd8) = pack8f(kf); }
            if (tid < 128) pg8::wt4(Dec + (size_t)unit * 128 + tid, __expf(sB[63 * BSTR + tid]));
#pragma unroll
            for (int i = 0; i < 4; ++i) { const int ii = tid + 512 * i; *(LAS u32x4*)(sV + (ii >> 5) * VSTR + (ii & 31) * 8) = vv[i]; }
        }
        __syncthreads();
        f32x4 acc[8][2];
#pragma unroll
        for (int i = 0; i < 8; ++i)
#pragma unroll
            for (int j = 0; j < 2; ++j) acc[i][j] = (f32x4){0.f, 0.f, 0.f, 0.f};
#pragma unroll
        for (int ks = 0; ks < 2; ++ks) {
            const int r0 = 32 * ks + 8 * fq + (fr >> 2), cc = 4 * (fr & 3);
            bf16x8 Y[2];
#pragma unroll
            for (int j = 0; j < 2; ++j) { const int vd0 = 32 * wave + 16 * j; Y[j] = tr_frag(lds_u32(sV + r0 * VSTR + vd0 + cc), lds_u32(sV + (r0 + 4) * VSTR + vd0 + cc)); }
#pragma unroll
            for (int i = 0; i < 8; ++i) { const bf16x8 X = tr_frag(lds_u32(sK + r0 * KSTR + 16 * i + cc), lds_u32(sK + (r0 + 4) * KSTR + 16 * i + cc));
#pragma unroll
                for (int j = 0; j < 2; ++j) acc[i][j] = __builtin_amdgcn_mfma_f32_16x16x32_bf16(X, Y[j], acc[i][j], 0, 0, 0); }
        }
        bf16* Uu = Ub + (size_t)unit * 32768;
        __syncthreads();
        LAS bf16* sU = (LAS bf16*)lds;
#pragma unroll
        for (int i = 0; i < 8; ++i)
#pragma unroll
            for (int j = 0; j < 2; ++j) { const int vd = 32 * wave + 16 * j + fr, kd = 16 * i + 4 * fq;
                u32x2 wv; wv.x = pk2(acc[i][j][0], acc[i][j][1]); wv.y = pk2(acc[i][j][2], acc[i][j][3]);
                *(LAS u32x2*)(sU + vd * USTR + kd) = wv; }
        __syncthreads();
#pragma unroll
        for (int it = 0; it < 8; ++it) { const int idx = tid + 512 * it, vd = idx >> 4, part = idx & 15;
            pg8::wt16(Uu + (size_t)idx * 8, *(const LAS u32x4*)(sU + vd * USTR + part * 8)); }
        __syncthreads();
    }
}

__device__ __forceinline__ void gla_g2(const Params& p, int tid) {
    unsigned char* big = p.ws + WS_BIG;
    bf16* Ub = (bf16*)(big + BIG_U); const float* Dec = (const float*)(big + BIG_DEC);
    for (int g = blockIdx.x * 512 + tid; g < 16 * 8192; g += gridDim.x * 512) {
        const int bh = g >> 13, e4 = (g & 8191) * 4, kd = e4 & 127;
        float S0, S1, S2, S3;
        { const size_t unit = (size_t)(bh & 3); const u32x2 u0 = *(const u32x2*)(Ub + unit * 32768 + e4); S0 = bf_lo(u0.x); S1 = bf_hi(u0.x); S2 = bf_lo(u0.y); S3 = bf_hi(u0.y); }
        for (int n0 = 1; n0 < NCH; n0 += 8) {
            u32x2 uu[8]; f32x4 dd[8];
#pragma unroll
            for (int i = 0; i < 8; ++i) { const size_t unit = (size_t)(n0 + i) * 16 + bh;
                uu[i] = *(const u32x2*)(Ub + unit * 32768 + e4); dd[i] = *(const f32x4*)(Dec + unit * 128 + kd); }
#pragma unroll
            for (int i = 0; i < 8; ++i) { const size_t unit = (size_t)(n0 + i) * 16 + bh;
                u32x2 wv; wv.x = pk2(S0, S1); wv.y = pk2(S2, S3); pg8::wt8(Ub + unit * 32768 + e4, wv);
                S0 = dd[i][0] * S0 + bf_lo(uu[i].x); S1 = dd[i][1] * S1 + bf_hi(uu[i].x); S2 = dd[i][2] * S2 + bf_lo(uu[i].y); S3 = dd[i][3] * S3 + bf_hi(uu[i].y); }
        }
    }
}

__device__ __forceinline__ void gla_g3(const Params& p, LAS unsigned char* lds, int tid, int wave, int lane) {
    unsigned char* big = p.ws + WS_BIG;
    const bf16* Qb = (const bf16*)(big + BIG_Q); const bf16* Kb = (const bf16*)(big + BIG_K); const bf16* Vb = (const bf16*)(big + BIG_V); const bf16* Gb = (const bf16*)(big + BIG_G);
    const bf16* Sb = (const bf16*)(big + BIG_U); bf16* Ob = (bf16*)(big + BIG_V);
    LAS float* sB = (LAS float*)(lds + GL_B); LAS float* sRed = (LAS float*)(lds + GL_RED);
    LAS bf16* sK = (LAS bf16*)(lds + GL_K); LAS bf16* sQs = (LAS bf16*)(lds + GL_QS); LAS bf16* sQi = (LAS bf16*)(lds + GL_QI); LAS bf16* sV = (LAS bf16*)(lds + GL_V); LAS bf16* sP = (LAS bf16*)(lds + GL_P);
    const int fr = lane & 15, fq = lane >> 4;
    const u32x4 z4 = (u32x4){0u, 0u, 0u, 0u};
    for (int idx = blockIdx.x; idx < GLA_UNITS; idx += gridDim.x) {
        int n, b, h; gla_unit(idx, n, b, h); const int unit = n * 16 + b * 4 + h;
        const float* Bu = (const float*)(p.ws + WS_HB) + (size_t)unit * 8192;
        f32x4 bt[4];
#pragma unroll
        for (int i = 0; i < 4; ++i) { const int ii = tid + 512 * i; bt[i] = *(const f32x4*)(Bu + (ii >> 5) * 128 + (ii & 31) * 4); }
        const int kd8 = (tid & 15) * 8, cb = tid >> 4;
        u32x4 qv[2], kv[2], vv[4];
#pragma unroll
        for (int i = 0; i < 2; ++i) { const int row = gla_row(b, n, cb + 32 * i);
            qv[i] = (row >= 0) ? *(const u32x4*)(Qb + (size_t)row * 512 + h * 128 + kd8) : z4; kv[i] = (row >= 0) ? *(const u32x4*)(Kb + (size_t)row * 512 + h * 128 + kd8) : z4; }
#pragma unroll
        for (int i = 0; i < 4; ++i) { const int ii = tid + 512 * i, row = gla_row(b, n, ii >> 5); vv[i] = (row >= 0) ? *(const u32x4*)(Vb + (size_t)row * D + h * 256 + (ii & 31) * 8) : z4; }
        const bf16* Su = Sb + (size_t)unit * 32768;
        bf16x8 X2[4][2];
        if (n) {
#pragma unroll
            for (int ks = 0; ks < 4; ++ks)
#pragma unroll
                for (int xi = 0; xi < 2; ++xi) X2[ks][xi] = *(const bf16x8*)(Su + (32 * wave + 16 * xi + fr) * 128 + 32 * ks + 8 * fq);
        }
        u32x2 gg[4][2]; f32x4 nw[2];
#pragma unroll
        for (int xi = 0; xi < 2; ++xi) nw[xi] = *(const f32x4*)(p.gla_norm_w + 32 * wave + 16 * xi + 4 * fq);
#pragma unroll
        for (int mi = 0; mi < 4; ++mi) { const int row = gla_row(b, n, 16 * mi + fr);
#pragma unroll
            for (int xi = 0; xi < 2; ++xi) gg[mi][xi] = (row >= 0) ? *(const u32x2*)(Gb + (size_t)row * D + h * 256 + 32 * wave + 16 * xi + 4 * fq) : (u32x2){0u, 0u}; }
#pragma unroll
        for (int i = 0; i < 4; ++i) { const int ii = tid + 512 * i; *(LAS f32x4*)(sB + (ii >> 5) * BSTR + (ii & 31) * 4) = bt[i]; }
        __syncthreads();
        {
            float br[8];
#pragma unroll
            for (int j = 0; j < 8; ++j) br[j] = sB[32 * BSTR + kd8 + j];
#pragma unroll
            for (int i = 0; i < 2; ++i) { const int c = cb + 32 * i;
                float qf[8], kf[8], qs[8], qi[8]; unpack8(qv[i], qf); unpack8(kv[i], kf);
#pragma unroll
                for (int j = 0; j < 8; ++j) { const float bb = sB[c * BSTR + kd8 + j]; const float e = __expf(bb - br[j]);
                    qs[j] = qf[j] * e; kf[j] = kf[j] * __expf(br[j] - bb); qi[j] = qf[j] * __expf(bb); }
                *(LAS u32x4*)(sQs + c * KSTR + kd8) = pack8f(qs); *(LAS u32x4*)(sK + c * KSTR + kd8) = pack8f(kf); *(LAS u32x4*)(sQi + c * KSTR + kd8) = pack8f(qi); }
#pragma unroll
            for (int i = 0; i < 4; ++i) { const int ii = tid + 512 * i; *(LAS u32x4*)(sV + (ii >> 5) * VSTR + (ii & 31) * 8) = vv[i]; }
        }
        __syncthreads();
        {
            const int ti = wave >> 1;
#pragma unroll
            for (int jj = 0; jj < 2; ++jj) {
                const int tj = 2 * (wave & 1) + jj;
                f32x4 a = (f32x4){0.f, 0.f, 0.f, 0.f};
                if (tj <= ti) {
#pragma unroll
                    for (int ks = 0; ks < 4; ++ks) {
                        const bf16x8 X = *(const LAS bf16x8*)(sK + (tj * 16 + fr) * KSTR + 32 * ks + 8 * fq);
                        const bf16x8 Y = *(const LAS bf16x8*)(sQs + (ti * 16 + fr) * KSTR + 32 * ks + 8 * fq);
                        a = __builtin_amdgcn_mfma_f32_16x16x32_bf16(X, Y, a, 0, 0, 0);
                    }
                }
                const int ci = ti * 16 + fr, cj = tj * 16 + 4 * fq;
                float e0 = (cj + 0 <= ci) ? a[0] : 0.f, e1 = (cj + 1 <= ci) ? a[1] : 0.f, e2 = (cj + 2 <= ci) ? a[2] : 0.f, e3 = (cj + 3 <= ci) ? a[3] : 0.f;
                u32x2 wv; wv.x = pk2(e0, e1); wv.y = pk2(e2, e3);
                *(LAS u32x2*)(sP + ci * PSTR + cj) = wv;
            }
        }
        __syncthreads();
        f32x4 acc[4][2];
#pragma unroll
        for (int mi = 0; mi < 4; ++mi)
#pragma unroll
            for (int xi = 0; xi < 2; ++xi) acc[mi][xi] = (f32x4){0.f, 0.f, 0.f, 0.f};
#pragma unroll
        for (int ks = 0; ks < 2; ++ks) {
            const int r0 = 32 * ks + 8 * fq + (fr >> 2), cc = 4 * (fr & 3);
            bf16x8 X1[2];
#pragma unroll
            for (int xi = 0; xi < 2; ++xi) { const int vd0 = 32 * wave + 16 * xi; X1[xi] = tr_frag(lds_u32(sV + r0 * VSTR + vd0 + cc), lds_u32(sV + (r0 + 4) * VSTR + vd0 + cc)); }
#pragma unroll
            for (int mi = 0; mi < 4; ++mi) { const bf16x8 Y1 = *(const LAS bf16x8*)(sP + (16 * mi + fr) * PSTR + 32 * ks + 8 * fq);
#pragma unroll
                for (int xi = 0; xi < 2; ++xi) acc[mi][xi] = __builtin_amdgcn_mfma_f32_16x16x32_bf16(X1[xi], Y1, acc[mi][xi], 0, 0, 0); }
        }
        if (n) {
#pragma unroll
            for (int ks = 0; ks < 4; ++ks) {
#pragma unroll
                for (int mi = 0; mi < 4; ++mi) { const bf16x8 Y2 = *(const LAS bf16x8*)(sQi + (16 * mi + fr) * KSTR + 32 * ks + 8 * fq);
#pragma unroll
                    for (int xi = 0; xi < 2; ++xi) acc[mi][xi] = __builtin_amdgcn_mfma_f32_16x16x32_bf16(X2[ks][xi], Y2, acc[mi][xi], 0, 0, 0); }
            }
        }
#pragma unroll
        for (int mi = 0; mi < 4; ++mi) { float ss = 0.f;
#pragma unroll
            for (int xi = 0; xi < 2; ++xi) ss += (acc[mi][xi][0] * acc[mi][xi][0] + acc[mi][xi][1] * acc[mi][xi][1]) + (acc[mi][xi][2] * acc[mi][xi][2] + acc[mi][xi][3] * acc[mi][xi][3]);
            ss += __shfl_xor(ss, 16); ss += __shfl_xor(ss, 32);
            if (fq == 0) sRed[wave * 64 + 16 * mi + fr] = ss; }
        __syncthreads();
        LAS bf16* sO = (LAS bf16*)(lds + GL_V);
#pragma unroll
        for (int mi = 0; mi < 4; ++mi) {
            const int c = 16 * mi + fr;
            float tot = 0.f;
#pragma unroll
            for (int w2 = 0; w2 < 8; ++w2) tot += sRed[w2 * 64 + c];
            const float rinv = 1.0f / sqrtf(tot * (1.0f / 256.0f) + RMS_EPS);
#pragma unroll
            for (int xi = 0; xi < 2; ++xi) { const int vd = 32 * wave + 16 * xi + 4 * fq;
                const float o0 = acc[mi][xi][0] * rinv * nw[xi][0] * bf_lo(gg[mi][xi].x), o1 = acc[mi][xi][1] * rinv * nw[xi][1] * bf_hi(gg[mi][xi].x);
                const float o2 = acc[mi][xi][2] * rinv * nw[xi][2] * bf_lo(gg[mi][xi].y), o3 = acc[mi][xi][3] * rinv * nw[xi][3] * bf_hi(gg[mi][xi].y);
                u32x2 wv; wv.x = pk2(o0, o1); wv.y = pk2(o2, o3);
                *(LAS u32x2*)(sO + c * VSTR + vd) = wv; }
        }
        __syncthreads();
#pragma unroll
        for (int it = 0; it < 4; ++it) { const int idx = tid + 512 * it, c = idx >> 5, part = idx & 31; const int row = gla_row(b, n, c);
            if (row >= 0) pg8::wt16(Ob + (size_t)row * D + h * 256 + part * 8, *(const LAS u32x4*)(sO + c * VSTR + part * 8)); }
        __syncthreads();
    }
}

typedef __attribute__((address_space(1))) unsigned gu32;
#define XB_TMO      128
#define XB_XCNT(j)  (256  + 64 * (j))
#define XB_XSUB(j)  (1280 + 64 * (j))
#define XB_XGEN(j)  (2304 + 64 * (j))
#define XB_TOP      3328
#define XB_TOPGEN   3392
#define XCD_BAR_WORDS 3456
#define XB_SPIN_CAP (1u << 18)

__device__ __forceinline__ unsigned xb_ld(unsigned* p)              { return __hip_atomic_load(p, __ATOMIC_RELAXED, __HIP_MEMORY_SCOPE_AGENT); }
__device__ __forceinline__ unsigned xb_add(unsigned* p, unsigned v) { return __hip_atomic_fetch_add(p, v, __ATOMIC_RELAXED, __HIP_MEMORY_SCOPE_AGENT); }
__device__ __forceinline__ unsigned xb_xcc_id() { return (unsigned)__builtin_amdgcn_s_getreg((3 << 11) | 20) & 0xFu; }
#define XB_SPIN(cond, bar) do { unsigned _sp = 0; while (cond) { __builtin_amdgcn_s_sleep(1); \
    if ((++_sp & 255u) == 0u) { if (xb_ld(&(bar)[XB_TMO])) break; if (_sp > XB_SPIN_CAP) { atomicAdd(&(bar)[XB_TMO], 1u); break; } } } } while (0)

struct XcdBarrier {
    unsigned* bar; unsigned x;
    volatile LAS unsigned* st;
};

__device__ __forceinline__ XcdBarrier xcd_barrier_post(unsigned* bar, volatile LAS unsigned* st) {
    XcdBarrier b; b.bar = bar; b.x = xb_xcc_id(); b.st = st;
    if (threadIdx.x == 0) (void)xb_add(&bar[XB_XCNT(b.x)], 1u);
    return b;
}
__device__ __forceinline__ void xcd_barrier_complete(unsigned* bar, unsigned x, unsigned& nloc, unsigned& nx) {
    const unsigned G = gridDim.x * gridDim.y * gridDim.z;
    unsigned sum, cnt, mine, sp = 0u;
    for (;;) {
        sum = 0u; cnt = 0u; mine = 0u;
#pragma unroll
        for (unsigned j = 0; j < 16; ++j) { const unsigned c = xb_ld(&bar[XB_XCNT(j)]); sum += c; cnt += (c > 0u) ? 1u : 0u; mine = (j == x) ? c : mine; }
        if (sum == G) break;
        __builtin_amdgcn_s_sleep(1);
        if ((++sp & 255u) == 0u) { if (xb_ld(&bar[XB_TMO])) break; if (sp > XB_SPIN_CAP) { atomicAdd(&bar[XB_TMO], 1u); break; } }
    }
    nloc = mine > 0u ? mine : 1u; nx = cnt > 0u ? cnt : 1u;
}

__device__ __forceinline__ void xcd_barrier(const XcdBarrier& b) {
    asm volatile("s_waitcnt vmcnt(0)" ::: "memory");
    __syncthreads();
    if (threadIdx.x == 0) {
        unsigned* bar = b.bar;
        __builtin_amdgcn_s_waitcnt(0);
        __builtin_amdgcn_fence(__ATOMIC_ACQUIRE, "agent"); asm volatile("s_waitcnt vmcnt(0)" ::: "memory");
        unsigned nloc = b.st[0], nx = b.st[1];
        if (nloc == 0u) { xcd_barrier_complete(bar, b.x, nloc, nx); b.st[0] = nloc; b.st[1] = nx; }
        const unsigned old = xb_add(&bar[XB_XSUB(b.x)], 1u);
        const unsigned gen = old / nloc;
        if (old + 1u == (gen + 1u) * nloc) {
            asm volatile("s_waitcnt vmcnt(0)" ::: "memory");
            const unsigned og = xb_add(&bar[XB_TOP], 1u);
            const unsigned tg = og / nx;
            if (og + 1u == (tg + 1u) * nx) xb_add(&bar[XB_TOPGEN], 1u);
            else XB_SPIN(xb_ld(&bar[XB_TOPGEN]) == tg, bar);
            xb_add(&bar[XB_XGEN(b.x)], 1u);
            asm volatile("s_waitcnt vmcnt(0)" ::: "memory");
        } else {
            XB_SPIN(xb_ld(&bar[XB_XGEN(b.x)]) == gen, bar);
            asm volatile("s_waitcnt vmcnt(0)" ::: "memory");
        }
    }
    __syncthreads();
}

__device__ __forceinline__ void mini_gemm(LAS unsigned char* lds, const bf16* A, const bf16* B0, const bf16* B1, int K, int wave, int lane, f32x4& r0, f32x4& r1) {
    const int fr = lane & 15, fq = lane >> 4;
    f32x4 a0 = (f32x4){0.f, 0.f, 0.f, 0.f}, a1 = a0;
    const bf16* ap = A + (size_t)fr * K + 8 * fq; const bf16* b0p = B0 + (size_t)fr * K + 8 * fq; const bf16* b1p = B1 + (size_t)fr * K + 8 * fq;
    for (int ks = wave; ks < K / 32; ks += 8) {
        const bf16x8 af = *(const bf16x8*)(ap + 32 * ks), b0 = *(const bf16x8*)(b0p + 32 * ks), b1 = *(const bf16x8*)(b1p + 32 * ks);
        a0 = __builtin_amdgcn_mfma_f32_16x16x32_bf16(b0, af, a0, 0, 0, 0);
        a1 = __builtin_amdgcn_mfma_f32_16x16x32_bf16(b1, af, a1, 0, 0, 0);
    }
    LAS f32x4* red = (LAS f32x4*)lds;
    red[(wave * 2 + 0) * 64 + lane] = a0; red[(wave * 2 + 1) * 64 + lane] = a1;
    __syncthreads();
    if (wave == 0) {
        r0 = red[lane]; r1 = red[64 + lane];
#pragma unroll
        for (int w = 1; w < 8; ++w) { r0 += red[(w * 2) * 64 + lane]; r1 += red[(w * 2 + 1) * 64 + lane]; }
    }
    __syncthreads();
}
__device__ __forceinline__ u32x2 pack4(const f32x4 v) { u32x2 w; w.x = pk2(v[0], v[1]); w.y = pk2(v[2], v[3]); return w; }
__device__ __forceinline__ void mini_ffn_in(LAS unsigned char* lds, const bf16* HB, const bf16* Wt, bf16* ACT, int t, int wave, int lane) {
    const int pn = t >> 3, j0 = (t & 7) * 16; f32x4 g, u;
    mini_gemm(lds, HB + (size_t)MMETA0 * D, Wt + (size_t)(256 * pn + j0) * D, Wt + (size_t)(256 * pn + 128 + j0) * D, D, wave, lane, g, u);
    if (wave == 0) { f32x4 a;
#pragma unroll
        for (int j = 0; j < 4; ++j) a[j] = pg8::silu_f(g[j]) * u[j];
        pg8::wt8(ACT + (size_t)(MMETA0 + (lane & 15)) * FF + 16 * t + 4 * (lane >> 4), pack4(a)); }
}
__device__ __forceinline__ void mini_resid(LAS unsigned char* lds, const bf16* A, int K, const bf16* Wt, const float* src, float* dst, const float* stats, const float* gain, const float* bias, float scale, int t, int wave, int lane) {
    f32x4 r[2];
    mini_gemm(lds, A + (size_t)MMETA0 * K, Wt + (size_t)(32 * t) * K, Wt + (size_t)(32 * t + 16) * K, K, wave, lane, r[0], r[1]);
    if (wave == 0) { const int row = lane & 15; float mean = 0.f, rstd = 1.f;
        if (stats) { mean = stats[(size_t)(MMETA0 + row) * 2]; rstd = stats[(size_t)(MMETA0 + row) * 2 + 1]; }
#pragma unroll
        for (int q = 0; q < 2; ++q) { const int col = 32 * t + 16 * q + 4 * (lane >> 4);
            const f32x4 x = *(const f32x4*)(src + (size_t)row * D + col);
            f32x4 h = x;
            if (stats) h = (x - mean) * rstd * *(const f32x4*)(gain + col) + *(const f32x4*)(bias + col);
            pg8::wt16(dst + (size_t)row * D + col, h * ALPHA + r[q] * scale); } }
}
__device__ __forceinline__ void mini_conv_in(LAS unsigned char* lds, const bf16* HB, const bf16* Wt, bf16* CU, bf16* BG, int t, int wave, int lane) {
    f32x4 a, b;
    if (t < 64) { const int pn = t >> 3, j0 = (t & 7) * 16;
        mini_gemm(lds, HB + (size_t)MMETA0 * D, Wt + (size_t)(256 * pn + j0) * D, Wt + (size_t)(256 * pn + 128 + j0) * D, D, wave, lane, a, b);
        if (wave == 0) pg8::wt8(CU + (size_t)(MMETA0 + (lane & 15)) * D + 16 * t + 4 * (lane >> 4), pack4(a * b));
    } else { const int c0 = 16 * (t - 64);
        mini_gemm(lds, HB + (size_t)MMETA0 * D, Wt + (size_t)(2048 + c0) * D, Wt + (size_t)(2048 + c0) * D, D, wave, lane, a, b);
        if (wave == 0) pg8::wt8(BG + (size_t)(MMETA0 + (lane & 15)) * D + c0 + 4 * (lane >> 4), pack4(a)); }
}
__device__ __forceinline__ void mini_gla_in(LAS unsigned char* lds, const bf16* HB, const bf16* Wt, bf16* Q, bf16* Kk, bf16* V, bf16* G, float qscale, int t, int wave, int lane) {
    f32x4 r[2];
    mini_gemm(lds, HB + (size_t)MMETA0 * D, Wt + (size_t)(32 * t) * D, Wt + (size_t)(32 * t + 16) * D, D, wave, lane, r[0], r[1]);
    if (wave == 0) { const size_t row = MMETA0 + (lane & 15);
#pragma unroll
        for (int q = 0; q < 2; ++q) { const int c = 32 * t + 16 * q + 4 * (lane >> 4); f32x4 v = r[q];
            if (c < 512) pg8::wt8(Q + row * 512 + c, pack4(v * qscale));
            else if (c < 1024) pg8::wt8(Kk + row * 512 + (c - 512), pack4(v));
            else if (c < 2048) pg8::wt8(V + row * D + (c - 1024), pack4(v));
            else {
#pragma unroll
                for (int j = 0; j < 4; ++j) v[j] = pg8::silu_f(v[j]);
                pg8::wt8(G + row * D + (c - 2048), pack4(v)); } } }
}
__device__ __forceinline__ void gz_phase(const bf16* HB, const bf16* Wgz, float* GZ, int gw, int NGW, int lane) {
    const int fr = lane & 15, fq = lane >> 4;
    for (int rb = gw; rb < MREAL / 16 + 1; rb += NGW) {
        const size_t row0 = (size_t)rb * 16;
        const bf16* ap = HB + (row0 + fr) * D + 8 * fq; const bf16* bp = Wgz + (size_t)fr * D + 8 * fq;
        f32x4 a0 = (f32x4){0.f, 0.f, 0.f, 0.f}, a1 = a0;
#pragma unroll 4
        for (int ks = 0; ks < D / 32; ks += 2) {
            a0 = __builtin_amdgcn_mfma_f32_16x16x32_bf16(*(const bf16x8*)(bp + 32 * ks), *(const bf16x8*)(ap + 32 * ks), a0, 0, 0, 0);
            a1 = __builtin_amdgcn_mfma_f32_16x16x32_bf16(*(const bf16x8*)(bp + 32 * ks + 32), *(const bf16x8*)(ap + 32 * ks + 32), a1, 0, 0, 0);
        }
        pg8::wt16(GZ + (row0 + fr) * 16 + 4 * fq, a0 + a1);
    }
}


#ifndef REP_G1
#define REP_G1 1
#endif
#ifndef REP_G2
#define REP_G2 0
#endif
#ifndef REP_LN
#define REP_LN 1
#endif
#ifndef REP_GLA
#define REP_GLA 1
#endif
#ifndef REP_SYNC
#define REP_SYNC 0
#endif
#ifndef REP_MIX
#define REP_MIX 1
#endif
template <class Epi>
__device__ __forceinline__ void run_gemm(LAS unsigned char* lds, const bf16* A, const bf16* Bt, int N, int K, const Epi& E) {
    pg8::Gemm g{A, Bt, MREAL, N, K}; pg8::StaticOrder S; S.init(MREAL, N, (int)gridDim.x, (int)blockIdx.x);
    pg8::gemm_phase<Epi, pg8::StaticOrder, true, true>(lds, g, S, E);
}

__global__ void __launch_bounds__(512, 2) fwd_megakernel(Params p) {
    extern __shared__ __attribute__((aligned(16))) unsigned char lds_raw[];
    LAS unsigned char* lds = (LAS unsigned char*)lds_raw;
    cg::grid_group grid = cg::this_grid();
    if (threadIdx.x < 16) ((LAS unsigned*)(lds + LDS_BYTES - 64))[threadIdx.x] = 0u;
    __syncthreads();
    const XcdBarrier xbar = xcd_barrier_post((unsigned*)(p.ws + WS_BAR), (volatile LAS unsigned*)(lds + LDS_BYTES - 64));
#define GSYNC() xcd_barrier(xbar)
    const int tid0 = threadIdx.x;
#define FRESH_IDS() int tid = tid0; asm volatile("" : "+v"(tid)); const int lane = tid & 63, wave = __builtin_amdgcn_readfirstlane(tid >> 6); const int gw = vcu * 8 + wave
    const int G = gridDim.x, bx = blockIdx.x;
    const int vcu = (G % 8 == 0) ? (bx % 8) * (G / 8) + bx / 8 : bx;
    const int NGW = G * 8;
    unsigned char* ws = p.ws; unsigned char* big = ws + WS_BIG;
    bf16* HB = (bf16*)(ws + WS_HB); float* XM = (float*)(ws + WS_XM); float* METAR = (float*)(ws + WS_METAR); float* STATS = (float*)(ws + WS_STATS);
    bf16* ACT = (bf16*)(big + BIG_ACT);

#ifndef NO_P0
    { FRESH_IDS(); p0_prologue(p, lds, gw, NGW, wave, lane); }
#endif
    grid.sync();

    int lnk = 0;
#pragma clang loop unroll(disable)
    for (int blk = 0; blk < 4; ++blk) {
        {
            { FRESH_IDS(); if (bx < 176) mini_ffn_in(lds, HB, (const bf16*)(ws + WS_WFI + (size_t)blk * SZ_WFI), ACT, bx, wave, lane); }
            pg8::EpiSwiGLU E1{ACT, FF};
            for (int rep = 0; rep < REP_G1; ++rep) run_gemm(lds, HB, (const bf16*)(ws + WS_WFI + (size_t)blk * SZ_WFI), 2 * FF, D, E1);
            GSYNC();
            pg8::EpiResid E2;
            if (lnk == 0) E2 = pg8::EpiResid{p.x, METAR, p.out, XM, nullptr, nullptr, nullptr, ALPHA, 0.5f};
            else E2 = pg8::EpiResid{p.out, XM, p.out, XM, STATS, p.ln_gain + (lnk - 1) * D, p.ln_bias + (lnk - 1) * D, ALPHA, 0.5f};
            { FRESH_IDS(); if (bx >= 64 && bx < 96) mini_resid(lds, ACT, FF, (const bf16*)(ws + WS_WFO + (size_t)blk * SZ_WFO), lnk == 0 ? METAR : XM, XM, E2.stats, E2.gain, E2.bias, 0.5f, bx - 64, wave, lane); }
            for (int rep = 0; rep < REP_G2; ++rep) { pg8::EpiResid E3 = E2; E3.Oreal = (float*)(big + BIG_U); run_gemm(lds, ACT, (const bf16*)(ws + WS_WFO + (size_t)blk * SZ_WFO), D, FF, E3); }
            run_gemm(lds, ACT, (const bf16*)(ws + WS_WFO + (size_t)blk * SZ_WFO), D, FF, E2);
            GSYNC();
            if (blk == 3) { FRESH_IDS(); ln_phase<true>(p.out, XM, p.ln_gain + 5 * D, p.ln_bias + 5 * D, nullptr, nullptr, p.out, gw, NGW, lane); break; }
            for (int rep = 0; rep < REP_LN; ++rep) { FRESH_IDS(); ln_phase<false>(p.out, XM, p.ln_gain + lnk * D, p.ln_bias + lnk * D, HB, STATS, nullptr, gw, NGW, lane); } ++lnk;
            for (int rep = 0; rep < REP_SYNC; ++rep) GSYNC();
            GSYNC();
        }
        if (blk == 0 || blk == 2) {
            const bf16* Wo; const bf16* Ao = HB;
            if (blk == 0) {
                { FRESH_IDS(); if (bx < 128) mini_conv_in(lds, HB, (const bf16*)(ws + WS_WCI), (bf16*)(big + BIG_CU), (bf16*)(big + BIG_BG), bx, wave, lane); }
                pg8::EpiConvIn Ec{(bf16*)(big + BIG_CU), (bf16*)(big + BIG_BG)};
                run_gemm(lds, HB, (const bf16*)(ws + WS_WCI), 3072, D, Ec);
                GSYNC();
#ifndef NO_CM
                for (int rep = 0; rep < REP_MIX; ++rep) { FRESH_IDS(); conv_mix_phase((const bf16*)(big + BIG_BG), (const bf16*)(big + BIG_CU), p.conv_w, HB, gw, NGW, lane); }
#endif
                GSYNC();
                Wo = (const bf16*)(ws + WS_WCO);
            } else {
                { FRESH_IDS(); gz_phase(HB, (const bf16*)(ws + WS_WGI) + (size_t)3072 * D, (float*)(big + BIG_GZ), gw, NGW, lane);
                  if (bx >= 128 && bx < 224) mini_gla_in(lds, HB, (const bf16*)(ws + WS_WGI), (bf16*)(big + BIG_Q), (bf16*)(big + BIG_K), (bf16*)(big + BIG_V), (bf16*)(big + BIG_G), 0.08838834764831845f, bx - 128, wave, lane); }
                pg8::EpiGlaIn Eg{(bf16*)(big + BIG_Q), (bf16*)(big + BIG_K), (bf16*)(big + BIG_V), (bf16*)(big + BIG_G), (float*)(big + BIG_GZ), 0.08838834764831845f};
                run_gemm(lds, HB, (const bf16*)(ws + WS_WGI), 3072, D, Eg);
                GSYNC();
#ifndef NO_G1
                for (int rep = 0; rep < REP_GLA; ++rep) { FRESH_IDS(); gla_g1(p, lds, tid, wave, lane); }
#endif
                GSYNC();
#ifndef NO_G2
                { FRESH_IDS(); gla_g2(p, tid); }
#endif
                GSYNC();
#ifndef NO_G3
                for (int rep = 0; rep < REP_GLA; ++rep) { FRESH_IDS(); gla_g3(p, lds, tid, wave, lane); }
#endif
                GSYNC();
                Wo = (const bf16*)(ws + WS_WGO); Ao = (const bf16*)(big + BIG_V);
            }
            pg8::EpiResid Eo{p.out, XM, p.out, XM, STATS, p.ln_gain + (lnk - 1) * D, p.ln_bias + (lnk - 1) * D, ALPHA, 1.0f};
            { FRESH_IDS(); if (bx >= 32 && bx < 64) mini_resid(lds, Ao, D, Wo, XM, XM, STATS, Eo.gain, Eo.bias, 1.0f, bx - 32, wave, lane); }
            run_gemm(lds, Ao, Wo, D, D, Eo);
            GSYNC();
            for (int rep = 0; rep < REP_LN; ++rep) { FRESH_IDS(); ln_phase<false>(p.out, XM, p.ln_gain + lnk * D, p.ln_bias + lnk * D, HB, STATS, nullptr, gw, NGW, lane); } ++lnk;
            for (int rep = 0; rep < REP_SYNC; ++rep) GSYNC();
            GSYNC();
        }
    }
}

extern "C" void kernel_launch(void* const* d_in, const int* in_sizes, int n_in, void* d_out, int out_size, void* d_ws, size_t ws_size, hipStream_t stream) {
    static int grid_blocks = 0;
    if (grid_blocks == 0) {
        if (n_in != 14 || out_size != MREAL * D || ws_size < WS_END) { fprintf(stderr, "kernel_launch: unexpected shapes: n_in %d out %d ws %zu (need %zu)\n", n_in, out_size, ws_size, (size_t)WS_END); grid_blocks = -1; return; }
        int dev = 0, cus = 0, per_cu = 0;
        hipGetDevice(&dev); hipDeviceGetAttribute(&cus, hipDeviceAttributeMultiprocessorCount, dev);
        if (hipFuncSetAttribute((const void*)fwd_megakernel, hipFuncAttributeMaxDynamicSharedMemorySize, LDS_BYTES) != hipSuccess) { fprintf(stderr, "kernel_launch: hipFuncSetAttribute failed\n"); grid_blocks = -1; return; }
        if (hipOccupancyMaxActiveBlocksPerMultiprocessor(&per_cu, (const void*)fwd_megakernel, 512, LDS_BYTES) != hipSuccess || per_cu < 1) { fprintf(stderr, "kernel_launch: occupancy query says %d\n", per_cu); per_cu = 1; }
        (void)hipGetLastError();
        grid_blocks = cus * 1;
    }
    if (grid_blocks < 0) return;
    Params p{};
    p.x = (const float*)d_in[0]; p.meta = (const float*)d_in[1]; p.ln_gain = (const float*)d_in[2]; p.ln_bias = (const float*)d_in[3];
    p.ffn_w_in = (const float*)d_in[4]; p.ffn_w_out = (const float*)d_in[5]; p.conv_w_in = (const float*)d_in[6]; p.conv_w = (const float*)d_in[7];
    p.conv_w_out = (const float*)d_in[8]; p.gla_w_in = (const float*)d_in[9]; p.gla_w_up = (const float*)d_in[10]; p.gla_b_gate = (const float*)d_in[11];
    p.gla_norm_w = (const float*)d_in[12]; p.gla_w_out = (const float*)d_in[13]; p.out = (float*)d_out; p.ws = (unsigned char*)d_ws;
    if (hipMemsetAsync((char*)d_ws + WS_BAR, 0, WS_BAR_BYTES, stream) != hipSuccess) { fprintf(stderr, "kernel_launch: memset of barrier words failed\n"); return; }
    void* args[] = {&p};
    hipError_t e = hipLaunchCooperativeKernel((const void*)fwd_megakernel, dim3(grid_blocks), dim3(512), args, LDS_BYTES, stream);
    if (e != hipSuccess) fprintf(stderr, "cooperative launch failed: %s (grid %d)\n", hipGetErrorString(e), grid_blocks);
}
```
